# Optimizing an MI355X kernel written in HIP

```python
import math
import jax, jax.numpy as jnp
from jax import lax
import numpy as np

D_MODEL = 2048
BATCH = 4
SEQ = 4096
DEPTH = 2
DEC_BATCH = 2
DEC_SEQ = 4096
PAST_LEN = 128

MIX_WIDTH = D_MODEL
A_HEADS = 6
A_HEAD_DIM = 128
A_WIDTH = A_HEADS * A_HEAD_DIM
CHUNK = 128
B_HEADS = 4
B_HEAD_DIM = 128
B_WIDTH = B_HEADS * B_HEAD_DIM
C_WIDTH = MIX_WIDTH - A_WIDTH - B_WIDTH
C_GROUP = 16
C_GROUPS = C_WIDTH // C_GROUP
C_STATE = 64
IN_WIDTH = 2 * A_WIDTH + B_WIDTH + C_WIDTH
D_FF = -(-8 * D_MODEL // (3 * 256)) * 256
EPS = 1e-6

kernel_name = "hybrid_gmlp_fnet_s5_encoder"


def rms_norm(x, g):
    xf = x.astype(jnp.float32)
    y = xf * lax.rsqrt(jnp.mean(xf * xf, axis=-1, keepdims=True) + EPS)
    return (y * g.astype(jnp.float32)).astype(x.dtype)


def gmlp_mixer(z, v_gain, w_s, b_s):
    nb, s, _ = z.shape
    z = jax.nn.gelu(z)
    u, v = jnp.split(z, 2, axis=-1)
    v = rms_norm(v.reshape(nb, s, A_HEADS, A_HEAD_DIM), v_gain.reshape(A_HEADS, A_HEAD_DIM))
    vc = v.reshape(nb, s // CHUNK, CHUNK, A_HEADS, A_HEAD_DIM)
    mixed = jnp.einsum('hqk,bnkhd->bnqhd', w_s, vc) + b_s.T[None, None, :, :, None]
    return u * mixed.reshape(nb, s, A_WIDTH)


def fourier_mixer(z):
    nb, s, _ = z.shape
    zh = z.reshape(nb, s, B_HEADS, B_HEAD_DIM).astype(jnp.float32)
    f = jnp.fft.fft2(zh, axes=(1, 3), norm='ortho').real
    return f.reshape(nb, s, B_WIDTH).astype(z.dtype)


def _complex_diag_scan(a_re, a_im, x_re, x_im, reverse):
    def combine(e1, e2):
        a1r, a1i, x1r, x1i = e1
        a2r, a2i, x2r, x2i = e2
        return (a2r * a1r - a2i * a1i,
                a2r * a1i + a2i * a1r,
                a2r * x1r - a2i * x1i + x2r,
                a2r * x1i + a2i * x1r + x2i)
    ar = jnp.broadcast_to(a_re, x_re.shape)
    ai = jnp.broadcast_to(a_im, x_re.shape)
    _, _, hr, hi = lax.associative_scan(combine, (ar, ai, x_re, x_im), axis=1, reverse=reverse)
    return hr, hi


def s5_mixer(z, lam_re, lam_im, log_step, b_re, b_im, c_re, c_im, d_skip, w_glu, b_glu):
    nb, s, _ = z.shape
    f32 = jnp.float32
    u = z.reshape(nb, s, C_GROUPS, C_GROUP).astype(f32)
    lr = lam_re.astype(f32)
    li = lam_im.astype(f32)
    step = jnp.exp(log_step.astype(f32))[..., None]
    mag = jnp.exp(lr * step)
    ab_re = mag * jnp.cos(li * step)
    ab_im = mag * jnp.sin(li * step)
    den = lr * lr + li * li
    nr = ab_re - 1.0
    q_re = (nr * lr + ab_im * li) / den
    q_im = (ab_im * lr - nr * li) / den
    br = b_re.astype(f32)[None]
    bi = b_im.astype(f32)[None]
    bb_re = q_re[..., None] * br - q_im[..., None] * bi
    bb_im = q_re[..., None] * bi + q_im[..., None] * br
    h_re = 0.0
    h_im = 0.0
    for t, rev in ((0, False), (1, True)):
        xr = jnp.einsum('bsgc,gpc->bsgp', u, bb_re[t])
        xi = jnp.einsum('bsgc,gpc->bsgp', u, bb_im[t])
        hr, hi = _complex_diag_scan(ab_re[t], ab_im[t], xr, xi, rev)
        h_re = h_re + hr
        h_im = h_im + hi
    y = (jnp.einsum('bsgp,gcp->bsgc', h_re, c_re.astype(f32))
         - jnp.einsum('bsgp,gcp->bsgc', h_im, c_im.astype(f32))
         + d_skip.astype(f32).reshape(C_GROUPS, C_GROUP) * u)
    y = jax.nn.gelu(y.reshape(nb, s, C_WIDTH)).astype(z.dtype)
    return y * jax.nn.sigmoid(y @ w_glu + b_glu)


def trunk(x, p):
    for l in range(DEPTH):
        h = rms_norm(x, p['norm1_g'][l])
        zin = h @ p['w_in'][l]
        za = zin[..., :2 * A_WIDTH]
        zb = zin[..., 2 * A_WIDTH:2 * A_WIDTH + B_WIDTH]
        zc = zin[..., 2 * A_WIDTH + B_WIDTH:]
        ya = gmlp_mixer(za, p['a_v_g'][l], p['a_ws'][l], p['a_bs'][l])
        yb = fourier_mixer(zb)
        yc = s5_mixer(zc, p['c_lam_re'][l], p['c_lam_im'][l], p['c_log_step'][l],
                      p['c_b_re'][l], p['c_b_im'][l], p['c_c_re'][l], p['c_c_im'][l],
                      p['c_d'][l], p['c_w_glu'][l], p['c_b_glu'][l])
        og = p['out_norm_g'][l]
        y = jnp.concatenate([
            rms_norm(ya, og[:A_WIDTH]),
            rms_norm(yb, og[A_WIDTH:A_WIDTH + B_WIDTH]),
            rms_norm(yc, og[A_WIDTH + B_WIDTH:])], axis=-1)
        x = x + y @ p['w_out'][l]
        h = rms_norm(x, p['norm2_g'][l])
        x = x + (jax.nn.silu(h @ p['w_gate'][l]) * (h @ p['w_up'][l])) @ p['w_down'][l]
    return rms_norm(x, p['final_g'])


def setup_inputs(seed: int = 0) -> dict:
    key = jax.random.key(seed)
    k = jax.random.split(key, 24)
    f32 = jnp.float32
    nrm = lambda kk, shape, scale: jax.random.normal(kk, shape, f32) * scale
    n_idx = jnp.arange(C_STATE, dtype=f32)
    return {
        'x_prompt': nrm(k[0], (BATCH, SEQ, D_MODEL), 1.0),
        'x_sample': nrm(k[1], (DEC_BATCH, DEC_SEQ, D_MODEL), 1.0),
        'norm1_g': 1.0 + nrm(k[2], (DEPTH, D_MODEL), 0.02),
        'w_in': nrm(k[3], (DEPTH, D_MODEL, IN_WIDTH), D_MODEL ** -0.5),
        'a_v_g': 1.0 + nrm(k[4], (DEPTH, A_WIDTH), 0.02),
        'a_ws': nrm(k[5], (DEPTH, A_HEADS, CHUNK, CHUNK), 0.5 * CHUNK ** -0.5),
        'a_bs': 1.0 + nrm(k[6], (DEPTH, A_HEADS, CHUNK), 0.02),
        'c_lam_re': -0.5 + nrm(k[7], (DEPTH, 2, C_GROUPS, C_STATE), 0.01),
        'c_lam_im': math.pi * n_idx + nrm(k[8], (DEPTH, 2, C_GROUPS, C_STATE), 0.01),
        'c_log_step': jax.random.uniform(k[9], (DEPTH, 2, C_GROUPS), f32, math.log(1e-3), math.log(1e-1)),
        'c_b_re': nrm(k[10], (DEPTH, C_GROUPS, C_STATE, C_GROUP), (2 * C_GROUP) ** -0.5),
        'c_b_im': nrm(k[11], (DEPTH, C_GROUPS, C_STATE, C_GROUP), (2 * C_GROUP) ** -0.5),
        'c_c_re': nrm(k[12], (DEPTH, C_GROUPS, C_GROUP, C_STATE), C_STATE ** -0.5),
        'c_c_im': nrm(k[13], (DEPTH, C_GROUPS, C_GROUP, C_STATE), C_STATE ** -0.5),
        'c_d': nrm(k[14], (DEPTH, C_WIDTH), 1.0),
        'c_w_glu': nrm(k[15], (DEPTH, C_WIDTH, C_WIDTH), C_WIDTH ** -0.5),
        'c_b_glu': nrm(k[16], (DEPTH, C_WIDTH), 0.02),
        'out_norm_g': 1.0 + nrm(k[17], (DEPTH, MIX_WIDTH), 0.02),
        'w_out': nrm(k[18], (DEPTH, MIX_WIDTH, D_MODEL), MIX_WIDTH ** -0.5),
        'norm2_g': 1.0 + nrm(k[19], (DEPTH, D_MODEL), 0.02),
        'w_gate': nrm(k[20], (DEPTH, D_MODEL, D_FF), D_MODEL ** -0.5),
        'w_up': nrm(k[21], (DEPTH, D_MODEL, D_FF), D_MODEL ** -0.5),
        'w_down': nrm(k[22], (DEPTH, D_FF, D_MODEL), D_FF ** -0.5),
        'final_g': 1.0 + nrm(k[23], (D_MODEL,), 0.02),
    }


def reference(x_prompt, x_sample, norm1_g, w_in, a_v_g, a_ws, a_bs, c_lam_re, c_lam_im,
              c_log_step, c_b_re, c_b_im, c_c_re, c_c_im, c_d, c_w_glu, c_b_glu,
              out_norm_g, w_out, norm2_g, w_gate, w_up, w_down, final_g):
    p = dict(norm1_g=norm1_g, w_in=w_in, a_v_g=a_v_g, a_ws=a_ws, a_bs=a_bs,
             c_lam_re=c_lam_re, c_lam_im=c_lam_im, c_log_step=c_log_step,
             c_b_re=c_b_re, c_b_im=c_b_im, c_c_re=c_c_re, c_c_im=c_c_im, c_d=c_d,
             c_w_glu=c_w_glu, c_b_glu=c_b_glu, out_norm_g=out_norm_g, w_out=w_out,
             norm2_g=norm2_g, w_gate=w_gate, w_up=w_up, w_down=w_down, final_g=final_g)
    y_prompt = trunk(x_prompt, p)
    y_sample = trunk(x_sample, p)
    return (y_prompt, y_sample)
```

```cpp
#include <hip/hip_runtime.h>
#include <hip/hip_cooperative_groups.h>
#include <cstdio>
#include <cstdint>
namespace cg = cooperative_groups;

#ifndef MK_ONE_LAUNCH
#define MK_ONE_LAUNCH 1
#endif

#define LAS __attribute__((address_space(3)))
typedef unsigned short bf16_t;
typedef short bf16x8 __attribute__((ext_vector_type(8)));
typedef float f32x4 __attribute__((ext_vector_type(4)));
typedef float f32x2 __attribute__((ext_vector_type(2)));
typedef unsigned u32x4 __attribute__((ext_vector_type(4)));
typedef unsigned u32x2 __attribute__((ext_vector_type(2)));

constexpr int T = 24576, DM = 2048, NBATCH = 6, SEQ = 4096, DFF = 5632, INW = 2816;
constexpr int NGRP = 48, NCHUNK = T / 32;
constexpr float EPS = 1e-6f;
constexpr int NTHREADS = 512;
constexpr int LDS_BYTES = 131072 + 1024;

constexpr size_t WS_WINAC = 0;
constexpr size_t WS_WINBF = WS_WINAC + (size_t)2304 * 2048 * 2;
constexpr size_t WS_WOUT  = WS_WINBF + (size_t)1024 * 2048 * 2;
constexpr size_t WS_WGLU  = WS_WOUT + (size_t)2048 * 2048 * 2;
constexpr size_t WS_WS    = WS_WGLU + (size_t)768 * 768 * 2;
constexpr size_t WS_WGU   = WS_WS + (size_t)6 * 128 * 128 * 2;
constexpr size_t WS_WDOWN = WS_WGU + (size_t)11264 * 2048 * 2;
constexpr size_t WS_DFT   = WS_WDOWN + (size_t)2048 * 5632 * 2;
constexpr size_t WS_AL    = WS_DFT + (size_t)4096 * 8192 * 2;
constexpr size_t WS_SLOT1 = WS_AL + (size_t)48 * 2 * 64 * 2 * 4;
constexpr size_t WS_ACT   = WS_SLOT1 + (size_t)T * 2048 * 2;
constexpr size_t WS_ZINA  = WS_ACT;
constexpr size_t WS_ZFT   = WS_ZINA + (size_t)T * 1536 * 2;
constexpr size_t WS_YCPRE = WS_ZFT;
constexpr size_t WS_UCAT  = WS_ZFT + (size_t)512 * 49152 * 2;
constexpr size_t WS_XS    = WS_UCAT + (size_t)48 * 768 * 768 * 2;
constexpr size_t WS_TE    = WS_XS + (size_t)48 * 768 * 256 * 4;
constexpr size_t WS_GM    = WS_TE + (size_t)48 * 512 * 768 * 2;
constexpr size_t WS_MIXEND = WS_GM + (size_t)48 * 256 * 512 * 2;
constexpr size_t WS_HID   = WS_ACT;
constexpr size_t WS_END   = WS_ACT + (size_t)T * 5632 * 2;
static_assert(WS_MIXEND <= WS_END, "mixer buffers must fit under the FFN hidden buffer");

struct Args { const float* in[24]; float* out; unsigned char* ws; int ph_lo, ph_hi; };

__device__ __forceinline__ int tid_l() { int t = threadIdx.x; asm volatile("" : "+v"(t)); return t; }
__device__ __forceinline__ unsigned cvt_pk_bf16(float lo, float hi) { unsigned r; asm("v_cvt_pk_bf16_f32 %0, %1, %2" : "=v"(r) : "v"(lo), "v"(hi)); return r; }
__device__ __forceinline__ float bf_lo(unsigned w) { return __uint_as_float(w << 16); }
__device__ __forceinline__ float bf_hi(unsigned w) { return __uint_as_float(w & 0xffff0000u); }
__device__ __forceinline__ bf16_t f2bf(float f) { return (bf16_t)(cvt_pk_bf16(f, 0.f) & 0xffffu); }
__device__ __forceinline__ float sigmoid_f(float v) { return __builtin_amdgcn_rcpf(1.0f + __builtin_amdgcn_exp2f(-1.4426950409f * v)); }
__device__ __forceinline__ float gelu_tanh(float x) { const float z = x * (1.5957691216f + 0.0713548163f * x * x); return x * sigmoid_f(z); }
__device__ __forceinline__ float wave_sum(float v) {
#pragma unroll
    for (int o = 32; o >= 1; o >>= 1) v += __shfl_xor(v, o);
    return v;
}

namespace pg8 {
constexpr int BM = 256, BK = 64, HALF = 128, HTB = HALF * BK * 2, STAGE_BYTES = 8 * HTB, NXCD = 8, WGM = 8;
__device__ __forceinline__ int lds_byte(int r, int c) { const int st = (r >> 4) * 2 + (c >> 5), rr = r & 15, cc = c & 31, ob = rr * 64 + cc * 2; return st * 1024 + (ob ^ (((ob >> 9) & 1) << 5)); }
__device__ __forceinline__ void stage_rc(int b, int& R, int& C) { const int st = b / 1024, sb = b % 1024, swz = sb ^ (((sb >> 9) & 1) << 5); R = (st >> 1) * 16 + swz / 64; C = (st & 1) * 32 + (swz % 64) / 2; }
__device__ __forceinline__ int perm32(int rho) { const int n = rho >> 4, i = rho & 15; return 8 * (i >> 2) + 4 * n + (i & 3); }

struct Unit { const char* A; const char* B; int pm, pn, grp; };
struct Sched {
    const char* A; const char* B; long gsA, gsB; int lda, ldb, nM, nN, nG, G, c;
    __device__ __forceinline__ bool next(int i, Unit& u) const {
        const int nwg = nM * nN;
        const long L = (long)i * G + c; if (c < 0 || L >= (long)nwg * nG) return false;
        const int grp = (int)(L / nwg); int wgid = (int)(L - (long)grp * nwg);
        { const int q = nwg / NXCD, r = nwg % NXCD, xcd = wgid % NXCD, off = wgid / NXCD; wgid = (xcd < r ? xcd * (q + 1) : r * (q + 1) + (xcd - r) * q) + off; }
        const int nig = WGM * nN, gid = wgid / nig, fm = gid * WGM, gsz = (nM - fm) < WGM ? (nM - fm) : WGM;
        u.pm = fm + ((wgid % nig) % gsz); u.pn = (wgid % nig) / gsz; u.grp = grp;
        u.A = A + (size_t)grp * gsA + (size_t)u.pm * 512 * lda; u.B = B + (size_t)grp * gsB + (size_t)u.pn * 512 * ldb;
        return true;
    }
};

template <class Epi>
__device__ __forceinline__ void gemm_phase(LAS unsigned char* lds, const Sched& S, const int K, const Epi& E) {
    int tid = threadIdx.x; asm volatile("" : "+v"(tid));
    const int wid = __builtin_amdgcn_readfirstlane(tid >> 6), lane = tid & 63, wr = wid >> 2, wc = wid & 3, fr = lane & 15, fq = lane >> 4;
    const int nt = K / BK;
    unsigned voffA[2], voffB[2];
#pragma unroll
    for (int i = 0; i < 2; ++i) { int R, C; stage_rc(tid * 16 + i * 8192, R, C); const int Rb = Epi::PERM ? ((R & ~31) + perm32(R & 31)) : R;
        voffA[i] = (unsigned)(R * S.lda + C) * 2u; voffB[i] = (unsigned)(Rb * S.ldb + C) * 2u; }
    const size_t kstep = (size_t)(BK * 2);
    const size_t hstepA = (size_t)HALF * S.lda * 2, hstepB = (size_t)HALF * S.ldb * 2;
    const unsigned ldsw = (unsigned)wid * 1024u;
    const int aoff = lds_byte(wr * 64 + fr, fq * 8), boff = lds_byte(wc * 32 + fr, fq * 8);
#define PG8_SA(b, h) (((b) * 2 + (h)) * HTB)
#define PG8_SB(b, h) ((4 + (b) * 2 + (h)) * HTB)
#define PG8_STAGE(bufoff, gbase, voff) do { _Pragma("unroll") for (int _i = 0; _i < 2; ++_i) \
        __builtin_amdgcn_global_load_lds((const unsigned*)((const char*)(gbase) + (voff)[_i]), (LAS unsigned*)(lds + (bufoff) + ldsw + _i * 8192), 16, 0, 0); } while (0)
#define PG8_LDA(dst, b, h) do { _Pragma("unroll") for (int m = 0; m < 4; ++m) _Pragma("unroll") for (int k = 0; k < 2; ++k) dst[m][k] = *(const LAS bf16x8*)(lds + PG8_SA(b, h) + aoff + m * 2048 + k * 1024); } while (0)
#define PG8_LDB(dst, b, h) do { _Pragma("unroll") for (int n = 0; n < 2; ++n) _Pragma("unroll") for (int k = 0; k < 2; ++k) dst[n][k] = *(const LAS bf16x8*)(lds + PG8_SB(b, h) + boff + n * 2048 + k * 1024); } while (0)
#define PG8_MMA(ai, bj, At, Bt) do { __builtin_amdgcn_s_setprio(1); _Pragma("unroll") for (int m = 0; m < 4; ++m) _Pragma("unroll") for (int n = 0; n < 2; ++n) _Pragma("unroll") for (int k = 0; k < 2; ++k) \
        acc[ai][bj][m][n] = __builtin_amdgcn_mfma_f32_16x16x32_bf16(Bt[n][k], At[m][k], acc[ai][bj][m][n], 0, 0, 0); __builtin_amdgcn_s_setprio(0); } while (0)
#define PG8_WAIT_V(n) asm volatile("s_waitcnt vmcnt(" #n ")" ::: "memory")
#define PG8_WAIT_L(n) asm volatile("s_waitcnt lgkmcnt(" #n ")" ::: "memory")
#define PG8_BAR __builtin_amdgcn_s_barrier()
#define PG8_SCHED __builtin_amdgcn_sched_barrier(0)
    Unit cur, nxt; int ui = 0;
    if (!S.next(0, cur)) return;
    f32x4 acc[2][2][4][2];
#pragma unroll
    for (int a = 0; a < 2; ++a)
#pragma unroll
        for (int b = 0; b < 2; ++b)
#pragma unroll
            for (int m = 0; m < 4; ++m)
#pragma unroll
                for (int n = 0; n < 2; ++n) acc[a][b][m][n] = (f32x4){0.f, 0.f, 0.f, 0.f};
    bf16x8 At[4][2], B0[2][2], B1[2][2];
    const char* cA = cur.A; const char* cB = cur.B;
    PG8_STAGE(PG8_SB(0, 0), cB, voffB); PG8_STAGE(PG8_SB(0, 1), cB + hstepB, voffB); PG8_STAGE(PG8_SA(0, 0), cA, voffA); PG8_STAGE(PG8_SA(0, 1), cA + hstepA, voffA);
    if (wr == 1) PG8_BAR;
    PG8_WAIT_V(2); PG8_BAR;
    PG8_STAGE(PG8_SB(1, 0), cB + kstep, voffB); PG8_STAGE(PG8_SA(1, 0), cA + kstep, voffA); PG8_STAGE(PG8_SB(1, 1), cB + hstepB + kstep, voffB);
    PG8_WAIT_V(6); PG8_BAR;
    for (;;) {
        const bool has_next = S.next(ui + 1, nxt);
        const char* nA = has_next ? nxt.A : cA; const char* nB = has_next ? nxt.B : cB;
        for (int t = 0; t < nt; t += 2) {
            const bool last = (t == nt - 2);
            const char* a1 = cA + (size_t)(t + 1) * kstep;
            const char* a2 = last ? nA : cA + (size_t)(t + 2) * kstep; const char* b2 = last ? nB : cB + (size_t)(t + 2) * kstep;
            const char* a3 = a2 + kstep; const char* b3 = b2 + kstep;
            PG8_LDB(B0, 0, 0); PG8_LDB(B1, 0, 1); PG8_SCHED; PG8_LDA(At, 0, 0); PG8_STAGE(PG8_SA(1, 1), a1 + hstepA, voffA);
            PG8_WAIT_V(8); PG8_WAIT_L(0); PG8_BAR; PG8_MMA(0, 0, At, B0); PG8_MMA(0, 1, At, B1); PG8_BAR; PG8_SCHED;
            PG8_LDA(At, 0, 1); PG8_STAGE(PG8_SB(0, 0), b2, voffB); PG8_STAGE(PG8_SB(0, 1), b2 + hstepB, voffB); PG8_STAGE(PG8_SA(0, 0), a2, voffA);
            PG8_WAIT_V(8); PG8_WAIT_L(0); PG8_BAR; PG8_MMA(1, 0, At, B0); PG8_MMA(1, 1, At, B1); PG8_BAR; PG8_SCHED;
            PG8_LDB(B0, 1, 0); PG8_LDB(B1, 1, 1); PG8_SCHED; PG8_LDA(At, 1, 0); PG8_STAGE(PG8_SA(0, 1), a2 + hstepA, voffA);
            PG8_WAIT_V(8); PG8_WAIT_L(0); PG8_BAR; PG8_MMA(0, 0, At, B0); PG8_MMA(0, 1, At, B1); PG8_BAR; PG8_SCHED;
            PG8_LDA(At, 1, 1); PG8_STAGE(PG8_SB(1, 0), b3, voffB); PG8_STAGE(PG8_SB(1, 1), b3 + hstepB, voffB); PG8_STAGE(PG8_SA(1, 0), a3, voffA);
            PG8_WAIT_V(8); PG8_WAIT_L(0); PG8_BAR; PG8_MMA(1, 0, At, B0); PG8_MMA(1, 1, At, B1); PG8_BAR; PG8_SCHED;
        }
        if (wr == 0) PG8_BAR;
        E(acc, cur, wr, wc, fr, fq);
        if (!has_next) break;
#pragma unroll
        for (int a = 0; a < 2; ++a)
#pragma unroll
            for (int b = 0; b < 2; ++b)
#pragma unroll
                for (int m = 0; m < 4; ++m)
#pragma unroll
                    for (int n = 0; n < 2; ++n) acc[a][b][m][n] = (f32x4){0.f, 0.f, 0.f, 0.f};
        cur = nxt; cA = nA; cB = nB; ++ui;
        if (wr == 1) PG8_BAR;
    }
    PG8_WAIT_V(0);
    PG8_BAR;
#undef PG8_SA
#undef PG8_SB
#undef PG8_STAGE
#undef PG8_LDA
#undef PG8_LDB
#undef PG8_MMA
#undef PG8_WAIT_V
#undef PG8_WAIT_L
#undef PG8_BAR
#undef PG8_SCHED
}
}
using pg8::Unit;
typedef const f32x4 (&AccRef)[2][2][4][2];

__device__ __forceinline__ u32x4 pack8(f32x4 v0, f32x4 v1) { u32x4 w; w.x = cvt_pk_bf16(v0[0], v0[1]); w.y = cvt_pk_bf16(v0[2], v0[3]); w.z = cvt_pk_bf16(v1[0], v1[1]); w.w = cvt_pk_bf16(v1[2], v1[3]); return w; }
__device__ __forceinline__ f32x4 gelu4(f32x4 v) { return (f32x4){gelu_tanh(v[0]), gelu_tanh(v[1]), gelu_tanh(v[2]), gelu_tanh(v[3])}; }

struct EpiWin { static constexpr bool PERM = true; bf16_t* zina; bf16_t* ucat;
    __device__ __forceinline__ void operator()(AccRef acc, const Unit& u, int wr, int wc, int fr, int fq) const {
        const int row0 = u.pm * 256 + wr * 64 + fr;
        if (u.pn < 6) {
            const int col0 = u.pn * 256 + wc * 32 + 8 * fq;
#pragma unroll
            for (int ai = 0; ai < 2; ++ai)
#pragma unroll
                for (int m = 0; m < 4; ++m) { bf16_t* rowp = zina + (size_t)(row0 + ai * 128 + m * 16) * 1536 + col0;
#pragma unroll
                    for (int bj = 0; bj < 2; ++bj) *(u32x4*)(rowp + bj * 128) = pack8(gelu4(acc[ai][bj][m][0]), gelu4(acc[ai][bj][m][1])); }
        } else {
            const int cc0 = (u.pn - 6) * 256 + wc * 32 + 8 * fq;
#pragma unroll
            for (int ai = 0; ai < 2; ++ai)
#pragma unroll
                for (int m = 0; m < 4; ++m) { const int t = row0 + ai * 128 + m * 16, n = t >> 5, j = t & 31;
#pragma unroll
                    for (int bj = 0; bj < 2; ++bj) { const int cc = cc0 + bj * 128, g = cc >> 4, c0 = cc & 15;
                        *(u32x4*)(ucat + ((size_t)(g * 768 + n) * 768 + j * 16 + c0)) = pack8(acc[ai][bj][m][0], acc[ai][bj][m][1]); } }
        }
    } };
struct EpiZft { static constexpr bool PERM = true; bf16_t* zft;
    __device__ __forceinline__ void operator()(AccRef acc, const Unit& u, int wr, int wc, int fr, int fq) const {
        const int row0 = u.pm * 256 + wr * 64 + fr, t0 = u.pn * 256 + wc * 32 + 8 * fq;
#pragma unroll
        for (int ai = 0; ai < 2; ++ai)
#pragma unroll
            for (int m = 0; m < 4; ++m) { const int r = row0 + ai * 128 + m * 16, ri = r >> 9, gc = r & 511;
#pragma unroll
                for (int bj = 0; bj < 2; ++bj) { const int t = t0 + bj * 128, b = t >> 12, n = t & 4095;
                    *(u32x4*)(zft + ((size_t)(gc * 6 + b) * 8192 + ri * 4096 + n)) = pack8(acc[ai][bj][m][0], acc[ai][bj][m][1]); } }
    } };
struct EpiFour { static constexpr bool PERM = true; bf16_t* y;
    __device__ __forceinline__ void operator()(AccRef acc, const Unit& u, int wr, int wc, int fr, int fq) const {
        const int row0 = u.grp * 4096 + u.pm * 256 + wr * 64 + fr, col0 = 768 + u.pn * 256 + wc * 32 + 8 * fq;
#pragma unroll
        for (int ai = 0; ai < 2; ++ai)
#pragma unroll
            for (int m = 0; m < 4; ++m) { bf16_t* rowp = y + (size_t)(row0 + ai * 128 + m * 16) * 2048 + col0;
#pragma unroll
                for (int bj = 0; bj < 2; ++bj) *(u32x4*)(rowp + bj * 128) = pack8(acc[ai][bj][m][0], acc[ai][bj][m][1]); }
    } };
struct EpiXs { static constexpr bool PERM = false; float* xs;
    __device__ __forceinline__ void operator()(AccRef acc, const Unit& u, int wr, int wc, int fr, int fq) const {
        const int row0 = u.pm * 256 + wr * 64 + fr, col0 = wc * 32 + 4 * fq;
#pragma unroll
        for (int ai = 0; ai < 2; ++ai)
#pragma unroll
            for (int m = 0; m < 4; ++m) { float* rowp = xs + ((size_t)u.grp * 768 + row0 + ai * 128 + m * 16) * 256 + col0;
#pragma unroll
                for (int bj = 0; bj < 2; ++bj)
#pragma unroll
                    for (int n = 0; n < 2; ++n) *(f32x4*)(rowp + bj * 128 + n * 16) = acc[ai][bj][m][n]; }
    } };
struct EpiYc { static constexpr bool PERM = true; bf16_t* ycpre;
    __device__ __forceinline__ void operator()(AccRef acc, const Unit& u, int wr, int wc, int fr, int fq) const {
        const int row0 = u.pm * 256 + wr * 64 + fr, col0 = u.pn * 256 + wc * 32 + 8 * fq;
#pragma unroll
        for (int ai = 0; ai < 2; ++ai)
#pragma unroll
            for (int m = 0; m < 4; ++m) { const int n = row0 + ai * 128 + m * 16;
#pragma unroll
                for (int bj = 0; bj < 2; ++bj) { const int col = col0 + bj * 128, i = col >> 4, c0 = col & 15;
                    *(u32x4*)(ycpre + ((size_t)(n * 32 + i) * 768 + u.grp * 16 + c0)) = pack8(gelu4(acc[ai][bj][m][0]), gelu4(acc[ai][bj][m][1])); } }
    } };
struct EpiGlu { static constexpr bool PERM = true; const bf16_t* ycpre; const float* bias; bf16_t* y;
    __device__ __forceinline__ void operator()(AccRef acc, const Unit& u, int wr, int wc, int fr, int fq) const {
        const int row0 = u.pm * 256 + wr * 64 + fr, col0 = u.pn * 256 + wc * 32 + 8 * fq;
        f32x4 bv[2][2];
#pragma unroll
        for (int bj = 0; bj < 2; ++bj)
#pragma unroll
            for (int n = 0; n < 2; ++n) bv[bj][n] = *(const f32x4*)(bias + col0 + bj * 128 + 4 * n);
#pragma unroll
        for (int ai = 0; ai < 2; ++ai)
#pragma unroll
            for (int m = 0; m < 4; ++m) { const size_t t = (size_t)(row0 + ai * 128 + m * 16);
#pragma unroll
                for (int bj = 0; bj < 2; ++bj) { const int col = col0 + bj * 128;
                    const u32x4 yc = *(const u32x4*)(ycpre + t * 768 + col);
                    const f32x4 v0 = acc[ai][bj][m][0] + bv[bj][0], v1 = acc[ai][bj][m][1] + bv[bj][1];
                    const f32x4 o0 = (f32x4){bf_lo(yc.x) * sigmoid_f(v0[0]), bf_hi(yc.x) * sigmoid_f(v0[1]), bf_lo(yc.y) * sigmoid_f(v0[2]), bf_hi(yc.y) * sigmoid_f(v0[3])};
                    const f32x4 o1 = (f32x4){bf_lo(yc.z) * sigmoid_f(v1[0]), bf_hi(yc.z) * sigmoid_f(v1[1]), bf_lo(yc.w) * sigmoid_f(v1[2]), bf_hi(yc.w) * sigmoid_f(v1[3])};
                    *(u32x4*)(y + t * 2048 + 1280 + col) = pack8(o0, o1); } }
    } };
struct EpiRes { static constexpr bool PERM = false; float* x;
    __device__ __forceinline__ void operator()(AccRef acc, const Unit& u, int wr, int wc, int fr, int fq) const {
        const int row0 = u.pm * 256 + wr * 64 + fr, col0 = u.pn * 256 + wc * 32 + 4 * fq;
#pragma unroll
        for (int ai = 0; ai < 2; ++ai)
#pragma unroll
            for (int m = 0; m < 4; ++m) { float* rowp = x + (size_t)(row0 + ai * 128 + m * 16) * 2048 + col0;
#pragma unroll
                for (int bj = 0; bj < 2; ++bj)
#pragma unroll
                    for (int n = 0; n < 2; ++n) { float* p = rowp + bj * 128 + n * 16; *(f32x4*)p = *(const f32x4*)p + acc[ai][bj][m][n]; }
                asm volatile("" ::: "memory"); }
    } };
struct EpiSwi { static constexpr bool PERM = true; bf16_t* hid;
    __device__ __forceinline__ void operator()(AccRef acc, const Unit& u, int wr, int wc, int fr, int fq) const {
        const int row0 = u.pm * 256 + wr * 64 + fr, col0 = u.pn * 128 + wc * 32 + 8 * fq;
#pragma unroll
        for (int ai = 0; ai < 2; ++ai)
#pragma unroll
            for (int m = 0; m < 4; ++m) {
                f32x4 o[2];
#pragma unroll
                for (int n = 0; n < 2; ++n) { const f32x4 g = acc[ai][0][m][n], up = acc[ai][1][m][n];
                    o[n] = (f32x4){g[0] * sigmoid_f(g[0]) * up[0], g[1] * sigmoid_f(g[1]) * up[1], g[2] * sigmoid_f(g[2]) * up[2], g[3] * sigmoid_f(g[3]) * up[3]}; }
                *(u32x4*)(hid + (size_t)(row0 + ai * 128 + m * 16) * 5632 + col0) = pack8(o[0], o[1]); }
    } };

struct TrDesc { const float* src; int ldsrc, K, c0, nc; bf16_t* dst; int mode, doff; };
__device__ __forceinline__ void transpose_tile(LAS unsigned char* lds, const TrDesc& d, int tile) {
    const int tid = tid_l(), nkt = d.K >> 6, kt = tile % nkt, ct = tile / nkt;
    { const int k = tid >> 3, n8 = (tid & 7) * 8;
      const float* s = d.src + (size_t)(kt * 64 + k) * d.ldsrc + d.c0 + ct * 64 + n8;
      const f32x4 v0 = *(const f32x4*)s, v1 = *(const f32x4*)(s + 4);
      LAS bf16_t* tl = (LAS bf16_t*)lds;
#pragma unroll
      for (int j = 0; j < 4; ++j) { tl[(n8 + j) * 66 + k] = f2bf(v0[j]); tl[(n8 + 4 + j) * 66 + k] = f2bf(v1[j]); } }
    __syncthreads();
    { const int n = tid >> 3, k8 = (tid & 7) * 8;
      const LAS unsigned* p = (const LAS unsigned*)((LAS bf16_t*)lds + n * 66 + k8);
      u32x4 w; w.x = p[0]; w.y = p[1]; w.z = p[2]; w.w = p[3];
      const int cc = ct * 64 + n;
      const int drow = d.mode == 0 ? d.doff + cc : ((cc >> 7) * 256 + (cc & 127) + (d.mode == 2 ? 128 : 0));
      *(u32x4*)(d.dst + (size_t)drow * d.K + kt * 64 + k8) = w; }
    __syncthreads();
}

__device__ __forceinline__ double kd(double c) { asm volatile("" : "+v"(c)); return c; }
__device__ __forceinline__ double exp_d(double x) {
    const double y = x * 0.125; double term = 1.0, sum = 1.0;
#pragma unroll 1
    for (int n = 1; n <= 22; ++n) { term *= y / (double)n; sum += term; }
    sum *= sum; sum *= sum; sum *= sum; return sum;
}
__device__ __forceinline__ void sincos_d(double x, double& s, double& c) {
    const double k = rint(x * kd(0.15915494309189535));
    double r = fma(-k, kd(6.283185307179586232), x); r = fma(-k, kd(2.4492935982947064e-16), r);
    const double y = r * 0.125, my2 = -(y * y);
    double sn = y, cs = 1.0, ts = y, tc = 1.0;
#pragma unroll 1
    for (int n = 1; n <= 10; ++n) { tc *= my2 / (double)((2 * n - 1) * (2 * n)); cs += tc; ts *= my2 / (double)((2 * n) * (2 * n + 1)); sn += ts; }
#pragma unroll 1
    for (int i = 0; i < 3; ++i) { const double c2 = cs * cs - sn * sn, s2 = 2.0 * sn * cs; cs = c2; sn = s2; }
    s = sn; c = cs;
}

__device__ __forceinline__ void s5_prep_group(LAS unsigned char* lds, const Args& a, int l, int g) {
    const int tid = tid_l();
    LAS float* apw = (LAS float*)lds;
    LAS float* bbr = apw + 2 * 33 * 64 * 2;
    LAS float* ccx = bbr + 2 * 64 * 16 * 2;
    LAS float* kt  = ccx + 16 * 64 * 2;
    bf16_t* TEp = (bf16_t*)(a.ws + WS_TE); bf16_t* GMp = (bf16_t*)(a.ws + WS_GM); float* ALp = (float*)(a.ws + WS_AL);
    if (tid < 128) {
        const int dir = tid >> 6, p = tid & 63;
        const double lr = (double)a.in[7][((l * 2 + dir) * 48 + g) * 64 + p], li = (double)a.in[8][((l * 2 + dir) * 48 + g) * 64 + p];
        const double st = exp_d((double)a.in[9][(l * 2 + dir) * 48 + g]);
        const double mag = exp_d(lr * st); double sn, cs; sincos_d(li * st, sn, cs);
        const double ar = mag * cs, ai = mag * sn, den = lr * lr + li * li, nr = ar - 1.0;
        const double qr = (nr * lr + ai * li) / den, qi = (ai * lr - nr * li) / den;
        double pr = 1.0, pi = 0.0;
        for (int tau = 0; tau <= 32; ++tau) { apw[((dir * 33 + tau) * 64 + p) * 2] = (float)pr; apw[((dir * 33 + tau) * 64 + p) * 2 + 1] = (float)pi;
            const double nr2 = pr * ar - pi * ai, ni2 = pr * ai + pi * ar; pr = nr2; pi = ni2; }
        ALp[((g * 2 + dir) * 64 + p) * 2] = apw[((dir * 33 + 32) * 64 + p) * 2]; ALp[((g * 2 + dir) * 64 + p) * 2 + 1] = apw[((dir * 33 + 32) * 64 + p) * 2 + 1];
        for (int c = 0; c < 16; ++c) { const double br = (double)a.in[10][((l * 48 + g) * 64 + p) * 16 + c], bi = (double)a.in[11][((l * 48 + g) * 64 + p) * 16 + c];
            bbr[((dir * 64 + p) * 16 + c) * 2] = (float)(qr * br - qi * bi); bbr[((dir * 64 + p) * 16 + c) * 2 + 1] = (float)(qr * bi + qi * br); }
    }
    for (int idx = tid; idx < 1024; idx += NTHREADS) { const int c = idx >> 6, p = idx & 63;
        ccx[idx * 2] = a.in[12][((l * 48 + g) * 16 + c) * 64 + p]; ccx[idx * 2 + 1] = a.in[13][((l * 48 + g) * 16 + c) * 64 + p]; }
    __syncthreads();
    for (int o = tid; o < 16384; o += NTHREADS) { const int dir = o >> 13, tau = (o >> 8) & 31, c = (o >> 4) & 15, c2 = o & 15;
        float s = 0.f;
        for (int p = 0; p < 64; ++p) { const float Cr = ccx[(c * 64 + p) * 2], Ci = ccx[(c * 64 + p) * 2 + 1];
            const float wr_ = apw[((dir * 33 + tau) * 64 + p) * 2], wi_ = apw[((dir * 33 + tau) * 64 + p) * 2 + 1];
            const float cwr = Cr * wr_ - Ci * wi_, cwi = Cr * wi_ + Ci * wr_;
            const float Br = bbr[((dir * 64 + p) * 16 + c2) * 2], Bi = bbr[((dir * 64 + p) * 16 + c2) * 2 + 1];
            s += cwr * Br - cwi * Bi; }
        kt[o] = s; }
    __syncthreads();
    {
        const int i = tid >> 4, c = tid & 15;
        bf16_t* rowp = TEp + ((size_t)g * 512 + tid) * 768;
        const float dsk = a.in[14][l * 768 + g * 16 + c];
        for (int j = 0; j < 32; ++j) {
            float v[16];
            if (j < i) {
#pragma unroll
                for (int c2 = 0; c2 < 16; ++c2) v[c2] = kt[(((i - j)) * 16 + c) * 16 + c2];
            } else if (j > i) {
#pragma unroll
                for (int c2 = 0; c2 < 16; ++c2) v[c2] = kt[((32 + (j - i)) * 16 + c) * 16 + c2];
            } else {
#pragma unroll
                for (int c2 = 0; c2 < 16; ++c2) v[c2] = kt[(c) * 16 + c2] + kt[((32) * 16 + c) * 16 + c2] + (c2 == c ? dsk : 0.f);
            }
            u32x4 w0, w1; w0.x = cvt_pk_bf16(v[0], v[1]); w0.y = cvt_pk_bf16(v[2], v[3]); w0.z = cvt_pk_bf16(v[4], v[5]); w0.w = cvt_pk_bf16(v[6], v[7]);
            w1.x = cvt_pk_bf16(v[8], v[9]); w1.y = cvt_pk_bf16(v[10], v[11]); w1.z = cvt_pk_bf16(v[12], v[13]); w1.w = cvt_pk_bf16(v[14], v[15]);
            *(u32x4*)(rowp + j * 16) = w0; *(u32x4*)(rowp + j * 16 + 8) = w1;
        }
        for (int dir = 0; dir < 2; ++dir) { const int e = dir == 0 ? i + 1 : 32 - i;
            for (int p4 = 0; p4 < 64; p4 += 4) { unsigned w[4];
#pragma unroll
                for (int q = 0; q < 4; ++q) { const int p = p4 + q; const float Cr = ccx[(c * 64 + p) * 2], Ci = ccx[(c * 64 + p) * 2 + 1];
                    const float wr_ = apw[((dir * 33 + e) * 64 + p) * 2], wi_ = apw[((dir * 33 + e) * 64 + p) * 2 + 1];
                    w[q] = cvt_pk_bf16(Cr * wr_ - Ci * wi_, -(Cr * wi_ + Ci * wr_)); }
                u32x4 ww; ww.x = w[0]; ww.y = w[1]; ww.z = w[2]; ww.w = w[3];
                *(u32x4*)(rowp + 512 + dir * 128 + p4 * 2) = ww; } }
    }
    {
        const int row = tid >> 1, half = tid & 1, dir = row >> 7, p = (row >> 1) & 63, ri = row & 1;
        bf16_t* rowp = GMp + ((size_t)g * 256 + row) * 512;
        for (int jj = 0; jj < 16; ++jj) { const int j = half * 16 + jj, e = dir == 0 ? 31 - j : j;
            const float wr_ = apw[((dir * 33 + e) * 64 + p) * 2], wi_ = apw[((dir * 33 + e) * 64 + p) * 2 + 1];
            float v[16];
#pragma unroll
            for (int c2 = 0; c2 < 16; ++c2) { const float Br = bbr[((dir * 64 + p) * 16 + c2) * 2], Bi = bbr[((dir * 64 + p) * 16 + c2) * 2 + 1];
                v[c2] = ri == 0 ? wr_ * Br - wi_ * Bi : wr_ * Bi + wi_ * Br; }
            u32x4 w0, w1; w0.x = cvt_pk_bf16(v[0], v[1]); w0.y = cvt_pk_bf16(v[2], v[3]); w0.z = cvt_pk_bf16(v[4], v[5]); w0.w = cvt_pk_bf16(v[6], v[7]);
            w1.x = cvt_pk_bf16(v[8], v[9]); w1.y = cvt_pk_bf16(v[10], v[11]); w1.z = cvt_pk_bf16(v[12], v[13]); w1.w = cvt_pk_bf16(v[14], v[15]);
            *(u32x4*)(rowp + j * 16) = w0; *(u32x4*)(rowp + j * 16 + 8) = w1; }
    }
    __syncthreads();
}

__device__ __forceinline__ void winbf_task(LAS unsigned char* lds, const float* w_in_l, bf16_t* dst, int task) {
    const int tid = tid_l(), g = task & 3, k0 = (task >> 2) * 64;
    LAS float* Wt = (LAS float*)lds;
    LAS float* tc = Wt + 64 * 128; LAS float* ts = tc + 128;
    { const int k = tid >> 3, c16 = (tid & 7) * 16; const float* s = w_in_l + (size_t)(k0 + k) * INW + 1536 + g * 128 + c16;
#pragma unroll
      for (int q = 0; q < 4; ++q) *(LAS f32x4*)(Wt + k * 128 + c16 + q * 4) = *(const f32x4*)(s + q * 4); }
    if (tid < 128) { float sn, cs; sincospif((float)tid * (1.0f / 64.0f), &sn, &cs); tc[tid] = cs; ts[tid] = sn; }
    __syncthreads();
    const int cp = tid & 127, kq = tid >> 7;
    float aC[16], aS[16];
#pragma unroll
    for (int kk = 0; kk < 16; ++kk) { aC[kk] = 0.f; aS[kk] = 0.f; }
    for (int c = 0; c < 128; ++c) { const int idx = (c * cp) & 127; const float vc = tc[idx], vs = ts[idx];
#pragma unroll
        for (int kk = 0; kk < 16; ++kk) { const float w = Wt[(kq * 16 + kk) * 128 + c]; aC[kk] += w * vc; aS[kk] += w * vs; } }
    bf16_t* dc = dst + (size_t)(g * 128 + cp) * 2048 + k0 + kq * 16; bf16_t* ds = dst + (size_t)(512 + g * 128 + cp) * 2048 + k0 + kq * 16;
    u32x4 w; w.x = cvt_pk_bf16(aC[0], aC[1]); w.y = cvt_pk_bf16(aC[2], aC[3]); w.z = cvt_pk_bf16(aC[4], aC[5]); w.w = cvt_pk_bf16(aC[6], aC[7]); *(u32x4*)dc = w;
    w.x = cvt_pk_bf16(aC[8], aC[9]); w.y = cvt_pk_bf16(aC[10], aC[11]); w.z = cvt_pk_bf16(aC[12], aC[13]); w.w = cvt_pk_bf16(aC[14], aC[15]); *(u32x4*)(dc + 8) = w;
    w.x = cvt_pk_bf16(aS[0], aS[1]); w.y = cvt_pk_bf16(aS[2], aS[3]); w.z = cvt_pk_bf16(aS[4], aS[5]); w.w = cvt_pk_bf16(aS[6], aS[7]); *(u32x4*)ds = w;
    w.x = cvt_pk_bf16(aS[8], aS[9]); w.y = cvt_pk_bf16(aS[10], aS[11]); w.z = cvt_pk_bf16(aS[12], aS[13]); w.w = cvt_pk_bf16(aS[14], aS[15]); *(u32x4*)(ds + 8) = w;
    __syncthreads();
}

__device__ __forceinline__ void dft_gen(LAS unsigned char* lds, bf16_t* dft, int bx, int G) {
    const int tid = tid_l();
    LAS float* tab = (LAS float*)lds;
    for (int i = tid; i < 4096; i += NTHREADS) tab[i] = cospif((float)i * (1.0f / 2048.0f)) * 0.0013810679320049757f;
    __syncthreads();
    for (int k = bx; k < 4096; k += G)
        for (int e8 = tid; e8 < 1024; e8 += NTHREADS) { const int col8 = e8 * 8, ri = col8 >> 12, n0 = col8 & 4095; float v[8];
#pragma unroll
            for (int j = 0; j < 8; ++j) { const int idx = (k * (n0 + j)) & 4095; v[j] = ri == 0 ? tab[idx] : -tab[(idx - 1024) & 4095]; }
            u32x4 w; w.x = cvt_pk_bf16(v[0], v[1]); w.y = cvt_pk_bf16(v[2], v[3]); w.z = cvt_pk_bf16(v[4], v[5]); w.w = cvt_pk_bf16(v[6], v[7]);
            *(u32x4*)(dft + (size_t)k * 8192 + col8) = w; }
    __syncthreads();
}

template <int MODE>
__device__ __forceinline__ void rms_rows(const float* xp, const float* xs, float* xres, const float* gain, bf16_t* outb, int bx, int G) {
    const int tid = tid_l(), lane = tid & 63, wave = tid >> 6;
    f32x4 gv[8];
#pragma unroll
    for (int it = 0; it < 8; ++it) gv[it] = *(const f32x4*)(gain + it * 256 + lane * 4);
    for (int row = bx * 8 + wave; row < T; row += G * 8) {
        const float* src = MODE == 0 ? (row < 16384 ? xp + (size_t)row * 2048 : xs + (size_t)(row - 16384) * 2048) : xres + (size_t)row * 2048;
        f32x4 v[8]; float ss = 0.f;
#pragma unroll
        for (int it = 0; it < 8; ++it) { v[it] = *(const f32x4*)(src + it * 256 + lane * 4); ss += v[it][0] * v[it][0] + v[it][1] * v[it][1] + v[it][2] * v[it][2] + v[it][3] * v[it][3]; }
        ss = wave_sum(ss);
        const float r = 1.0f / sqrtf(ss * (1.0f / 2048.0f) + EPS);
#pragma unroll
        for (int it = 0; it < 8; ++it) {
            const f32x4 o = v[it] * r * gv[it];
            if (MODE == 0) *(f32x4*)(xres + (size_t)row * 2048 + it * 256 + lane * 4) = v[it];
            if (MODE == 2) *(f32x4*)(xres + (size_t)row * 2048 + it * 256 + lane * 4) = o;
            else { u32x2 w; w.x = cvt_pk_bf16(o[0], o[1]); w.y = cvt_pk_bf16(o[2], o[3]); *(u32x2*)(outb + (size_t)row * 2048 + it * 256 + lane * 4) = w; }
        }
    }
}

__device__ __forceinline__ void outnorm_rows(bf16_t* y, const float* og, int bx, int G) {
    const int tid = tid_l(), lane = tid & 63, wave = tid >> 6;
    for (int row = bx * 8 + wave; row < T; row += G * 8) {
        bf16_t* rp = y + (size_t)row * 2048;
        u32x4 w[4]; float ss[3] = {0.f, 0.f, 0.f};
#pragma unroll
        for (int it = 0; it < 4; ++it) { const int ch = it * 64 + lane; w[it] = *(const u32x4*)(rp + ch * 8);
            float s = 0.f;
#pragma unroll
            for (int q = 0; q < 4; ++q) { const float a0 = bf_lo(w[it][q]), a1 = bf_hi(w[it][q]); s += a0 * a0 + a1 * a1; }
            const int seg = ch < 96 ? 0 : (ch < 160 ? 1 : 2);
            ss[0] += seg == 0 ? s : 0.f; ss[1] += seg == 1 ? s : 0.f; ss[2] += seg == 2 ? s : 0.f; }
        ss[0] = wave_sum(ss[0]); ss[1] = wave_sum(ss[1]); ss[2] = wave_sum(ss[2]);
        const float r0 = 1.0f / sqrtf(ss[0] * (1.0f / 768.0f) + EPS), r1 = 1.0f / sqrtf(ss[1] * (1.0f / 512.0f) + EPS), r2 = 1.0f / sqrtf(ss[2] * (1.0f / 768.0f) + EPS);
#pragma unroll
        for (int it = 0; it < 4; ++it) { const int ch = it * 64 + lane; const float r = ch < 96 ? r0 : (ch < 160 ? r1 : r2);
            const f32x4 g0 = *(const f32x4*)(og + ch * 8), g1 = *(const f32x4*)(og + ch * 8 + 4);
            u32x4 o; o.x = cvt_pk_bf16(bf_lo(w[it].x) * r * g0[0], bf_hi(w[it].x) * r * g0[1]); o.y = cvt_pk_bf16(bf_lo(w[it].y) * r * g0[2], bf_hi(w[it].y) * r * g0[3]);
            o.z = cvt_pk_bf16(bf_lo(w[it].z) * r * g1[0], bf_hi(w[it].z) * r * g1[1]); o.w = cvt_pk_bf16(bf_lo(w[it].w) * r * g1[2], bf_hi(w[it].w) * r * g1[3]);
            *(u32x4*)(rp + ch * 8) = o; }
    }
}

__device__ __forceinline__ void gmlp_task(LAS unsigned char* lds, const bf16_t* zina, const bf16_t* wsb, const float* vg, const float* bs, bf16_t* y, int task) {
    const int tid = tid_l(), lane = tid & 63, wid = tid >> 6, fr = lane & 15, fq = lane >> 4;
    const int cidx = task / 6, h = task - cidx * 6, t0 = cidx * 128;
    LAS bf16_t* vT = (LAS bf16_t*)lds;
    { const int k = tid >> 2, dq = (tid & 3) * 32;
      const bf16_t* src = zina + (size_t)(t0 + k) * 1536 + 768 + h * 128 + dq;
      u32x4 w[4]; float ss = 0.f;
#pragma unroll
      for (int q = 0; q < 4; ++q) { w[q] = *(const u32x4*)(src + q * 8);
#pragma unroll
          for (int e = 0; e < 4; ++e) { const float a0 = bf_lo(w[q][e]), a1 = bf_hi(w[q][e]); ss += a0 * a0 + a1 * a1; } }
      ss += __shfl_xor(ss, 1); ss += __shfl_xor(ss, 2);
      const float r = 1.0f / sqrtf(ss * (1.0f / 128.0f) + EPS);
#pragma unroll
      for (int q = 0; q < 4; ++q)
#pragma unroll
          for (int e = 0; e < 4; ++e) { const int d = dq + q * 8 + e * 2;
              vT[d * 136 + k] = f2bf(bf_lo(w[q][e]) * r * vg[h * 128 + d]); vT[(d + 1) * 136 + k] = f2bf(bf_hi(w[q][e]) * r * vg[h * 128 + d + 1]); } }
    __syncthreads();
    const int q0 = (wid >> 1) * 32, d0 = (wid & 1) * 64;
    f32x4 acc[2][4];
#pragma unroll
    for (int mq = 0; mq < 2; ++mq)
#pragma unroll
        for (int nd = 0; nd < 4; ++nd) acc[mq][nd] = (f32x4){0.f, 0.f, 0.f, 0.f};
#pragma unroll
    for (int ks = 0; ks < 4; ++ks) {
        bf16x8 af[2], bfr[4];
#pragma unroll
        for (int mq = 0; mq < 2; ++mq) af[mq] = *(const bf16x8*)(wsb + (size_t)(h * 128 + q0 + mq * 16 + fr) * 128 + ks * 32 + fq * 8);
#pragma unroll
        for (int nd = 0; nd < 4; ++nd) bfr[nd] = *(const LAS bf16x8*)(vT + (d0 + nd * 16 + fr) * 136 + ks * 32 + fq * 8);
#pragma unroll
        for (int mq = 0; mq < 2; ++mq)
#pragma unroll
            for (int nd = 0; nd < 4; ++nd) acc[mq][nd] = __builtin_amdgcn_mfma_f32_16x16x32_bf16(bfr[nd], af[mq], acc[mq][nd], 0, 0, 0);
    }
#pragma unroll
    for (int mq = 0; mq < 2; ++mq) { const int q = q0 + mq * 16 + fr; const float b = bs[h * 128 + q];
#pragma unroll
        for (int nd = 0; nd < 4; ++nd) { const int d = d0 + nd * 16 + 4 * fq;
            const u32x2 uu = *(const u32x2*)(zina + (size_t)(t0 + q) * 1536 + h * 128 + d);
            const f32x4 m = acc[mq][nd] + b;
            u32x2 o; o.x = cvt_pk_bf16(bf_lo(uu.x) * m[0], bf_hi(uu.x) * m[1]); o.y = cvt_pk_bf16(bf_lo(uu.y) * m[2], bf_hi(uu.y) * m[3]);
            *(u32x2*)(y + (size_t)(t0 + q) * 2048 + h * 128 + d) = o; } }
    __syncthreads();
}

__device__ __forceinline__ void carry_scan(const float* xs, const float* ALp, bf16_t* ucat, int bx) {
    const int idx = bx * NTHREADS + tid_l();
    if (idx >= 48 * 6 * 128) return;
    const int p = idx & 63, dir = (idx >> 6) & 1, b = (idx >> 7) % 6, g = idx / 768;
    const f32x2 aL = *(const f32x2*)(ALp + ((g * 2 + dir) * 64 + p) * 2);
    float hr = 0.f, hi = 0.f;
#pragma unroll 8
    for (int s = 0; s < 128; ++s) { const int c = dir == 0 ? s : 127 - s; const size_t chunk = (size_t)g * 768 + b * 128 + c;
        const f32x2 x = *(const f32x2*)(xs + chunk * 256 + dir * 128 + p * 2);
        *(unsigned*)(ucat + chunk * 768 + 512 + dir * 128 + p * 2) = cvt_pk_bf16(hr, hi);
        const float nr = aL.x * hr - aL.y * hi + x.x, ni = aL.x * hi + aL.y * hr + x.y; hr = nr; hi = ni; }
}

constexpr int N_PHASES = 23;
__global__ void __launch_bounds__(NTHREADS, 2) mega_fwd(Args a) {
    extern __shared__ __attribute__((aligned(16))) unsigned char lds_raw[];
    LAS unsigned char* lds = (LAS unsigned char*)lds_raw;
    cg::grid_group grid = cg::this_grid();
#define WINAC ((bf16_t*)(ws + WS_WINAC))
#define WINBF ((bf16_t*)(ws + WS_WINBF))
#define WOUT  ((bf16_t*)(ws + WS_WOUT))
#define WGLU  ((bf16_t*)(ws + WS_WGLU))
#define WSB   ((bf16_t*)(ws + WS_WS))
#define WGU   ((bf16_t*)(ws + WS_WGU))
#define WDOWN ((bf16_t*)(ws + WS_WDOWN))
#define DFT   ((bf16_t*)(ws + WS_DFT))
#define AL    ((float*)(ws + WS_AL))
#define SLOT1 ((bf16_t*)(ws + WS_SLOT1))
#define ZINA  ((bf16_t*)(ws + WS_ZINA))
#define ZFT   ((bf16_t*)(ws + WS_ZFT))
#define YCPRE ((bf16_t*)(ws + WS_YCPRE))
#define UCAT  ((bf16_t*)(ws + WS_UCAT))
#define XS    ((float*)(ws + WS_XS))
#define TE    ((bf16_t*)(ws + WS_TE))
#define GM    ((bf16_t*)(ws + WS_GM))
#define HID   ((bf16_t*)(ws + WS_HID))
    int ph = 0;
#ifndef ONLY_PH
#define ONLY_PH -1
#endif
#define PH_BEGIN(k) if ((ONLY_PH < 0 || ONLY_PH == (k)) && ph >= a.ph_lo && ph < a.ph_hi) { unsigned char* ws = a.ws; float* X = a.out; int bx = blockIdx.x, G = gridDim.x; asm volatile("; PHASEMARK %4" : "+s"(ws), "+s"(X), "+s"(bx), "+s"(G) : "i"(k));
#define PH_END   if (ph + 1 < a.ph_hi) grid.sync(); } ++ph;

#pragma unroll 1
    for (int l = 0; l < 2; ++l) {
        PH_BEGIN(0)
            for (int g = bx; g < NGRP; g += G) s5_prep_group(lds, a, l, g);
            for (int t = bx; t < 128; t += G) winbf_task(lds, a.in[3] + (size_t)l * 2048 * INW, WINBF, t);
            if (l == 0) dft_gen(lds, DFT, bx, G);
            {
                const float* s = a.in[5] + (size_t)l * 6 * 128 * 128;
                for (int i = bx * NTHREADS + tid_l(); i < 6 * 128 * 128 / 2; i += G * NTHREADS) ((unsigned*)WSB)[i] = cvt_pk_bf16(s[2 * i], s[2 * i + 1]);
            }
            {
                const TrDesc td[7] = {
                    {a.in[3] + (size_t)l * 2048 * INW, INW, 2048, 0, 1536, WINAC, 0, 0},
                    {a.in[3] + (size_t)l * 2048 * INW, INW, 2048, 2048, 768, WINAC, 0, 1536},
                    {a.in[18] + (size_t)l * 2048 * 2048, 2048, 2048, 0, 2048, WOUT, 0, 0},
                    {a.in[15] + (size_t)l * 768 * 768, 768, 768, 0, 768, WGLU, 0, 0},
                    {a.in[20] + (size_t)l * 2048 * DFF, DFF, 2048, 0, DFF, WGU, 1, 0},
                    {a.in[21] + (size_t)l * 2048 * DFF, DFF, 2048, 0, DFF, WGU, 2, 0},
                    {a.in[22] + (size_t)l * DFF * 2048, 2048, DFF, 0, 2048, WDOWN, 0, 0}};
                const int ntile[7] = {32 * 24, 32 * 12, 32 * 32, 12 * 12, 32 * 88, 32 * 88, 88 * 32};
#pragma unroll
                for (int m = 0; m < 7; ++m) for (int t = bx; t < ntile[m]; t += G) transpose_tile(lds, td[m], t);
            }
            if (l == 0) rms_rows<0>(a.in[0], a.in[1], X, a.in[2], SLOT1, bx, G);
            else        rms_rows<1>(nullptr, nullptr, X, a.in[2] + l * 2048, SLOT1, bx, G);
        PH_END
        PH_BEGIN(1)
            { pg8::Sched S{(const char*)SLOT1, (const char*)WINAC, 0, 0, 2048, 2048, T / 256, 9, 1, G, bx}; EpiWin E{ZINA, UCAT}; pg8::gemm_phase(lds, S, 2048, E); }
            { pg8::Sched S{(const char*)WINBF, (const char*)SLOT1, 0, 0, 2048, 2048, 4, T / 256, 1, G, bx}; EpiZft E{ZFT}; pg8::gemm_phase(lds, S, 2048, E); }
        PH_END
        PH_BEGIN(2)
            const int nF = (G * 3) / 4, nR = G - nF;
            if (bx < nF) { pg8::Sched S{(const char*)DFT, (const char*)ZFT, 0, 8192 * 2, 8192, 49152, 16, 2, NBATCH, nF, bx}; EpiFour E{SLOT1}; pg8::gemm_phase(lds, S, 8192, E); }
            else {
                { pg8::Sched S{(const char*)UCAT, (const char*)GM, (long)768 * 768 * 2, (long)256 * 512 * 2, 768, 512, 3, 1, NGRP, nR, bx - nF}; EpiXs E{XS}; pg8::gemm_phase(lds, S, 512, E); }
                for (int t = bx - nF; t < 192 * 6; t += nR) gmlp_task(lds, ZINA, WSB, a.in[4] + l * 768, a.in[6] + l * 768, SLOT1, t);
            }
        PH_END
        PH_BEGIN(3)
            carry_scan(XS, AL, UCAT, bx);
        PH_END
        PH_BEGIN(4)
            { pg8::Sched S{(const char*)UCAT, (const char*)TE, (long)768 * 768 * 2, (long)512 * 768 * 2, 768, 768, 3, 2, NGRP, G, bx}; EpiYc E{YCPRE}; pg8::gemm_phase(lds, S, 768, E); }
        PH_END
        PH_BEGIN(5)
            { pg8::Sched S{(const char*)YCPRE, (const char*)WGLU, 0, 0, 768, 768, T / 256, 3, 1, G, bx}; EpiGlu E{YCPRE, a.in[16] + l * 768, SLOT1}; pg8::gemm_phase(lds, S, 768, E); }
        PH_END
        PH_BEGIN(6)
            outnorm_rows(SLOT1, a.in[17] + l * 2048, bx, G);
        PH_END
        PH_BEGIN(7)
            { pg8::Sched S{(const char*)SLOT1, (const char*)WOUT, 0, 0, 2048, 2048, T / 256, 8, 1, G, bx}; EpiRes E{X}; pg8::gemm_phase(lds, S, 2048, E); }
        PH_END
        PH_BEGIN(8)
            rms_rows<1>(nullptr, nullptr, X, a.in[19] + l * 2048, SLOT1, bx, G);
        PH_END
        PH_BEGIN(9)
            { pg8::Sched S{(const char*)SLOT1, (const char*)WGU, 0, 0, 2048, 2048, T / 256, 44, 1, G, bx}; EpiSwi E{HID}; pg8::gemm_phase(lds, S, 2048, E); }
        PH_END
        PH_BEGIN(10)
            { pg8::Sched S{(const char*)HID, (const char*)WDOWN, 0, 0, DFF, DFF, T / 256, 8, 1, G, bx}; EpiRes E{X}; pg8::gemm_phase(lds, S, DFF, E); }
        PH_END
    }
    PH_BEGIN(11)
        rms_rows<2>(nullptr, nullptr, X, a.in[23], nullptr, bx, G);
    PH_END
#undef PH_BEGIN
#undef PH_END
}

extern "C" void kernel_launch(void* const* d_in, const int* in_sizes, int n_in, void* d_out, int out_size, void* d_ws, size_t ws_size, hipStream_t stream) {
    static int grid = 0;
    if (grid == 0) {
        if (n_in != 24 || out_size != T * DM || ws_size < WS_END) { fprintf(stderr, "kernel_launch: unexpected shapes / workspace (n_in %d out %d ws %zu need %zu)\n", n_in, out_size, ws_size, (size_t)WS_END); grid = -1; return; }
        int dev = 0, cus = 0, per_cu = 0;
        if (hipGetDevice(&dev) != hipSuccess || hipDeviceGetAttribute(&cus, hipDeviceAttributeMultiprocessorCount, dev) != hipSuccess) { grid = -1; return; }
        if (hipFuncSetAttribute((const void*)mega_fwd, hipFuncAttributeMaxDynamicSharedMemorySize, LDS_BYTES) != hipSuccess) { fprintf(stderr, "kernel_launch: hipFuncSetAttribute failed\n"); grid = -1; return; }
        if (hipOccupancyMaxActiveBlocksPerMultiprocessor(&per_cu, (const void*)mega_fwd, NTHREADS, LDS_BYTES) != hipSuccess || per_cu < 1) { fprintf(stderr, "kernel_launch: occupancy query says %d\n", per_cu); per_cu = 1; }
        (void)hipGetLastError();
        grid = cus * 1;
    }
    if (grid < 0) return;
    Args a{};
    for (int i = 0; i < 24; ++i) a.in[i] = (const float*)d_in[i];
    a.out = (float*)d_out; a.ws = (unsigned char*)d_ws;
#if MK_ONE_LAUNCH
    a.ph_lo = 0; a.ph_hi = N_PHASES;
    void* args[] = {&a};
    hipError_t e = hipLaunchCooperativeKernel((const void*)mega_fwd, dim3(grid), dim3(NTHREADS), args, LDS_BYTES, stream);
    if (e != hipSuccess) fprintf(stderr, "cooperative launch failed: %s (grid %d)\n", hipGetErrorString(e), grid);
#else
    for (int p = 0; p < N_PHASES; ++p) {
        a.ph_lo = p; a.ph_hi = p + 1;
        hipLaunchKernelGGL(mega_fwd, dim3(grid), dim3(NTHREADS), LDS_BYTES, stream, a);
    }
#endif
}
```

```cpp
#include <hip/hip_runtime.h>
#include <hip/hip_cooperative_groups.h>
#include <cstdio>
#include <cstdint>
namespace cg = cooperative_groups;

#ifndef MK_ONE_LAUNCH
#define MK_ONE_LAUNCH 1
#endif

#define LAS __attribute__((address_space(3)))
typedef unsigned short bf16_t;
typedef short bf16x8 __attribute__((ext_vector_type(8)));
typedef float f32x4 __attribute__((ext_vector_type(4)));
typedef float f32x2 __attribute__((ext_vector_type(2)));
typedef unsigned u32x4 __attribute__((ext_vector_type(4)));
typedef unsigned u32x2 __attribute__((ext_vector_type(2)));

constexpr int T = 24576, DM = 2048, NBATCH = 6, SEQ = 4096, DFF = 5632, INW = 2816;
constexpr int NGRP = 48, NCHUNK = T / 32;
constexpr float EPS = 1e-6f;
constexpr int NTHREADS = 512;
constexpr int LDS_BYTES = 131072 + 1024;

constexpr size_t WS_WINAC = 0;
constexpr size_t WS_WINBF = WS_WINAC + (size_t)2304 * 2048 * 2;
constexpr size_t WS_WOUT  = WS_WINBF + (size_t)1024 * 2048 * 2;
constexpr size_t WS_WGLU  = WS_WOUT + (size_t)2048 * 2048 * 2;
constexpr size_t WS_WS    = WS_WGLU + (size_t)768 * 768 * 2;
constexpr size_t WS_WGU   = WS_WS + (size_t)6 * 128 * 128 * 2;
constexpr size_t WS_WDOWN = WS_WGU + (size_t)11264 * 2048 * 2;
constexpr size_t WS_DFT   = WS_WDOWN + (size_t)2048 * 5632 * 2;
constexpr size_t WS_AL    = WS_DFT + (size_t)4096 * 8192 * 2;
constexpr size_t WS_APW   = WS_AL + (size_t)48 * 2 * 64 * 2 * 4;
constexpr size_t WS_KT    = WS_APW + (size_t)48 * 2 * 33 * 64 * 2 * 4;
constexpr size_t WS_SLOT1 = WS_KT + (size_t)48 * 2 * 32 * 256 * 4;
constexpr size_t WS_ACT   = WS_SLOT1 + (size_t)T * 2048 * 2;
constexpr size_t WS_ZINA  = WS_ACT;
constexpr size_t WS_ZFT   = WS_ZINA + (size_t)T * 1536 * 2;
constexpr size_t WS_YCPRE = WS_ZFT;
constexpr size_t WS_UCAT  = WS_ZFT + (size_t)512 * 49152 * 2;
constexpr size_t WS_XS    = WS_UCAT + (size_t)48 * 768 * 768 * 2;
constexpr size_t WS_TE    = WS_XS + (size_t)48 * 768 * 256 * 4;
constexpr size_t WS_GM    = WS_TE + (size_t)48 * 512 * 768 * 2;
constexpr size_t WS_MIXEND = WS_GM + (size_t)48 * 256 * 512 * 2;
constexpr size_t WS_HID   = WS_ACT;
constexpr size_t WS_END   = WS_ACT + (size_t)T * 5632 * 2;
static_assert(WS_MIXEND <= WS_END, "mixer buffers must fit under the FFN hidden buffer");

struct Args { const float* in[24]; float* out; unsigned char* ws; int ph_lo, ph_hi; };

__device__ __forceinline__ int tid_l() { int t = threadIdx.x; asm volatile("" : "+v"(t)); return t; }
__device__ __forceinline__ unsigned cvt_pk_bf16(float lo, float hi) { unsigned r; asm("v_cvt_pk_bf16_f32 %0, %1, %2" : "=v"(r) : "v"(lo), "v"(hi)); return r; }
__device__ __forceinline__ float bf_lo(unsigned w) { return __uint_as_float(w << 16); }
__device__ __forceinline__ float bf_hi(unsigned w) { return __uint_as_float(w & 0xffff0000u); }
__device__ __forceinline__ bf16_t f2bf(float f) { return (bf16_t)(cvt_pk_bf16(f, 0.f) & 0xffffu); }
__device__ __forceinline__ float sigmoid_f(float v) { return __builtin_amdgcn_rcpf(1.0f + __builtin_amdgcn_exp2f(-1.4426950409f * v)); }
__device__ __forceinline__ float gelu_tanh(float x) { const float z = x * (1.5957691216f + 0.0713548163f * x * x); return x * sigmoid_f(z); }
__device__ __forceinline__ float wave_sum(float v) {
#pragma unroll
    for (int o = 32; o >= 1; o >>= 1) v += __shfl_xor(v, o);
    return v;
}

namespace pg8 {
constexpr int BM = 256, BK = 64, HALF = 128, HTB = HALF * BK * 2, STAGE_BYTES = 8 * HTB, NXCD = 8, WGM = 8;
__device__ __forceinline__ int lds_byte(int r, int c) { const int st = (r >> 4) * 2 + (c >> 5), rr = r & 15, cc = c & 31, ob = rr * 64 + cc * 2; return st * 1024 + (ob ^ (((ob >> 9) & 1) << 5)); }
__device__ __forceinline__ void stage_rc(int b, int& R, int& C) { const int st = b / 1024, sb = b % 1024, swz = sb ^ (((sb >> 9) & 1) << 5); R = (st >> 1) * 16 + swz / 64; C = (st & 1) * 32 + (swz % 64) / 2; }
__device__ __forceinline__ int perm32(int rho) { const int n = rho >> 4, i = rho & 15; return 8 * (i >> 2) + 4 * n + (i & 3); }

struct Unit { const char* A; const char* B; int pm, pn, grp; };
struct Sched {
    const char* A; const char* B; long gsA, gsB; int lda, ldb, nM, nN, nG, G, c;
    __device__ __forceinline__ bool next(int i, Unit& u) const {
        const int nwg = nM * nN;
        const long L = (long)i * G + c; if (c < 0 || L >= (long)nwg * nG) return false;
        const int grp = (int)(L / nwg); int wgid = (int)(L - (long)grp * nwg);
        { const int q = nwg / NXCD, r = nwg % NXCD, xcd = wgid % NXCD, off = wgid / NXCD; wgid = (xcd < r ? xcd * (q + 1) : r * (q + 1) + (xcd - r) * q) + off; }
        const int nig = WGM * nN, gid = wgid / nig, fm = gid * WGM, gsz = (nM - fm) < WGM ? (nM - fm) : WGM;
        u.pm = fm + ((wgid % nig) % gsz); u.pn = (wgid % nig) / gsz; u.grp = grp;
        u.A = A + (size_t)grp * gsA + (size_t)u.pm * 512 * lda; u.B = B + (size_t)grp * gsB + (size_t)u.pn * 512 * ldb;
        return true;
    }
};

template <class Epi>
__device__ __forceinline__ void gemm_phase(LAS unsigned char* lds, const Sched& S, const int K, const Epi& E) {
    int tid = threadIdx.x; asm volatile("" : "+v"(tid));
    const int wid = __builtin_amdgcn_readfirstlane(tid >> 6), lane = tid & 63, wr = wid >> 2, wc = wid & 3, fr = lane & 15, fq = lane >> 4;
    const int nt = K / BK;
    unsigned voffA[2], voffB[2];
#pragma unroll
    for (int i = 0; i < 2; ++i) { int R, C; stage_rc(tid * 16 + i * 8192, R, C); const int Rb = Epi::PERM ? ((R & ~31) + perm32(R & 31)) : R;
        voffA[i] = (unsigned)(R * S.lda + C) * 2u; voffB[i] = (unsigned)(Rb * S.ldb + C) * 2u; }
    const size_t kstep = (size_t)(BK * 2);
    const size_t hstepA = (size_t)HALF * S.lda * 2, hstepB = (size_t)HALF * S.ldb * 2;
    const unsigned ldsw = (unsigned)wid * 1024u;
    const int aoff = lds_byte(wr * 64 + fr, fq * 8), boff = lds_byte(wc * 32 + fr, fq * 8);
#define PG8_SA(b, h) (((b) * 2 + (h)) * HTB)
#define PG8_SB(b, h) ((4 + (b) * 2 + (h)) * HTB)
#define PG8_STAGE(bufoff, gbase, voff) do { _Pragma("unroll") for (int _i = 0; _i < 2; ++_i) \
        __builtin_amdgcn_global_load_lds((const unsigned*)((const char*)(gbase) + (voff)[_i]), (LAS unsigned*)(lds + (bufoff) + ldsw + _i * 8192), 16, 0, 0); } while (0)
#define PG8_LDA(dst, b, h) do { _Pragma("unroll") for (int m = 0; m < 4; ++m) _Pragma("unroll") for (int k = 0; k < 2; ++k) dst[m][k] = *(const LAS bf16x8*)(lds + PG8_SA(b, h) + aoff + m * 2048 + k * 1024); } while (0)
#define PG8_LDB(dst, b, h) do { _Pragma("unroll") for (int n = 0; n < 2; ++n) _Pragma("unroll") for (int k = 0; k < 2; ++k) dst[n][k] = *(const LAS bf16x8*)(lds + PG8_SB(b, h) + boff + n * 2048 + k * 1024); } while (0)
#define PG8_MMA(ai, bj, At, Bt) do { __builtin_amdgcn_s_setprio(1); _Pragma("unroll") for (int m = 0; m < 4; ++m) _Pragma("unroll") for (int n = 0; n < 2; ++n) _Pragma("unroll") for (int k = 0; k < 2; ++k) \
        acc[ai][bj][m][n] = __builtin_amdgcn_mfma_f32_16x16x32_bf16(Bt[n][k], At[m][k], acc[ai][bj][m][n], 0, 0, 0); __builtin_amdgcn_s_setprio(0); } while (0)
#define PG8_WAIT_V(n) asm volatile("s_waitcnt vmcnt(" #n ")" ::: "memory")
#define PG8_WAIT_L(n) asm volatile("s_waitcnt lgkmcnt(" #n ")" ::: "memory")
#define PG8_BAR __builtin_amdgcn_s_barrier()
#define PG8_SCHED __builtin_amdgcn_sched_barrier(0)
    Unit cur, nxt; int ui = 0;
    if (!S.next(0, cur)) return;
    f32x4 acc[2][2][4][2];
#pragma unroll
    for (int a = 0; a < 2; ++a)
#pragma unroll
        for (int b = 0; b < 2; ++b)
#pragma unroll
            for (int m = 0; m < 4; ++m)
#pragma unroll
                for (int n = 0; n < 2; ++n) acc[a][b][m][n] = (f32x4){0.f, 0.f, 0.f, 0.f};
    bf16x8 At[4][2], B0[2][2], B1[2][2];
    const char* cA = cur.A; const char* cB = cur.B;
    PG8_STAGE(PG8_SB(0, 0), cB, voffB); PG8_STAGE(PG8_SB(0, 1), cB + hstepB, voffB); PG8_STAGE(PG8_SA(0, 0), cA, voffA); PG8_STAGE(PG8_SA(0, 1), cA + hstepA, voffA);
    if (wr == 1) PG8_BAR;
    PG8_WAIT_V(2); PG8_BAR;
    PG8_STAGE(PG8_SB(1, 0), cB + kstep, voffB); PG8_STAGE(PG8_SA(1, 0), cA + kstep, voffA); PG8_STAGE(PG8_SB(1, 1), cB + hstepB + kstep, voffB);
    PG8_WAIT_V(6); PG8_BAR;
    for (;;) {
        const bool has_next = S.next(ui + 1, nxt);
        const char* nA = has_next ? nxt.A : cA; const char* nB = has_next ? nxt.B : cB;
        for (int t = 0; t < nt; t += 2) {
            const bool last = (t == nt - 2);
            const char* a1 = cA + (size_t)(t + 1) * kstep;
            const char* a2 = last ? nA : cA + (size_t)(t + 2) * kstep; const char* b2 = last ? nB : cB + (size_t)(t + 2) * kstep;
            const char* a3 = a2 + kstep; const char* b3 = b2 + kstep;
            PG8_LDB(B0, 0, 0); PG8_LDB(B1, 0, 1); PG8_SCHED; PG8_LDA(At, 0, 0); PG8_STAGE(PG8_SA(1, 1), a1 + hstepA, voffA);
            PG8_WAIT_V(8); PG8_WAIT_L(0); PG8_BAR; PG8_MMA(0, 0, At, B0); PG8_MMA(0, 1, At, B1); PG8_BAR; PG8_SCHED;
            PG8_LDA(At, 0, 1); PG8_STAGE(PG8_SB(0, 0), b2, voffB); PG8_STAGE(PG8_SB(0, 1), b2 + hstepB, voffB); PG8_STAGE(PG8_SA(0, 0), a2, voffA);
            PG8_WAIT_V(8); PG8_WAIT_L(0); PG8_BAR; PG8_MMA(1, 0, At, B0); PG8_MMA(1, 1, At, B1); PG8_BAR; PG8_SCHED;
            PG8_LDB(B0, 1, 0); PG8_LDB(B1, 1, 1); PG8_SCHED; PG8_LDA(At, 1, 0); PG8_STAGE(PG8_SA(0, 1), a2 + hstepA, voffA);
            PG8_WAIT_V(8); PG8_WAIT_L(0); PG8_BAR; PG8_MMA(0, 0, At, B0); PG8_MMA(0, 1, At, B1); PG8_BAR; PG8_SCHED;
            PG8_LDA(At, 1, 1); PG8_STAGE(PG8_SB(1, 0), b3, voffB); PG8_STAGE(PG8_SB(1, 1), b3 + hstepB, voffB); PG8_STAGE(PG8_SA(1, 0), a3, voffA);
            PG8_WAIT_V(8); PG8_WAIT_L(0); PG8_BAR; PG8_MMA(1, 0, At, B0); PG8_MMA(1, 1, At, B1); PG8_BAR; PG8_SCHED;
        }
        if (wr == 0) PG8_BAR;
        E(acc, cur, wr, wc, fr, fq);
        if (!has_next) break;
#pragma unroll
        for (int a = 0; a < 2; ++a)
#pragma unroll
            for (int b = 0; b < 2; ++b)
#pragma unroll
                for (int m = 0; m < 4; ++m)
#pragma unroll
                    for (int n = 0; n < 2; ++n) acc[a][b][m][n] = (f32x4){0.f, 0.f, 0.f, 0.f};
        cur = nxt; cA = nA; cB = nB; ++ui;
        if (wr == 1) PG8_BAR;
    }
    PG8_WAIT_V(0);
    PG8_BAR;
#undef PG8_SA
#undef PG8_SB
#undef PG8_STAGE
#undef PG8_LDA
#undef PG8_LDB
#undef PG8_MMA
#undef PG8_WAIT_V
#undef PG8_WAIT_L
#undef PG8_BAR
#undef PG8_SCHED
}
}
using pg8::Unit;
typedef const f32x4 (&AccRef)[2][2][4][2];

__device__ __forceinline__ u32x4 pack8(f32x4 v0, f32x4 v1) { u32x4 w; w.x = cvt_pk_bf16(v0[0], v0[1]); w.y = cvt_pk_bf16(v0[2], v0[3]); w.z = cvt_pk_bf16(v1[0], v1[1]); w.w = cvt_pk_bf16(v1[2], v1[3]); return w; }
__device__ __forceinline__ f32x4 gelu4(f32x4 v) { return (f32x4){gelu_tanh(v[0]), gelu_tanh(v[1]), gelu_tanh(v[2]), gelu_tanh(v[3])}; }

struct EpiWin { static constexpr bool PERM = true; bf16_t* zina; bf16_t* ucat;
    __device__ __forceinline__ void operator()(AccRef acc, const Unit& u, int wr, int wc, int fr, int fq) const {
        const int row0 = u.pm * 256 + wr * 64 + fr;
        if (u.pn < 6) {
            const int col0 = u.pn * 256 + wc * 32 + 8 * fq;
#pragma unroll
            for (int ai = 0; ai < 2; ++ai)
#pragma unroll
                for (int m = 0; m < 4; ++m) { bf16_t* rowp = zina + (size_t)(row0 + ai * 128 + m * 16) * 1536 + col0;
#pragma unroll
                    for (int bj = 0; bj < 2; ++bj) *(u32x4*)(rowp + bj * 128) = pack8(gelu4(acc[ai][bj][m][0]), gelu4(acc[ai][bj][m][1])); }
        } else {
            const int cc0 = (u.pn - 6) * 256 + wc * 32 + 8 * fq;
#pragma unroll
            for (int ai = 0; ai < 2; ++ai)
#pragma unroll
                for (int m = 0; m < 4; ++m) { const int t = row0 + ai * 128 + m * 16, n = t >> 5, j = t & 31;
#pragma unroll
                    for (int bj = 0; bj < 2; ++bj) { const int cc = cc0 + bj * 128, g = cc >> 4, c0 = cc & 15;
                        *(u32x4*)(ucat + ((size_t)(g * 768 + n) * 768 + j * 16 + c0)) = pack8(acc[ai][bj][m][0], acc[ai][bj][m][1]); } }
        }
    } };
struct EpiZft { static constexpr bool PERM = true; bf16_t* zft;
    __device__ __forceinline__ void operator()(AccRef acc, const Unit& u, int wr, int wc, int fr, int fq) const {
        const int row0 = u.pm * 256 + wr * 64 + fr, t0 = u.pn * 256 + wc * 32 + 8 * fq;
#pragma unroll
        for (int ai = 0; ai < 2; ++ai)
#pragma unroll
            for (int m = 0; m < 4; ++m) { const int r = row0 + ai * 128 + m * 16, ri = r >> 9, gc = r & 511;
#pragma unroll
                for (int bj = 0; bj < 2; ++bj) { const int t = t0 + bj * 128, b = t >> 12, n = t & 4095;
                    *(u32x4*)(zft + ((size_t)(gc * 6 + b) * 8192 + ri * 4096 + n)) = pack8(acc[ai][bj][m][0], acc[ai][bj][m][1]); } }
    } };
struct EpiFour { static constexpr bool PERM = true; bf16_t* y;
    __device__ __forceinline__ void operator()(AccRef acc, const Unit& u, int wr, int wc, int fr, int fq) const {
        const int row0 = u.grp * 4096 + u.pm * 256 + wr * 64 + fr, col0 = 768 + u.pn * 256 + wc * 32 + 8 * fq;
#pragma unroll
        for (int ai = 0; ai < 2; ++ai)
#pragma unroll
            for (int m = 0; m < 4; ++m) { bf16_t* rowp = y + (size_t)(row0 + ai * 128 + m * 16) * 2048 + col0;
#pragma unroll
                for (int bj = 0; bj < 2; ++bj) *(u32x4*)(rowp + bj * 128) = pack8(acc[ai][bj][m][0], acc[ai][bj][m][1]); }
    } };
struct EpiXs { static constexpr bool PERM = false; float* xs;
    __device__ __forceinline__ void operator()(AccRef acc, const Unit& u, int wr, int wc, int fr, int fq) const {
        const int row0 = u.pm * 256 + wr * 64 + fr, col0 = wc * 32 + 4 * fq;
#pragma unroll
        for (int ai = 0; ai < 2; ++ai)
#pragma unroll
            for (int m = 0; m < 4; ++m) { float* rowp = xs + ((size_t)u.grp * 768 + row0 + ai * 128 + m * 16) * 256 + col0;
#pragma unroll
                for (int bj = 0; bj < 2; ++bj)
#pragma unroll
                    for (int n = 0; n < 2; ++n) *(f32x4*)(rowp + bj * 128 + n * 16) = acc[ai][bj][m][n]; }
    } };
struct EpiYc { static constexpr bool PERM = true; bf16_t* ycpre;
    __device__ __forceinline__ void operator()(AccRef acc, const Unit& u, int wr, int wc, int fr, int fq) const {
        const int row0 = u.pm * 256 + wr * 64 + fr, col0 = u.pn * 256 + wc * 32 + 8 * fq;
#pragma unroll
        for (int ai = 0; ai < 2; ++ai)
#pragma unroll
            for (int m = 0; m < 4; ++m) { const int n = row0 + ai * 128 + m * 16;
#pragma unroll
                for (int bj = 0; bj < 2; ++bj) { const int col = col0 + bj * 128, i = col >> 4, c0 = col & 15;
                    *(u32x4*)(ycpre + ((size_t)(n * 32 + i) * 768 + u.grp * 16 + c0)) = pack8(gelu4(acc[ai][bj][m][0]), gelu4(acc[ai][bj][m][1])); } }
    } };
struct EpiGlu { static constexpr bool PERM = true; const bf16_t* ycpre; const float* bias; bf16_t* y;
    __device__ __forceinline__ void operator()(AccRef acc, const Unit& u, int wr, int wc, int fr, int fq) const {
        const int row0 = u.pm * 256 + wr * 64 + fr, col0 = u.pn * 256 + wc * 32 + 8 * fq;
        f32x4 bv[2][2];
#pragma unroll
        for (int bj = 0; bj < 2; ++bj)
#pragma unroll
            for (int n = 0; n < 2; ++n) bv[bj][n] = *(const f32x4*)(bias + col0 + bj * 128 + 4 * n);
#pragma unroll
        for (int ai = 0; ai < 2; ++ai)
#pragma unroll
            for (int m = 0; m < 4; ++m) { const size_t t = (size_t)(row0 + ai * 128 + m * 16);
#pragma unroll
                for (int bj = 0; bj < 2; ++bj) { const int col = col0 + bj * 128;
                    const u32x4 yc = *(const u32x4*)(ycpre + t * 768 + col);
                    const f32x4 v0 = acc[ai][bj][m][0] + bv[bj][0], v1 = acc[ai][bj][m][1] + bv[bj][1];
                    const f32x4 o0 = (f32x4){bf_lo(yc.x) * sigmoid_f(v0[0]), bf_hi(yc.x) * sigmoid_f(v0[1]), bf_lo(yc.y) * sigmoid_f(v0[2]), bf_hi(yc.y) * sigmoid_f(v0[3])};
                    const f32x4 o1 = (f32x4){bf_lo(yc.z) * sigmoid_f(v1[0]), bf_hi(yc.z) * sigmoid_f(v1[1]), bf_lo(yc.w) * sigmoid_f(v1[2]), bf_hi(yc.w) * sigmoid_f(v1[3])};
                    *(u32x4*)(y + t * 2048 + 1280 + col) = pack8(o0, o1); } }
    } };
struct EpiRes { static constexpr bool PERM = false; float* x;
    __device__ __forceinline__ void operator()(AccRef acc, const Unit& u, int wr, int wc, int fr, int fq) const {
        const int row0 = u.pm * 256 + wr * 64 + fr, col0 = u.pn * 256 + wc * 32 + 4 * fq;
#pragma unroll
        for (int ai = 0; ai < 2; ++ai) {
            float* base = x + (size_t)(row0 + ai * 128) * 2048 + col0;
            f32x4 ld[4][2][2];
#pragma unroll
            for (int m = 0; m < 4; ++m)
#pragma unroll
                for (int bj = 0; bj < 2; ++bj)
#pragma unroll
                    for (int n = 0; n < 2; ++n) ld[m][bj][n] = *(const f32x4*)(base + (size_t)m * 16 * 2048 + bj * 128 + n * 16);
#pragma unroll
            for (int m = 0; m < 4; ++m)
#pragma unroll
                for (int bj = 0; bj < 2; ++bj)
#pragma unroll
                    for (int n = 0; n < 2; ++n) *(f32x4*)(base + (size_t)m * 16 * 2048 + bj * 128 + n * 16) = ld[m][bj][n] + acc[ai][bj][m][n];
            asm volatile("" ::: "memory"); }
    } };
struct EpiSwi { static constexpr bool PERM = true; bf16_t* hid;
    __device__ __forceinline__ void operator()(AccRef acc, const Unit& u, int wr, int wc, int fr, int fq) const {
        const int row0 = u.pm * 256 + wr * 64 + fr, col0 = u.pn * 128 + wc * 32 + 8 * fq;
#pragma unroll
        for (int ai = 0; ai < 2; ++ai)
#pragma unroll
            for (int m = 0; m < 4; ++m) {
                f32x4 o[2];
#pragma unroll
                for (int n = 0; n < 2; ++n) { const f32x4 g = acc[ai][0][m][n], up = acc[ai][1][m][n];
                    o[n] = (f32x4){g[0] * sigmoid_f(g[0]) * up[0], g[1] * sigmoid_f(g[1]) * up[1], g[2] * sigmoid_f(g[2]) * up[2], g[3] * sigmoid_f(g[3]) * up[3]}; }
                *(u32x4*)(hid + (size_t)(row0 + ai * 128 + m * 16) * 5632 + col0) = pack8(o[0], o[1]); }
    } };

struct TrDesc { const float* src; int ldsrc, K, c0, nc; bf16_t* dst; int mode, doff; };
__device__ __forceinline__ void transpose_tile(LAS unsigned char* lds, const TrDesc& d, int tile) {
    const int tid = tid_l(), nkt = d.K >> 6, kt = tile % nkt, ct = tile / nkt;
    LAS bf16_t* tl = (LAS bf16_t*)lds;
    { const int k = tid >> 3, n8 = (tid & 7) * 8;
      const float* s = d.src + (size_t)(kt * 64 + k) * d.ldsrc + d.c0 + ct * 256 + n8;
      f32x4 v[4][2];
#pragma unroll
      for (int q = 0; q < 4; ++q) { v[q][0] = *(const f32x4*)(s + q * 64); v[q][1] = *(const f32x4*)(s + q * 64 + 4); }
#pragma unroll
      for (int q = 0; q < 4; ++q)
#pragma unroll
          for (int j = 0; j < 4; ++j) { tl[(q * 64 + n8 + j) * 66 + k] = f2bf(v[q][0][j]); tl[(q * 64 + n8 + 4 + j) * 66 + k] = f2bf(v[q][1][j]); } }
    __syncthreads();
    { const int n = tid >> 3, k8 = (tid & 7) * 8;
#pragma unroll
      for (int q = 0; q < 4; ++q) {
          const LAS unsigned* p = (const LAS unsigned*)(tl + (q * 64 + n) * 66 + k8);
          u32x4 w; w.x = p[0]; w.y = p[1]; w.z = p[2]; w.w = p[3];
          const int cc = ct * 256 + q * 64 + n;
          const int drow = d.mode == 0 ? d.doff + cc : ((cc >> 7) * 256 + (cc & 127) + (d.mode == 2 ? 128 : 0));
          *(u32x4*)(d.dst + (size_t)drow * d.K + kt * 64 + k8) = w; } }
    __syncthreads();
}

__device__ __forceinline__ double kd(double c) { asm volatile("" : "+v"(c)); return c; }
__device__ __forceinline__ double exp_d(double x) {
    const double y = x * 0.125; double term = 1.0, sum = 1.0;
#pragma unroll 1
    for (int n = 1; n <= 22; ++n) { term *= y / (double)n; sum += term; }
    sum *= sum; sum *= sum; sum *= sum; return sum;
}
__device__ __forceinline__ void sincos_d(double x, double& s, double& c) {
    const double k = rint(x * kd(0.15915494309189535));
    double r = fma(-k, kd(6.283185307179586232), x); r = fma(-k, kd(2.4492935982947064e-16), r);
    const double y = r * 0.125, my2 = -(y * y);
    double sn = y, cs = 1.0, ts = y, tc = 1.0;
#pragma unroll 1
    for (int n = 1; n <= 10; ++n) { tc *= my2 / (double)((2 * n - 1) * (2 * n)); cs += tc; ts *= my2 / (double)((2 * n) * (2 * n + 1)); sn += ts; }
#pragma unroll 1
    for (int i = 0; i < 3; ++i) { const double c2 = cs * cs - sn * sn, s2 = 2.0 * sn * cs; cs = c2; sn = s2; }
    s = sn; c = cs;
}

__device__ __forceinline__ void s5_disc(const Args& a, int l, int g, int dir, int p, double& ar, double& ai, double& qr, double& qi) {
    const double lr = (double)a.in[7][((l * 2 + dir) * 48 + g) * 64 + p], li = (double)a.in[8][((l * 2 + dir) * 48 + g) * 64 + p];
    const double st = exp_d((double)a.in[9][(l * 2 + dir) * 48 + g]);
    const double mag = exp_d(lr * st); double sn, cs; sincos_d(li * st, sn, cs);
    ar = mag * cs; ai = mag * sn; const double den = lr * lr + li * li, nr = ar - 1.0;
    qr = (nr * lr + ai * li) / den; qi = (ai * lr - nr * li) / den;
}
__device__ __forceinline__ void s5_group_a(LAS unsigned char* lds, const Args& a, int l, int g) {
    const int tid = tid_l();
    LAS float* apw = (LAS float*)lds;
    LAS float* bbr = apw + 2 * 33 * 64 * 2;
    bf16_t* GMp = (bf16_t*)(a.ws + WS_GM); float* ALp = (float*)(a.ws + WS_AL); float* APWp = (float*)(a.ws + WS_APW);
    if (tid < 128) {
        const int dir = tid >> 6, p = tid & 63;
        double ar, ai, qr, qi; s5_disc(a, l, g, dir, p, ar, ai, qr, qi);
        double pr = 1.0, pi = 0.0;
#pragma unroll 1
        for (int tau = 0; tau <= 32; ++tau) { const float fr_ = (float)pr, fi_ = (float)pi;
            apw[((dir * 33 + tau) * 64 + p) * 2] = fr_; apw[((dir * 33 + tau) * 64 + p) * 2 + 1] = fi_;
            *(f32x2*)(APWp + ((size_t)((g * 2 + dir) * 33 + tau) * 64 + p) * 2) = (f32x2){fr_, fi_};
            const double nr2 = pr * ar - pi * ai, ni2 = pr * ai + pi * ar; pr = nr2; pi = ni2; }
        ALp[((g * 2 + dir) * 64 + p) * 2] = apw[((dir * 33 + 32) * 64 + p) * 2]; ALp[((g * 2 + dir) * 64 + p) * 2 + 1] = apw[((dir * 33 + 32) * 64 + p) * 2 + 1];
#pragma unroll 1
        for (int c = 0; c < 16; ++c) { const double br = (double)a.in[10][((l * 48 + g) * 64 + p) * 16 + c], bi = (double)a.in[11][((l * 48 + g) * 64 + p) * 16 + c];
            bbr[((dir * 64 + p) * 16 + c) * 2] = (float)(qr * br - qi * bi); bbr[((dir * 64 + p) * 16 + c) * 2 + 1] = (float)(qr * bi + qi * br); }
    }
    __syncthreads();
    {
        const int row = tid >> 1, half = tid & 1, dir = row >> 7, p = (row >> 1) & 63, ri = row & 1;
        bf16_t* rowp = GMp + ((size_t)g * 256 + row) * 512;
        for (int jj = 0; jj < 16; ++jj) { const int j = half * 16 + jj, e = dir == 0 ? 31 - j : j;
            const float wr_ = apw[((dir * 33 + e) * 64 + p) * 2], wi_ = apw[((dir * 33 + e) * 64 + p) * 2 + 1];
            float v[16];
#pragma unroll
            for (int c2 = 0; c2 < 16; ++c2) { const float Br = bbr[((dir * 64 + p) * 16 + c2) * 2], Bi = bbr[((dir * 64 + p) * 16 + c2) * 2 + 1];
                v[c2] = ri == 0 ? wr_ * Br - wi_ * Bi : wr_ * Bi + wi_ * Br; }
            u32x4 w0, w1; w0.x = cvt_pk_bf16(v[0], v[1]); w0.y = cvt_pk_bf16(v[2], v[3]); w0.z = cvt_pk_bf16(v[4], v[5]); w0.w = cvt_pk_bf16(v[6], v[7]);
            w1.x = cvt_pk_bf16(v[8], v[9]); w1.y = cvt_pk_bf16(v[10], v[11]); w1.z = cvt_pk_bf16(v[12], v[13]); w1.w = cvt_pk_bf16(v[14], v[15]);
            *(u32x4*)(rowp + j * 16) = w0; *(u32x4*)(rowp + j * 16 + 8) = w1; }
    }
    __syncthreads();
}
__device__ __forceinline__ void s5_ktab(LAS unsigned char* lds, const Args& a, int l, int task) {
    const int tid = tid_l(), g = task >> 3, dir = (task >> 2) & 1, tb = task & 3;
    LAS float* ap8 = (LAS float*)lds;
    LAS float* bbr = ap8 + 8 * 64 * 2;
    LAS float* ccx = bbr + 64 * 16 * 2;
    LAS float* cw  = ccx + 16 * 64 * 2;
    float* KTp = (float*)(a.ws + WS_KT);
    if (tid < 64) {
        const int p = tid; double ar, ai, qr, qi; s5_disc(a, l, g, dir, p, ar, ai, qr, qi);
        double pr = 1.0, pi = 0.0;
#pragma unroll 1
        for (int t = 0; t < tb * 8; ++t) { const double nr2 = pr * ar - pi * ai, ni2 = pr * ai + pi * ar; pr = nr2; pi = ni2; }
#pragma unroll 1
        for (int t = 0; t < 8; ++t) { ap8[(t * 64 + p) * 2] = (float)pr; ap8[(t * 64 + p) * 2 + 1] = (float)pi;
            const double nr2 = pr * ar - pi * ai, ni2 = pr * ai + pi * ar; pr = nr2; pi = ni2; }
#pragma unroll 1
        for (int c = 0; c < 16; ++c) { const double br = (double)a.in[10][((l * 48 + g) * 64 + p) * 16 + c], bi = (double)a.in[11][((l * 48 + g) * 64 + p) * 16 + c];
            bbr[(p * 16 + c) * 2] = (float)(qr * br - qi * bi); bbr[(p * 16 + c) * 2 + 1] = (float)(qr * bi + qi * br); }
    }
    for (int idx = tid; idx < 1024; idx += NTHREADS) { const int c = idx >> 6, p = idx & 63;
        ccx[idx * 2] = a.in[12][((l * 48 + g) * 16 + c) * 64 + p]; ccx[idx * 2 + 1] = a.in[13][((l * 48 + g) * 16 + c) * 64 + p]; }
    __syncthreads();
    for (int idx = tid; idx < 8192; idx += NTHREADS) { const int t = idx >> 10, cp = idx & 1023, p = idx & 63;
        const float Cr = ccx[cp * 2], Ci = ccx[cp * 2 + 1], wr_ = ap8[(t * 64 + p) * 2], wi_ = ap8[(t * 64 + p) * 2 + 1];
        cw[idx * 2] = Cr * wr_ - Ci * wi_; cw[idx * 2 + 1] = Cr * wi_ + Ci * wr_; }
    __syncthreads();
#pragma unroll
    for (int k = 0; k < 4; ++k) { const int o = tid + k * NTHREADS, t = o >> 8, c = (o >> 4) & 15, c2 = o & 15;
        float s = 0.f;
        for (int p = 0; p < 64; ++p) s += cw[((t * 16 + c) * 64 + p) * 2] * bbr[(p * 16 + c2) * 2] - cw[((t * 16 + c) * 64 + p) * 2 + 1] * bbr[(p * 16 + c2) * 2 + 1];
        KTp[((size_t)((g * 2 + dir) * 32 + tb * 8 + t)) * 256 + c * 16 + c2] = s; }
    __syncthreads();
}
__device__ __forceinline__ void s5_te(const Args& a, int l, int task) {
    const int tid = tid_l(), g = task >> 2, qd = task & 3, r = tid >> 2, sub = tid & 3, i = qd * 8 + (r >> 4), c = r & 15;
    const float* KTp = (const float*)(a.ws + WS_KT); const float* APWp = (const float*)(a.ws + WS_APW);
    bf16_t* rowp = (bf16_t*)(a.ws + WS_TE) + ((size_t)g * 512 + i * 16 + c) * 768;
    const float dsk = a.in[14][l * 768 + g * 16 + c];
    const float* kf = KTp + (size_t)((g * 2 + 0) * 32) * 256 + c * 16; const float* kb = KTp + (size_t)((g * 2 + 1) * 32) * 256 + c * 16;
#pragma unroll 2
    for (int jj = 0; jj < 8; ++jj) { const int j = sub * 8 + jj;
        f32x4 v[4];
        if (j < i) {
#pragma unroll
            for (int q = 0; q < 4; ++q) v[q] = *(const f32x4*)(kf + (i - j) * 256 + q * 4);
        } else if (j > i) {
#pragma unroll
            for (int q = 0; q < 4; ++q) v[q] = *(const f32x4*)(kb + (j - i) * 256 + q * 4);
        } else {
#pragma unroll
            for (int q = 0; q < 4; ++q) { v[q] = *(const f32x4*)(kf + q * 4) + *(const f32x4*)(kb + q * 4);
#pragma unroll
                for (int e = 0; e < 4; ++e) v[q][e] += (q * 4 + e == c) ? dsk : 0.f; }
        }
        *(u32x4*)(rowp + j * 16) = pack8(v[0], v[1]); *(u32x4*)(rowp + j * 16 + 8) = pack8(v[2], v[3]); }
    { const int dir = sub >> 1, p0 = (sub & 1) * 32, e = dir == 0 ? i + 1 : 32 - i;
      const float* cr = a.in[12] + ((l * 48 + g) * 16 + c) * 64 + p0; const float* ci = a.in[13] + ((l * 48 + g) * 16 + c) * 64 + p0;
      const float* aw = APWp + ((size_t)((g * 2 + dir) * 33 + e) * 64 + p0) * 2;
#pragma unroll 2
      for (int p4 = 0; p4 < 32; p4 += 4) { const f32x4 Cr = *(const f32x4*)(cr + p4), Ci = *(const f32x4*)(ci + p4), w0 = *(const f32x4*)(aw + p4 * 2), w1 = *(const f32x4*)(aw + p4 * 2 + 4);
          u32x4 ww; ww.x = cvt_pk_bf16(Cr[0] * w0[0] - Ci[0] * w0[1], -(Cr[0] * w0[1] + Ci[0] * w0[0])); ww.y = cvt_pk_bf16(Cr[1] * w0[2] - Ci[1] * w0[3], -(Cr[1] * w0[3] + Ci[1] * w0[2]));
          ww.z = cvt_pk_bf16(Cr[2] * w1[0] - Ci[2] * w1[1], -(Cr[2] * w1[1] + Ci[2] * w1[0])); ww.w = cvt_pk_bf16(Cr[3] * w1[2] - Ci[3] * w1[3], -(Cr[3] * w1[3] + Ci[3] * w1[2]));
          *(u32x4*)(rowp + 512 + dir * 128 + (p0 + p4) * 2) = ww; } }
}

__device__ __forceinline__ void winbf_task(LAS unsigned char* lds, const float* w_in_l, bf16_t* dst, int task) {
    const int tid = tid_l(), g = task & 3, k0 = (task >> 2) * 64;
    LAS float* Wt = (LAS float*)lds;
    LAS float* tc = Wt + 64 * 128; LAS float* ts = tc + 128;
    { const int k = tid >> 3, c16 = (tid & 7) * 16; const float* s = w_in_l + (size_t)(k0 + k) * INW + 1536 + g * 128 + c16;
#pragma unroll
      for (int q = 0; q < 4; ++q) *(LAS f32x4*)(Wt + k * 128 + c16 + q * 4) = *(const f32x4*)(s + q * 4); }
    if (tid < 128) { float sn, cs; sincospif((float)tid * (1.0f / 64.0f), &sn, &cs); tc[tid] = cs; ts[tid] = sn; }
    __syncthreads();
    const int cp = tid & 127, kq = tid >> 7;
    float aC[16], aS[16];
#pragma unroll
    for (int kk = 0; kk < 16; ++kk) { aC[kk] = 0.f; aS[kk] = 0.f; }
    for (int c = 0; c < 128; ++c) { const int idx = (c * cp) & 127; const float vc = tc[idx], vs = ts[idx];
#pragma unroll
        for (int kk = 0; kk < 16; ++kk) { const float w = Wt[(kq * 16 + kk) * 128 + c]; aC[kk] += w * vc; aS[kk] += w * vs; } }
    bf16_t* dc = dst + (size_t)(g * 128 + cp) * 2048 + k0 + kq * 16; bf16_t* ds = dst + (size_t)(512 + g * 128 + cp) * 2048 + k0 + kq * 16;
    u32x4 w; w.x = cvt_pk_bf16(aC[0], aC[1]); w.y = cvt_pk_bf16(aC[2], aC[3]); w.z = cvt_pk_bf16(aC[4], aC[5]); w.w = cvt_pk_bf16(aC[6], aC[7]); *(u32x4*)dc = w;
    w.x = cvt_pk_bf16(aC[8], aC[9]); w.y = cvt_pk_bf16(aC[10], aC[11]); w.z = cvt_pk_bf16(aC[12], aC[13]); w.w = cvt_pk_bf16(aC[14], aC[15]); *(u32x4*)(dc + 8) = w;
    w.x = cvt_pk_bf16(aS[0], aS[1]); w.y = cvt_pk_bf16(aS[2], aS[3]); w.z = cvt_pk_bf16(aS[4], aS[5]); w.w = cvt_pk_bf16(aS[6], aS[7]); *(u32x4*)ds = w;
    w.x = cvt_pk_bf16(aS[8], aS[9]); w.y = cvt_pk_bf16(aS[10], aS[11]); w.z = cvt_pk_bf16(aS[12], aS[13]); w.w = cvt_pk_bf16(aS[14], aS[15]); *(u32x4*)(ds + 8) = w;
    __syncthreads();
}

__device__ __forceinline__ void dft_gen(LAS unsigned char* lds, bf16_t* dft, int bx, int G) {
    const int tid = tid_l();
    LAS float* tab = (LAS float*)lds;
    for (int i = tid; i < 4096; i += NTHREADS) tab[i] = cospif((float)i * (1.0f / 2048.0f)) * 0.0013810679320049757f;
    __syncthreads();
    for (int k = bx; k < 4096; k += G)
        for (int e8 = tid; e8 < 1024; e8 += NTHREADS) { const int col8 = e8 * 8, ri = col8 >> 12, n0 = col8 & 4095; float v[8];
#pragma unroll
            for (int j = 0; j < 8; ++j) { const int idx = (k * (n0 + j)) & 4095; v[j] = ri == 0 ? tab[idx] : -tab[(idx - 1024) & 4095]; }
            u32x4 w; w.x = cvt_pk_bf16(v[0], v[1]); w.y = cvt_pk_bf16(v[2], v[3]); w.z = cvt_pk_bf16(v[4], v[5]); w.w = cvt_pk_bf16(v[6], v[7]);
            *(u32x4*)(dft + (size_t)k * 8192 + col8) = w; }
    __syncthreads();
}

template <int MODE>
__device__ __forceinline__ void rms_rows(const float* xp, const float* xs, float* xres, const float* gain, bf16_t* outb, int bx, int G) {
    const int tid = tid_l(), lane = tid & 63, wave = tid >> 6;
    f32x4 gv[8];
#pragma unroll
    for (int it = 0; it < 8; ++it) gv[it] = *(const f32x4*)(gain + it * 256 + lane * 4);
    for (int row = bx * 8 + wave; row < T; row += G * 8) {
        const float* src = MODE == 0 ? (row < 16384 ? xp + (size_t)row * 2048 : xs + (size_t)(row - 16384) * 2048) : xres + (size_t)row * 2048;
        f32x4 v[8]; float ss = 0.f;
#pragma unroll
        for (int it = 0; it < 8; ++it) { v[it] = *(const f32x4*)(src + it * 256 + lane * 4); ss += v[it][0] * v[it][0] + v[it][1] * v[it][1] + v[it][2] * v[it][2] + v[it][3] * v[it][3]; }
        ss = wave_sum(ss);
        const float r = 1.0f / sqrtf(ss * (1.0f / 2048.0f) + EPS);
#pragma unroll
        for (int it = 0; it < 8; ++it) {
            const f32x4 o = v[it] * r * gv[it];
            if (MODE == 0) *(f32x4*)(xres + (size_t)row * 2048 + it * 256 + lane * 4) = v[it];
            if (MODE == 2) *(f32x4*)(xres + (size_t)row * 2048 + it * 256 + lane * 4) = o;
            else { u32x2 w; w.x = cvt_pk_bf16(o[0], o[1]); w.y = cvt_pk_bf16(o[2], o[3]); *(u32x2*)(outb + (size_t)row * 2048 + it * 256 + lane * 4) = w; }
        }
    }
}

__device__ __forceinline__ void outnorm_rows(bf16_t* y, const float* og, int bx, int G) {
    const int tid = tid_l(), lane = tid & 63, wave = tid >> 6;
    for (int row = bx * 8 + wave; row < T; row += G * 8) {
        bf16_t* rp = y + (size_t)row * 2048;
        u32x4 w[4]; float ss[3] = {0.f, 0.f, 0.f};
#pragma unroll
        for (int it = 0; it < 4; ++it) { const int ch = it * 64 + lane; w[it] = *(const u32x4*)(rp + ch * 8);
            float s = 0.f;
#pragma unroll
            for (int q = 0; q < 4; ++q) { const float a0 = bf_lo(w[it][q]), a1 = bf_hi(w[it][q]); s += a0 * a0 + a1 * a1; }
            const int seg = ch < 96 ? 0 : (ch < 160 ? 1 : 2);
            ss[0] += seg == 0 ? s : 0.f; ss[1] += seg == 1 ? s : 0.f; ss[2] += seg == 2 ? s : 0.f; }
        ss[0] = wave_sum(ss[0]); ss[1] = wave_sum(ss[1]); ss[2] = wave_sum(ss[2]);
        const float r0 = 1.0f / sqrtf(ss[0] * (1.0f / 768.0f) + EPS), r1 = 1.0f / sqrtf(ss[1] * (1.0f / 512.0f) + EPS), r2 = 1.0f / sqrtf(ss[2] * (1.0f / 768.0f) + EPS);
#pragma unroll
        for (int it = 0; it < 4; ++it) { const int ch = it * 64 + lane; const float r = ch < 96 ? r0 : (ch < 160 ? r1 : r2);
            const f32x4 g0 = *(const f32x4*)(og + ch * 8), g1 = *(const f32x4*)(og + ch * 8 + 4);
            u32x4 o; o.x = cvt_pk_bf16(bf_lo(w[it].x) * r * g0[0], bf_hi(w[it].x) * r * g0[1]); o.y = cvt_pk_bf16(bf_lo(w[it].y) * r * g0[2], bf_hi(w[it].y) * r * g0[3]);
            o.z = cvt_pk_bf16(bf_lo(w[it].z) * r * g1[0], bf_hi(w[it].z) * r * g1[1]); o.w = cvt_pk_bf16(bf_lo(w[it].w) * r * g1[2], bf_hi(w[it].w) * r * g1[3]);
            *(u32x4*)(rp + ch * 8) = o; }
    }
}

__device__ __forceinline__ void gmlp_task(LAS unsigned char* lds, const bf16_t* zina, const bf16_t* wsb, const float* vg, const float* bs, bf16_t* y, int task) {
    const int tid = tid_l(), lane = tid & 63, wid = tid >> 6, fr = lane & 15, fq = lane >> 4;
    const int cidx = task / 6, h = task - cidx * 6, t0 = cidx * 128;
    LAS bf16_t* vT = (LAS bf16_t*)lds;
    { const int k = tid >> 2, dq = (tid & 3) * 32;
      const bf16_t* src = zina + (size_t)(t0 + k) * 1536 + 768 + h * 128 + dq;
      u32x4 w[4]; float ss = 0.f;
#pragma unroll
      for (int q = 0; q < 4; ++q) { w[q] = *(const u32x4*)(src + q * 8);
#pragma unroll
          for (int e = 0; e < 4; ++e) { const float a0 = bf_lo(w[q][e]), a1 = bf_hi(w[q][e]); ss += a0 * a0 + a1 * a1; } }
      ss += __shfl_xor(ss, 1); ss += __shfl_xor(ss, 2);
      const float r = 1.0f / sqrtf(ss * (1.0f / 128.0f) + EPS);
#pragma unroll
      for (int q = 0; q < 4; ++q)
#pragma unroll
          for (int e = 0; e < 4; ++e) { const int d = dq + q * 8 + e * 2;
              vT[d * 136 + k] = f2bf(bf_lo(w[q][e]) * r * vg[h * 128 + d]); vT[(d + 1) * 136 + k] = f2bf(bf_hi(w[q][e]) * r * vg[h * 128 + d + 1]); } }
    __syncthreads();
    const int q0 = (wid >> 1) * 32, d0 = (wid & 1) * 64;
    f32x4 acc[2][4];
#pragma unroll
    for (int mq = 0; mq < 2; ++mq)
#pragma unroll
        for (int nd = 0; nd < 4; ++nd) acc[mq][nd] = (f32x4){0.f, 0.f, 0.f, 0.f};
#pragma unroll
    for (int ks = 0; ks < 4; ++ks) {
        bf16x8 af[2], bfr[4];
#pragma unroll
        for (int mq = 0; mq < 2; ++mq) af[mq] = *(const bf16x8*)(wsb + (size_t)(h * 128 + q0 + mq * 16 + fr) * 128 + ks * 32 + fq * 8);
#pragma unroll
        for (int nd = 0; nd < 4; ++nd) bfr[nd] = *(const LAS bf16x8*)(vT + (d0 + nd * 16 + fr) * 136 + ks * 32 + fq * 8);
#pragma unroll
        for (int mq = 0; mq < 2; ++mq)
#pragma unroll
            for (int nd = 0; nd < 4; ++nd) acc[mq][nd] = __builtin_amdgcn_mfma_f32_16x16x32_bf16(bfr[nd], af[mq], acc[mq][nd], 0, 0, 0);
    }
#pragma unroll
    for (int mq = 0; mq < 2; ++mq) { const int q = q0 + mq * 16 + fr; const float b = bs[h * 128 + q];
#pragma unroll
        for (int nd = 0; nd < 4; ++nd) { const int d = d0 + nd * 16 + 4 * fq;
            const u32x2 uu = *(const u32x2*)(zina + (size_t)(t0 + q) * 1536 + h * 128 + d);
            const f32x4 m = acc[mq][nd] + b;
            u32x2 o; o.x = cvt_pk_bf16(bf_lo(uu.x) * m[0], bf_hi(uu.x) * m[1]); o.y = cvt_pk_bf16(bf_lo(uu.y) * m[2], bf_hi(uu.y) * m[3]);
            *(u32x2*)(y + (size_t)(t0 + q) * 2048 + h * 128 + d) = o; } }
    __syncthreads();
}

__device__ __forceinline__ void carry_scan(const float* xs, const float* ALp, bf16_t* ucat, int bx) {
    const int idx = bx * NTHREADS + tid_l();
    if (idx >= 48 * 6 * 128) return;
    const int p = idx & 63, dir = (idx >> 6) & 1, b = (idx >> 7) % 6, g = idx / 768;
    const f32x2 aL = *(const f32x2*)(ALp + ((g * 2 + dir) * 64 + p) * 2);
    float hr = 0.f, hi = 0.f;
#pragma unroll 8
    for (int s = 0; s < 128; ++s) { const int c = dir == 0 ? s : 127 - s; const size_t chunk = (size_t)g * 768 + b * 128 + c;
        const f32x2 x = *(const f32x2*)(xs + chunk * 256 + dir * 128 + p * 2);
        *(unsigned*)(ucat + chunk * 768 + 512 + dir * 128 + p * 2) = cvt_pk_bf16(hr, hi);
        const float nr = aL.x * hr - aL.y * hi + x.x, ni = aL.x * hi + aL.y * hr + x.y; hr = nr; hi = ni; }
}

constexpr int N_PHASES = 23;
__global__ void __launch_bounds__(NTHREADS, 2) mega_fwd(Args a) {
    extern __shared__ __attribute__((aligned(16))) unsigned char lds_raw[];
    LAS unsigned char* lds = (LAS unsigned char*)lds_raw;
    cg::grid_group grid = cg::this_grid();
#define WINAC ((bf16_t*)(ws + WS_WINAC))
#define WINBF ((bf16_t*)(ws + WS_WINBF))
#define WOUT  ((bf16_t*)(ws + WS_WOUT))
#define WGLU  ((bf16_t*)(ws + WS_WGLU))
#define WSB   ((bf16_t*)(ws + WS_WS))
#define WGU   ((bf16_t*)(ws + WS_WGU))
#define WDOWN ((bf16_t*)(ws + WS_WDOWN))
#define DFT   ((bf16_t*)(ws + WS_DFT))
#define AL    ((float*)(ws + WS_AL))
#define SLOT1 ((bf16_t*)(ws + WS_SLOT1))
#define ZINA  ((bf16_t*)(ws + WS_ZINA))
#define ZFT   ((bf16_t*)(ws + WS_ZFT))
#define YCPRE ((bf16_t*)(ws + WS_YCPRE))
#define UCAT  ((bf16_t*)(ws + WS_UCAT))
#define XS    ((float*)(ws + WS_XS))
#define TE    ((bf16_t*)(ws + WS_TE))
#define GM    ((bf16_t*)(ws + WS_GM))
#define HID   ((bf16_t*)(ws + WS_HID))
    int ph = 0;
#ifndef ONLY_PH
#define ONLY_PH -1
#endif
#ifndef PROBE_DUP
#define PROBE_DUP -1
#endif
#define PH_BEGIN(k) if ((ONLY_PH < 0 || ONLY_PH == (k)) && ph >= a.ph_lo && ph < a.ph_hi) { const int nrep_ = ((k) == PROBE_DUP) ? 2 : 1; for (int rep_ = 0; rep_ < nrep_; ++rep_) { unsigned char* ws = a.ws; float* X = a.out; int bx = blockIdx.x, G = gridDim.x; asm volatile("; PHASEMARK %4" : "+s"(ws), "+s"(X), "+s"(bx), "+s"(G) : "i"(k));
#define PH_END   if (rep_ + 1 < nrep_) grid.sync(); } if (ph + 1 < a.ph_hi) grid.sync(); } ++ph;

#pragma unroll 1
    for (int l = 0; l < 2; ++l) {
        PH_BEGIN(0)
            for (int g = bx; g < NGRP; g += G) s5_group_a(lds, a, l, g);
            for (int t = G - 1 - bx; t < NGRP * 8; t += G) s5_ktab(lds, a, l, t);
            for (int t = (bx + G - 48) % G; t < 128; t += G) winbf_task(lds, a.in[3] + (size_t)l * 2048 * INW, WINBF, t);
            if (l == 0) dft_gen(lds, DFT, bx, G);
            {
                const float* s = a.in[5] + (size_t)l * 6 * 128 * 128;
                for (int i = bx * NTHREADS + tid_l(); i < 6 * 128 * 128 / 2; i += G * NTHREADS) ((unsigned*)WSB)[i] = cvt_pk_bf16(s[2 * i], s[2 * i + 1]);
            }
            {
                const TrDesc td[7] = {
                    {a.in[3] + (size_t)l * 2048 * INW, INW, 2048, 0, 1536, WINAC, 0, 0},
                    {a.in[3] + (size_t)l * 2048 * INW, INW, 2048, 2048, 768, WINAC, 0, 1536},
                    {a.in[18] + (size_t)l * 2048 * 2048, 2048, 2048, 0, 2048, WOUT, 0, 0},
                    {a.in[15] + (size_t)l * 768 * 768, 768, 768, 0, 768, WGLU, 0, 0},
                    {a.in[20] + (size_t)l * 2048 * DFF, DFF, 2048, 0, DFF, WGU, 1, 0},
                    {a.in[21] + (size_t)l * 2048 * DFF, DFF, 2048, 0, DFF, WGU, 2, 0},
                    {a.in[22] + (size_t)l * DFF * 2048, 2048, DFF, 0, 2048, WDOWN, 0, 0}};
                const int ntile[7] = {32 * 6, 32 * 3, 32 * 8, 12 * 3, 32 * 22, 32 * 22, 88 * 8};
#pragma unroll
                for (int m = 0; m < 7; ++m) for (int t = bx; t < ntile[m]; t += G) transpose_tile(lds, td[m], t);
            }
            if (l == 0) rms_rows<0>(a.in[0], a.in[1], X, a.in[2], SLOT1, bx, G);
            else        rms_rows<1>(nullptr, nullptr, X, a.in[2] + l * 2048, SLOT1, bx, G);
        PH_END
        PH_BEGIN(1)
            { pg8::Sched S{(const char*)SLOT1, (const char*)WINAC, 0, 0, 2048, 2048, T / 256, 9, 1, G, bx}; EpiWin E{ZINA, UCAT}; pg8::gemm_phase(lds, S, 2048, E); }
            { pg8::Sched S{(const char*)WINBF, (const char*)SLOT1, 0, 0, 2048, 2048, 4, T / 256, 1, G, G - 1 - bx}; EpiZft E{ZFT}; pg8::gemm_phase(lds, S, 2048, E); }
        PH_END
        PH_BEGIN(2)
            const int nF = (G * 3) / 4, nR = G - nF;
            if (bx < nF) { pg8::Sched S{(const char*)DFT, (const char*)ZFT, 0, 8192 * 2, 8192, 49152, 16, 2, NBATCH, nF, bx}; EpiFour E{SLOT1}; pg8::gemm_phase(lds, S, 8192, E); }
            else {
                { pg8::Sched S{(const char*)UCAT, (const char*)GM, (long)768 * 768 * 2, (long)256 * 512 * 2, 768, 512, 3, 1, NGRP, nR, bx - nF}; EpiXs E{XS}; pg8::gemm_phase(lds, S, 512, E); }
                for (int t = bx - nF; t < 192 * 6; t += nR) gmlp_task(lds, ZINA, WSB, a.in[4] + l * 768, a.in[6] + l * 768, SLOT1, t);
            }
        PH_END
        PH_BEGIN(3)
            if (bx < 72) carry_scan(XS, AL, UCAT, bx);
            else for (int t = bx - 72; t < NGRP * 4; t += G - 72) s5_te(a, l, t);
        PH_END
        PH_BEGIN(4)
            { pg8::Sched S{(const char*)UCAT, (const char*)TE, (long)768 * 768 * 2, (long)512 * 768 * 2, 768, 768, 3, 2, NGRP, G, bx}; EpiYc E{YCPRE}; pg8::gemm_phase(lds, S, 768, E); }
        PH_END
        PH_BEGIN(5)
            { pg8::Sched S{(const char*)YCPRE, (const char*)WGLU, 0, 0, 768, 768, T / 256, 3, 1, G, bx}; EpiGlu E{YCPRE, a.in[16] + l * 768, SLOT1}; pg8::gemm_phase(lds, S, 768, E); }
        PH_END
        PH_BEGIN(6)
            outnorm_rows(SLOT1, a.in[17] + l * 2048, bx, G);
        PH_END
        PH_BEGIN(7)
            { pg8::Sched S{(const char*)SLOT1, (const char*)WOUT, 0, 0, 2048, 2048, T / 256, 8, 1, G, bx}; EpiRes E{X}; pg8::gemm_phase(lds, S, 2048, E); }
        PH_END
        PH_BEGIN(8)
            rms_rows<1>(nullptr, nullptr, X, a.in[19] + l * 2048, SLOT1, bx, G);
        PH_END
        PH_BEGIN(9)
            { pg8::Sched S{(const char*)SLOT1, (const char*)WGU, 0, 0, 2048, 2048, T / 256, 44, 1, G, bx}; EpiSwi E{HID}; pg8::gemm_phase(lds, S, 2048, E); }
        PH_END
        PH_BEGIN(10)
            { pg8::Sched S{(const char*)HID, (const char*)WDOWN, 0, 0, DFF, DFF, T / 256, 8, 1, G, bx}; EpiRes E{X}; pg8::gemm_phase(lds, S, DFF, E); }
        PH_END
    }
    PH_BEGIN(11)
        rms_rows<2>(nullptr, nullptr, X, a.in[23], nullptr, bx, G);
    PH_END
#undef PH_BEGIN
#undef PH_END
}

extern "C" void kernel_launch(void* const* d_in, const int* in_sizes, int n_in, void* d_out, int out_size, void* d_ws, size_t ws_size, hipStream_t stream) {
    static int grid = 0;
    if (grid == 0) {
        if (n_in != 24 || out_size != T * DM || ws_size < WS_END) { fprintf(stderr, "kernel_launch: unexpected shapes / workspace (n_in %d out %d ws %zu need %zu)\n", n_in, out_size, ws_size, (size_t)WS_END); grid = -1; return; }
        int dev = 0, cus = 0, per_cu = 0;
        if (hipGetDevice(&dev) != hipSuccess || hipDeviceGetAttribute(&cus, hipDeviceAttributeMultiprocessorCount, dev) != hipSuccess) { grid = -1; return; }
        if (hipFuncSetAttribute((const void*)mega_fwd, hipFuncAttributeMaxDynamicSharedMemorySize, LDS_BYTES) != hipSuccess) { fprintf(stderr, "kernel_launch: hipFuncSetAttribute failed\n"); grid = -1; return; }
        if (hipOccupancyMaxActiveBlocksPerMultiprocessor(&per_cu, (const void*)mega_fwd, NTHREADS, LDS_BYTES) != hipSuccess || per_cu < 1) { fprintf(stderr, "kernel_launch: occupancy query says %d\n", per_cu); per_cu = 1; }
        (void)hipGetLastError();
        grid = cus * 1;
    }
    if (grid < 0) return;
    Args a{};
    for (int i = 0; i < 24; ++i) a.in[i] = (const float*)d_in[i];
    a.out = (float*)d_out; a.ws = (unsigned char*)d_ws;
#if MK_ONE_LAUNCH
    a.ph_lo = 0; a.ph_hi = N_PHASES;
    void* args[] = {&a};
    hipError_t e = hipLaunchCooperativeKernel((const void*)mega_fwd, dim3(grid), dim3(NTHREADS), args, LDS_BYTES, stream);
    if (e != hipSuccess) fprintf(stderr, "cooperative launch failed: %s (grid %d)\n", hipGetErrorString(e), grid);
#else
    for (int p = 0; p < N_PHASES; ++p) {
        a.ph_lo = p; a.ph_hi = p + 1;
        hipLaunchKernelGGL(mega_fwd, dim3(grid), dim3(NTHREADS), LDS_BYTES, stream, a);
    }
#endif
}
```

```cpp
#include <hip/hip_runtime.h>
#include <hip/hip_cooperative_groups.h>
#include <cstdio>
#include <cstdint>
namespace cg = cooperative_groups;

#ifndef MK_ONE_LAUNCH
#define MK_ONE_LAUNCH 1
#endif

#define LAS __attribute__((address_space(3)))
typedef unsigned short bf16_t;
typedef short bf16x8 __attribute__((ext_vector_type(8)));
typedef float f32x4 __attribute__((ext_vector_type(4)));
typedef float f32x2 __attribute__((ext_vector_type(2)));
typedef unsigned u32x4 __attribute__((ext_vector_type(4)));
typedef unsigned u32x2 __attribute__((ext_vector_type(2)));

constexpr int T = 24576, DM = 2048, NBATCH = 6, SEQ = 4096, DFF = 5632, INW = 2816;
constexpr int NGRP = 48, NCHUNK = T / 32;
constexpr float EPS = 1e-6f;
constexpr int NTHREADS = 512;
constexpr int LDS_BYTES = 131072 + 1024;

constexpr size_t WS_WINAC = 0;
constexpr size_t WS_WINBF = WS_WINAC + (size_t)2304 * 2048 * 2;
constexpr size_t WS_WOUT  = WS_WINBF + (size_t)1024 * 2048 * 2;
constexpr size_t WS_WGLU  = WS_WOUT + (size_t)2048 * 2048 * 2;
constexpr size_t WS_WS    = WS_WGLU + (size_t)768 * 768 * 2;
constexpr size_t WS_WGU   = WS_WS + (size_t)6 * 128 * 128 * 2;
constexpr size_t WS_WDOWN = WS_WGU + (size_t)11264 * 2048 * 2;
constexpr size_t WS_DFT   = WS_WDOWN + (size_t)2048 * 5632 * 2;
constexpr size_t WS_VT    = WS_DFT;
constexpr size_t WS_D256  = WS_DFT + (size_t)49152 * 512 * 2;
constexpr size_t WS_AL    = WS_DFT + (size_t)4096 * 8192 * 2;
constexpr size_t WS_APW   = WS_AL + (size_t)48 * 2 * 64 * 2 * 4;
constexpr size_t WS_KT    = WS_APW + (size_t)48 * 2 * 33 * 64 * 2 * 4;
constexpr size_t WS_SLOT1 = WS_KT + (size_t)48 * 2 * 32 * 256 * 4;
constexpr size_t WS_ACT   = WS_SLOT1 + (size_t)T * 2048 * 2;
constexpr size_t WS_ZINA  = WS_ACT;
constexpr size_t WS_ZFT   = WS_ZINA + (size_t)T * 1536 * 2;
constexpr size_t WS_YCPRE = WS_ZFT;
constexpr size_t WS_UCAT  = WS_ZFT + (size_t)512 * 49152 * 2;
constexpr size_t WS_XS    = WS_UCAT + (size_t)48 * 768 * 768 * 2;
constexpr size_t WS_TE    = WS_XS + (size_t)48 * 768 * 256 * 4;
constexpr size_t WS_GM    = WS_TE + (size_t)48 * 512 * 768 * 2;
constexpr size_t WS_MIXEND = WS_GM + (size_t)48 * 256 * 512 * 2;
constexpr size_t WS_HID   = WS_ACT;
constexpr size_t WS_END   = WS_ACT + (size_t)T * 5632 * 2;
static_assert(WS_MIXEND <= WS_END, "mixer buffers must fit under the FFN hidden buffer");

struct Args { const float* in[24]; float* out; unsigned char* ws; int ph_lo, ph_hi; };

__device__ __forceinline__ int tid_l() { int t = threadIdx.x; asm volatile("" : "+v"(t)); return t; }
__device__ __forceinline__ unsigned cvt_pk_bf16(float lo, float hi) { unsigned r; asm("v_cvt_pk_bf16_f32 %0, %1, %2" : "=v"(r) : "v"(lo), "v"(hi)); return r; }
__device__ __forceinline__ float bf_lo(unsigned w) { return __uint_as_float(w << 16); }
__device__ __forceinline__ float bf_hi(unsigned w) { return __uint_as_float(w & 0xffff0000u); }
__device__ __forceinline__ bf16_t f2bf(float f) { return (bf16_t)(cvt_pk_bf16(f, 0.f) & 0xffffu); }
__device__ __forceinline__ float sigmoid_f(float v) { return __builtin_amdgcn_rcpf(1.0f + __builtin_amdgcn_exp2f(-1.4426950409f * v)); }
__device__ __forceinline__ float gelu_tanh(float x) { const float z = x * (1.5957691216f + 0.0713548163f * x * x); return x * sigmoid_f(z); }
__device__ __forceinline__ float wave_sum(float v) {
#pragma unroll
    for (int o = 32; o >= 1; o >>= 1) v += __shfl_xor(v, o);
    return v;
}

namespace pg8 {
constexpr int BM = 256, BK = 64, HALF = 128, HTB = HALF * BK * 2, STAGE_BYTES = 8 * HTB, NXCD = 8, WGM = 8;
__device__ __forceinline__ int lds_byte(int r, int c) { const int st = (r >> 4) * 2 + (c >> 5), rr = r & 15, cc = c & 31, ob = rr * 64 + cc * 2; return st * 1024 + (ob ^ (((ob >> 9) & 1) << 5)); }
__device__ __forceinline__ void stage_rc(int b, int& R, int& C) { const int st = b / 1024, sb = b % 1024, swz = sb ^ (((sb >> 9) & 1) << 5); R = (st >> 1) * 16 + swz / 64; C = (st & 1) * 32 + (swz % 64) / 2; }
__device__ __forceinline__ int perm32(int rho) { const int n = rho >> 4, i = rho & 15; return 8 * (i >> 2) + 4 * n + (i & 3); }

struct Unit { const char* A; const char* B; int pm, pn, grp; };
struct Sched {
    const char* A; const char* B; long gsA, gsB; int lda, ldb, nM, nN, nG, G, c, bmap;
    __device__ __forceinline__ bool next(int i, Unit& u) const {
        const int nwg = nM * nN;
        const long L = (long)i * G + c; if (c < 0 || L >= (long)nwg * nG) return false;
        const int grp = (int)(L / nwg); int wgid = (int)(L - (long)grp * nwg);
        { const int q = nwg / NXCD, r = nwg % NXCD, xcd = wgid % NXCD, off = wgid / NXCD; wgid = (xcd < r ? xcd * (q + 1) : r * (q + 1) + (xcd - r) * q) + off; }
        const int nig = WGM * nN, gid = wgid / nig, fm = gid * WGM, gsz = (nM - fm) < WGM ? (nM - fm) : WGM;
        u.pm = fm + ((wgid % nig) % gsz); u.pn = (wgid % nig) / gsz; u.grp = grp;
        u.A = A + (size_t)grp * gsA + (size_t)u.pm * 512 * lda; u.B = B + (size_t)grp * gsB + (bmap ? (size_t)((u.pn >> 4) * 4096 + (u.pn & 15) * 16) * 2 * ldb : (size_t)u.pn * 512 * ldb);
        return true;
    }
};

template <class Epi>
__device__ __forceinline__ void gemm_phase(LAS unsigned char* lds, const Sched& S, const int K, const Epi& E) {
    int tid = threadIdx.x; asm volatile("" : "+v"(tid));
    const int wid = __builtin_amdgcn_readfirstlane(tid >> 6), lane = tid & 63, wr = wid >> 2, wc = wid & 3, fr = lane & 15, fq = lane >> 4;
    const int nt = K / BK;
    unsigned voffA[2], voffB[2];
#pragma unroll
    for (int i = 0; i < 2; ++i) { int R, C; stage_rc(tid * 16 + i * 8192, R, C); const int Rb = Epi::PERM ? ((R & ~31) + perm32(R & 31)) : R;
        const int RbT = Epi::BMAP ? ((Rb >> 4) + 256 * (Rb & 15)) : Rb;
        voffA[i] = (unsigned)(R * S.lda + C) * 2u; voffB[i] = (unsigned)(RbT * S.ldb + C) * 2u; }
    const size_t kstep = (size_t)(BK * 2);
    const size_t hstepA = (size_t)HALF * S.lda * 2, hstepB = (size_t)(Epi::BMAP ? 8 : HALF) * S.ldb * 2;
    const unsigned ldsw = (unsigned)wid * 1024u;
    const int aoff = lds_byte(wr * 64 + fr, fq * 8), boff = lds_byte(wc * 32 + fr, fq * 8);
#define PG8_SA(b, h) (((b) * 2 + (h)) * HTB)
#define PG8_SB(b, h) ((4 + (b) * 2 + (h)) * HTB)
#define PG8_STAGE(bufoff, gbase, voff) do { _Pragma("unroll") for (int _i = 0; _i < 2; ++_i) \
        __builtin_amdgcn_global_load_lds((const unsigned*)((const char*)(gbase) + (voff)[_i]), (LAS unsigned*)(lds + (bufoff) + ldsw + _i * 8192), 16, 0, 0); } while (0)
#define PG8_LDA(dst, b, h) do { _Pragma("unroll") for (int m = 0; m < 4; ++m) _Pragma("unroll") for (int k = 0; k < 2; ++k) dst[m][k] = *(const LAS bf16x8*)(lds + PG8_SA(b, h) + aoff + m * 2048 + k * 1024); } while (0)
#define PG8_LDB(dst, b, h) do { _Pragma("unroll") for (int n = 0; n < 2; ++n) _Pragma("unroll") for (int k = 0; k < 2; ++k) dst[n][k] = *(const LAS bf16x8*)(lds + PG8_SB(b, h) + boff + n * 2048 + k * 1024); } while (0)
#define PG8_MMA(ai, bj, At, Bt) do { __builtin_amdgcn_s_setprio(1); _Pragma("unroll") for (int m = 0; m < 4; ++m) _Pragma("unroll") for (int n = 0; n < 2; ++n) _Pragma("unroll") for (int k = 0; k < 2; ++k) \
        acc[ai][bj][m][n] = __builtin_amdgcn_mfma_f32_16x16x32_bf16(Bt[n][k], At[m][k], acc[ai][bj][m][n], 0, 0, 0); __builtin_amdgcn_s_setprio(0); } while (0)
#define PG8_WAIT_V(n) asm volatile("s_waitcnt vmcnt(" #n ")" ::: "memory")
#define PG8_WAIT_L(n) asm volatile("s_waitcnt lgkmcnt(" #n ")" ::: "memory")
#define PG8_BAR __builtin_amdgcn_s_barrier()
#define PG8_SCHED __builtin_amdgcn_sched_barrier(0)
    Unit cur, nxt; int ui = 0;
    if (!S.next(0, cur)) return;
    f32x4 acc[2][2][4][2];
#pragma unroll
    for (int a = 0; a < 2; ++a)
#pragma unroll
        for (int b = 0; b < 2; ++b)
#pragma unroll
            for (int m = 0; m < 4; ++m)
#pragma unroll
                for (int n = 0; n < 2; ++n) acc[a][b][m][n] = (f32x4){0.f, 0.f, 0.f, 0.f};
    bf16x8 At[4][2], B0[2][2], B1[2][2];
    const char* cA = cur.A; const char* cB = cur.B;
    PG8_STAGE(PG8_SB(0, 0), cB, voffB); PG8_STAGE(PG8_SB(0, 1), cB + hstepB, voffB); PG8_STAGE(PG8_SA(0, 0), cA, voffA); PG8_STAGE(PG8_SA(0, 1), cA + hstepA, voffA);
    if (wr == 1) PG8_BAR;
    PG8_WAIT_V(2); PG8_BAR;
    PG8_STAGE(PG8_SB(1, 0), cB + kstep, voffB); PG8_STAGE(PG8_SA(1, 0), cA + kstep, voffA); PG8_STAGE(PG8_SB(1, 1), cB + hstepB + kstep, voffB);
    PG8_WAIT_V(6); PG8_BAR;
    for (;;) {
        const bool has_next = S.next(ui + 1, nxt);
        const char* nA = has_next ? nxt.A : cA; const char* nB = has_next ? nxt.B : cB;
        for (int t = 0; t < nt; t += 2) {
            const bool last = (t == nt - 2);
            const char* a1 = cA + (size_t)(t + 1) * kstep;
            const char* a2 = last ? nA : cA + (size_t)(t + 2) * kstep; const char* b2 = last ? nB : cB + (size_t)(t + 2) * kstep;
            const char* a3 = a2 + kstep; const char* b3 = b2 + kstep;
            PG8_LDB(B0, 0, 0); PG8_LDB(B1, 0, 1); PG8_SCHED; PG8_LDA(At, 0, 0); PG8_STAGE(PG8_SA(1, 1), a1 + hstepA, voffA);
            PG8_WAIT_V(8); PG8_WAIT_L(0); PG8_BAR; PG8_MMA(0, 0, At, B0); PG8_MMA(0, 1, At, B1); PG8_BAR; PG8_SCHED;
            PG8_LDA(At, 0, 1); PG8_STAGE(PG8_SB(0, 0), b2, voffB); PG8_STAGE(PG8_SB(0, 1), b2 + hstepB, voffB); PG8_STAGE(PG8_SA(0, 0), a2, voffA);
            PG8_WAIT_V(8); PG8_WAIT_L(0); PG8_BAR; PG8_MMA(1, 0, At, B0); PG8_MMA(1, 1, At, B1); PG8_BAR; PG8_SCHED;
            PG8_LDB(B0, 1, 0); PG8_LDB(B1, 1, 1); PG8_SCHED; PG8_LDA(At, 1, 0); PG8_STAGE(PG8_SA(0, 1), a2 + hstepA, voffA);
            PG8_WAIT_V(8); PG8_WAIT_L(0); PG8_BAR; PG8_MMA(0, 0, At, B0); PG8_MMA(0, 1, At, B1); PG8_BAR; PG8_SCHED;
            PG8_LDA(At, 1, 1); PG8_STAGE(PG8_SB(1, 0), b3, voffB); PG8_STAGE(PG8_SB(1, 1), b3 + hstepB, voffB); PG8_STAGE(PG8_SA(1, 0), a3, voffA);
            PG8_WAIT_V(8); PG8_WAIT_L(0); PG8_BAR; PG8_MMA(1, 0, At, B0); PG8_MMA(1, 1, At, B1); PG8_BAR; PG8_SCHED;
        }
        if (wr == 0) PG8_BAR;
        E(acc, cur, wr, wc, fr, fq);
        if (!has_next) break;
#pragma unroll
        for (int a = 0; a < 2; ++a)
#pragma unroll
            for (int b = 0; b < 2; ++b)
#pragma unroll
                for (int m = 0; m < 4; ++m)
#pragma unroll
                    for (int n = 0; n < 2; ++n) acc[a][b][m][n] = (f32x4){0.f, 0.f, 0.f, 0.f};
        cur = nxt; cA = nA; cB = nB; ++ui;
        if (wr == 1) PG8_BAR;
    }
    PG8_WAIT_V(0);
    PG8_BAR;
#undef PG8_SA
#undef PG8_SB
#undef PG8_STAGE
#undef PG8_LDA
#undef PG8_LDB
#undef PG8_MMA
#undef PG8_WAIT_V
#undef PG8_WAIT_L
#undef PG8_BAR
#undef PG8_SCHED
}
}
using pg8::Unit;
typedef const f32x4 (&AccRef)[2][2][4][2];

__device__ __forceinline__ u32x4 pack8(f32x4 v0, f32x4 v1) { u32x4 w; w.x = cvt_pk_bf16(v0[0], v0[1]); w.y = cvt_pk_bf16(v0[2], v0[3]); w.z = cvt_pk_bf16(v1[0], v1[1]); w.w = cvt_pk_bf16(v1[2], v1[3]); return w; }
__device__ __forceinline__ f32x4 gelu4(f32x4 v) { return (f32x4){gelu_tanh(v[0]), gelu_tanh(v[1]), gelu_tanh(v[2]), gelu_tanh(v[3])}; }

struct EpiWin { static constexpr bool PERM = true; static constexpr int BMAP = 0; bf16_t* zina; bf16_t* ucat;
    __device__ __forceinline__ void operator()(AccRef acc, const Unit& u, int wr, int wc, int fr, int fq) const {
        const int row0 = u.pm * 256 + wr * 64 + fr;
        if (u.pn < 6) {
            const int col0 = u.pn * 256 + wc * 32 + 8 * fq;
#pragma unroll
            for (int ai = 0; ai < 2; ++ai)
#pragma unroll
                for (int m = 0; m < 4; ++m) { bf16_t* rowp = zina + (size_t)(row0 + ai * 128 + m * 16) * 1536 + col0;
#pragma unroll
                    for (int bj = 0; bj < 2; ++bj) *(u32x4*)(rowp + bj * 128) = pack8(gelu4(acc[ai][bj][m][0]), gelu4(acc[ai][bj][m][1])); }
        } else {
            const int cc0 = (u.pn - 6) * 256 + wc * 32 + 8 * fq;
#pragma unroll
            for (int ai = 0; ai < 2; ++ai)
#pragma unroll
                for (int m = 0; m < 4; ++m) { const int t = row0 + ai * 128 + m * 16, n = t >> 5, j = t & 31;
#pragma unroll
                    for (int bj = 0; bj < 2; ++bj) { const int cc = cc0 + bj * 128, g = cc >> 4, c0 = cc & 15;
                        *(u32x4*)(ucat + ((size_t)(g * 768 + n) * 768 + j * 16 + c0)) = pack8(acc[ai][bj][m][0], acc[ai][bj][m][1]); } }
        }
    } };
struct EpiZft2 { static constexpr bool PERM = true; static constexpr int BMAP = 1; bf16_t* zf2;
    __device__ __forceinline__ void operator()(AccRef acc, const Unit& u, int wr, int wc, int fr, int fq) const {
        const int row0 = u.pm * 256 + wr * 64 + fr, b = u.pn >> 4, n1b = (u.pn & 15) * 16 + 2 * wc + (fq >> 1), n20 = (fq & 1) * 8;
#pragma unroll
        for (int ai = 0; ai < 2; ++ai)
#pragma unroll
            for (int m = 0; m < 4; ++m) { const int r = row0 + ai * 128 + m * 16, ri = r >> 9, gc = r & 511;
#pragma unroll
                for (int bj = 0; bj < 2; ++bj) { const int n1 = n1b + 8 * bj;
                    *(u32x4*)(zf2 + ((((size_t)b * 512 + gc) * 256 + n1) * 32 + ri * 16 + n20)) = pack8(acc[ai][bj][m][0], acc[ai][bj][m][1]); } }
    } };
struct EpiFour2 { static constexpr bool PERM = true; static constexpr int BMAP = 0; bf16_t* y;
    __device__ __forceinline__ void operator()(AccRef acc, const Unit& u, int wr, int wc, int fr, int fq) const {
        const int bk = u.pn >> 1, b = bk >> 4, k2 = bk & 15, col0 = 768 + (u.pn & 1) * 256 + wc * 32 + 8 * fq, k10 = wr * 64 + fr;
#pragma unroll
        for (int ai = 0; ai < 2; ++ai)
#pragma unroll
            for (int m = 0; m < 4; ++m) { const int k1 = k10 + ai * 128 + m * 16; bf16_t* rowp = y + (size_t)(b * 4096 + 16 * k1 + k2) * 2048 + col0;
#pragma unroll
                for (int bj = 0; bj < 2; ++bj) *(u32x4*)(rowp + bj * 128) = pack8(acc[ai][bj][m][0], acc[ai][bj][m][1]); }
    } };
struct EpiXs { static constexpr bool PERM = false; static constexpr int BMAP = 0; float* xs;
    __device__ __forceinline__ void operator()(AccRef acc, const Unit& u, int wr, int wc, int fr, int fq) const {
        const int row0 = u.pm * 256 + wr * 64 + fr, col0 = wc * 32 + 4 * fq;
#pragma unroll
        for (int ai = 0; ai < 2; ++ai)
#pragma unroll
            for (int m = 0; m < 4; ++m) { float* rowp = xs + ((size_t)u.grp * 768 + row0 + ai * 128 + m * 16) * 256 + col0;
#pragma unroll
                for (int bj = 0; bj < 2; ++bj)
#pragma unroll
                    for (int n = 0; n < 2; ++n) *(f32x4*)(rowp + bj * 128 + n * 16) = acc[ai][bj][m][n]; }
    } };
struct EpiYc { static constexpr bool PERM = true; static constexpr int BMAP = 0; bf16_t* ycpre;
    __device__ __forceinline__ void operator()(AccRef acc, const Unit& u, int wr, int wc, int fr, int fq) const {
        const int row0 = u.pm * 256 + wr * 64 + fr, col0 = u.pn * 256 + wc * 32 + 8 * fq;
#pragma unroll
        for (int ai = 0; ai < 2; ++ai)
#pragma unroll
            for (int m = 0; m < 4; ++m) { const int n = row0 + ai * 128 + m * 16;
#pragma unroll
                for (int bj = 0; bj < 2; ++bj) { const int col = col0 + bj * 128, i = col >> 4, c0 = col & 15;
                    *(u32x4*)(ycpre + ((size_t)(n * 32 + i) * 768 + u.grp * 16 + c0)) = pack8(gelu4(acc[ai][bj][m][0]), gelu4(acc[ai][bj][m][1])); } }
    } };
struct EpiGlu { static constexpr bool PERM = true; static constexpr int BMAP = 0; const bf16_t* ycpre; const float* bias; bf16_t* y;
    __device__ __forceinline__ void operator()(AccRef acc, const Unit& u, int wr, int wc, int fr, int fq) const {
        const int row0 = u.pm * 256 + wr * 64 + fr, col0 = u.pn * 256 + wc * 32 + 8 * fq;
        f32x4 bv[2][2];
#pragma unroll
        for (int bj = 0; bj < 2; ++bj)
#pragma unroll
            for (int n = 0; n < 2; ++n) bv[bj][n] = *(const f32x4*)(bias + col0 + bj * 128 + 4 * n);
#pragma unroll
        for (int ai = 0; ai < 2; ++ai)
#pragma unroll
            for (int m = 0; m < 4; ++m) { const size_t t = (size_t)(row0 + ai * 128 + m * 16);
#pragma unroll
                for (int bj = 0; bj < 2; ++bj) { const int col = col0 + bj * 128;
                    const u32x4 yc = *(const u32x4*)(ycpre + t * 768 + col);
                    const f32x4 v0 = acc[ai][bj][m][0] + bv[bj][0], v1 = acc[ai][bj][m][1] + bv[bj][1];
                    const f32x4 o0 = (f32x4){bf_lo(yc.x) * sigmoid_f(v0[0]), bf_hi(yc.x) * sigmoid_f(v0[1]), bf_lo(yc.y) * sigmoid_f(v0[2]), bf_hi(yc.y) * sigmoid_f(v0[3])};
                    const f32x4 o1 = (f32x4){bf_lo(yc.z) * sigmoid_f(v1[0]), bf_hi(yc.z) * sigmoid_f(v1[1]), bf_lo(yc.w) * sigmoid_f(v1[2]), bf_hi(yc.w) * sigmoid_f(v1[3])};
                    *(u32x4*)(y + t * 2048 + 1280 + col) = pack8(o0, o1); } }
    } };
struct EpiRes { static constexpr bool PERM = false; static constexpr int BMAP = 0; float* x;
    __device__ __forceinline__ void operator()(AccRef acc, const Unit& u, int wr, int wc, int fr, int fq) const {
        const int row0 = u.pm * 256 + wr * 64 + fr, col0 = u.pn * 256 + wc * 32 + 4 * fq;
#pragma unroll
        for (int ai = 0; ai < 2; ++ai) {
            float* base = x + (size_t)(row0 + ai * 128) * 2048 + col0;
            f32x4 ld[4][2][2];
#pragma unroll
            for (int m = 0; m < 4; ++m)
#pragma unroll
                for (int bj = 0; bj < 2; ++bj)
#pragma unroll
                    for (int n = 0; n < 2; ++n) ld[m][bj][n] = *(const f32x4*)(base + (size_t)m * 16 * 2048 + bj * 128 + n * 16);
#pragma unroll
            for (int m = 0; m < 4; ++m)
#pragma unroll
                for (int bj = 0; bj < 2; ++bj)
#pragma unroll
                    for (int n = 0; n < 2; ++n) *(f32x4*)(base + (size_t)m * 16 * 2048 + bj * 128 + n * 16) = ld[m][bj][n] + acc[ai][bj][m][n];
            asm volatile("" ::: "memory"); }
    } };
struct EpiSwi { static constexpr bool PERM = true; static constexpr int BMAP = 0; bf16_t* hid;
    __device__ __forceinline__ void operator()(AccRef acc, const Unit& u, int wr, int wc, int fr, int fq) const {
        const int row0 = u.pm * 256 + wr * 64 + fr, col0 = u.pn * 128 + wc * 32 + 8 * fq;
#pragma unroll
        for (int ai = 0; ai < 2; ++ai)
#pragma unroll
            for (int m = 0; m < 4; ++m) {
                f32x4 o[2];
#pragma unroll
                for (int n = 0; n < 2; ++n) { const f32x4 g = acc[ai][0][m][n], up = acc[ai][1][m][n];
                    o[n] = (f32x4){g[0] * sigmoid_f(g[0]) * up[0], g[1] * sigmoid_f(g[1]) * up[1], g[2] * sigmoid_f(g[2]) * up[2], g[3] * sigmoid_f(g[3]) * up[3]}; }
                *(u32x4*)(hid + (size_t)(row0 + ai * 128 + m * 16) * 5632 + col0) = pack8(o[0], o[1]); }
    } };

struct TrDesc { const float* src; int ldsrc, K, c0, nc; bf16_t* dst; int mode, doff; };
__device__ __forceinline__ void transpose_tile(LAS unsigned char* lds, const TrDesc& d, int tile) {
    const int tid = tid_l(), nkt = d.K >> 6, kt = tile % nkt, ct = tile / nkt;
    LAS bf16_t* tl = (LAS bf16_t*)lds;
    { const int k = tid >> 3, n8 = (tid & 7) * 8;
      const float* s = d.src + (size_t)(kt * 64 + k) * d.ldsrc + d.c0 + ct * 256 + n8;
      f32x4 v[4][2];
#pragma unroll
      for (int q = 0; q < 4; ++q) { v[q][0] = *(const f32x4*)(s + q * 64); v[q][1] = *(const f32x4*)(s + q * 64 + 4); }
#pragma unroll
      for (int q = 0; q < 4; ++q)
#pragma unroll
          for (int j = 0; j < 4; ++j) { tl[(q * 64 + n8 + j) * 66 + k] = f2bf(v[q][0][j]); tl[(q * 64 + n8 + 4 + j) * 66 + k] = f2bf(v[q][1][j]); } }
    __syncthreads();
    { const int n = tid >> 3, k8 = (tid & 7) * 8;
#pragma unroll
      for (int q = 0; q < 4; ++q) {
          const LAS unsigned* p = (const LAS unsigned*)(tl + (q * 64 + n) * 66 + k8);
          u32x4 w; w.x = p[0]; w.y = p[1]; w.z = p[2]; w.w = p[3];
          const int cc = ct * 256 + q * 64 + n;
          const int drow = d.mode == 0 ? d.doff + cc : ((cc >> 7) * 256 + (cc & 127) + (d.mode == 2 ? 128 : 0));
          *(u32x4*)(d.dst + (size_t)drow * d.K + kt * 64 + k8) = w; } }
    __syncthreads();
}

__device__ __forceinline__ double kd(double c) { asm volatile("" : "+v"(c)); return c; }
__device__ __forceinline__ double exp_d(double x) {
    const double y = x * 0.125; double term = 1.0, sum = 1.0;
#pragma unroll 1
    for (int n = 1; n <= 22; ++n) { term *= y / (double)n; sum += term; }
    sum *= sum; sum *= sum; sum *= sum; return sum;
}
__device__ __forceinline__ void sincos_d(double x, double& s, double& c) {
    const double k = rint(x * kd(0.15915494309189535));
    double r = fma(-k, kd(6.283185307179586232), x); r = fma(-k, kd(2.4492935982947064e-16), r);
    const double y = r * 0.125, my2 = -(y * y);
    double sn = y, cs = 1.0, ts = y, tc = 1.0;
#pragma unroll 1
    for (int n = 1; n <= 10; ++n) { tc *= my2 / (double)((2 * n - 1) * (2 * n)); cs += tc; ts *= my2 / (double)((2 * n) * (2 * n + 1)); sn += ts; }
#pragma unroll 1
    for (int i = 0; i < 3; ++i) { const double c2 = cs * cs - sn * sn, s2 = 2.0 * sn * cs; cs = c2; sn = s2; }
    s = sn; c = cs;
}

__device__ __forceinline__ void s5_disc(const Args& a, int l, int g, int dir, int p, double& ar, double& ai, double& qr, double& qi) {
    const double lr = (double)a.in[7][((l * 2 + dir) * 48 + g) * 64 + p], li = (double)a.in[8][((l * 2 + dir) * 48 + g) * 64 + p];
    const double st = exp_d((double)a.in[9][(l * 2 + dir) * 48 + g]);
    const double mag = exp_d(lr * st); double sn, cs; sincos_d(li * st, sn, cs);
    ar = mag * cs; ai = mag * sn; const double den = lr * lr + li * li, nr = ar - 1.0;
    qr = (nr * lr + ai * li) / den; qi = (ai * lr - nr * li) / den;
}
__device__ __forceinline__ void s5_group_a(LAS unsigned char* lds, const Args& a, int l, int g) {
    const int tid = tid_l();
    LAS float* apw = (LAS float*)lds;
    LAS float* bbr = apw + 2 * 33 * 64 * 2;
    bf16_t* GMp = (bf16_t*)(a.ws + WS_GM); float* ALp = (float*)(a.ws + WS_AL); float* APWp = (float*)(a.ws + WS_APW);
    if (tid < 128) {
        const int dir = tid >> 6, p = tid & 63;
        double ar, ai, qr, qi; s5_disc(a, l, g, dir, p, ar, ai, qr, qi);
        double pr = 1.0, pi = 0.0;
#pragma unroll 1
        for (int tau = 0; tau <= 32; ++tau) { const float fr_ = (float)pr, fi_ = (float)pi;
            apw[((dir * 33 + tau) * 64 + p) * 2] = fr_; apw[((dir * 33 + tau) * 64 + p) * 2 + 1] = fi_;
            *(f32x2*)(APWp + ((size_t)((g * 2 + dir) * 33 + tau) * 64 + p) * 2) = (f32x2){fr_, fi_};
            const double nr2 = pr * ar - pi * ai, ni2 = pr * ai + pi * ar; pr = nr2; pi = ni2; }
        ALp[((g * 2 + dir) * 64 + p) * 2] = apw[((dir * 33 + 32) * 64 + p) * 2]; ALp[((g * 2 + dir) * 64 + p) * 2 + 1] = apw[((dir * 33 + 32) * 64 + p) * 2 + 1];
#pragma unroll 1
        for (int c = 0; c < 16; ++c) { const double br = (double)a.in[10][((l * 48 + g) * 64 + p) * 16 + c], bi = (double)a.in[11][((l * 48 + g) * 64 + p) * 16 + c];
            bbr[((dir * 64 + p) * 16 + c) * 2] = (float)(qr * br - qi * bi); bbr[((dir * 64 + p) * 16 + c) * 2 + 1] = (float)(qr * bi + qi * br); }
    }
    __syncthreads();
    {
        const int row = tid >> 1, half = tid & 1, dir = row >> 7, p = (row >> 1) & 63, ri = row & 1;
        bf16_t* rowp = GMp + ((size_t)g * 256 + row) * 512;
        for (int jj = 0; jj < 16; ++jj) { const int j = half * 16 + jj, e = dir == 0 ? 31 - j : j;
            const float wr_ = apw[((dir * 33 + e) * 64 + p) * 2], wi_ = apw[((dir * 33 + e) * 64 + p) * 2 + 1];
            float v[16];
#pragma unroll
            for (int c2 = 0; c2 < 16; ++c2) { const float Br = bbr[((dir * 64 + p) * 16 + c2) * 2], Bi = bbr[((dir * 64 + p) * 16 + c2) * 2 + 1];
                v[c2] = ri == 0 ? wr_ * Br - wi_ * Bi : wr_ * Bi + wi_ * Br; }
            u32x4 w0, w1; w0.x = cvt_pk_bf16(v[0], v[1]); w0.y = cvt_pk_bf16(v[2], v[3]); w0.z = cvt_pk_bf16(v[4], v[5]); w0.w = cvt_pk_bf16(v[6], v[7]);
            w1.x = cvt_pk_bf16(v[8], v[9]); w1.y = cvt_pk_bf16(v[10], v[11]); w1.z = cvt_pk_bf16(v[12], v[13]); w1.w = cvt_pk_bf16(v[14], v[15]);
            *(u32x4*)(rowp + j * 16) = w0; *(u32x4*)(rowp + j * 16 + 8) = w1; }
    }
    __syncthreads();
}
__device__ __forceinline__ void s5_ktab(LAS unsigned char* lds, const Args& a, int l, int task) {
    const int tid = tid_l(), g = task >> 3, dir = (task >> 2) & 1, tb = task & 3;
    LAS float* ap8 = (LAS float*)lds;
    LAS float* bbr = ap8 + 8 * 64 * 2;
    LAS float* ccx = bbr + 64 * 16 * 2;
    LAS float* cw  = ccx + 16 * 64 * 2;
    float* KTp = (float*)(a.ws + WS_KT);
    if (tid < 64) {
        const int p = tid; double ar, ai, qr, qi; s5_disc(a, l, g, dir, p, ar, ai, qr, qi);
        double pr = 1.0, pi = 0.0;
#pragma unroll 1
        for (int t = 0; t < tb * 8; ++t) { const double nr2 = pr * ar - pi * ai, ni2 = pr * ai + pi * ar; pr = nr2; pi = ni2; }
#pragma unroll 1
        for (int t = 0; t < 8; ++t) { ap8[(t * 64 + p) * 2] = (float)pr; ap8[(t * 64 + p) * 2 + 1] = (float)pi;
            const double nr2 = pr * ar - pi * ai, ni2 = pr * ai + pi * ar; pr = nr2; pi = ni2; }
#pragma unroll 1
        for (int c = 0; c < 16; ++c) { const double br = (double)a.in[10][((l * 48 + g) * 64 + p) * 16 + c], bi = (double)a.in[11][((l * 48 + g) * 64 + p) * 16 + c];
            bbr[(p * 16 + c) * 2] = (float)(qr * br - qi * bi); bbr[(p * 16 + c) * 2 + 1] = (float)(qr * bi + qi * br); }
    }
    for (int idx = tid; idx < 1024; idx += NTHREADS) { const int c = idx >> 6, p = idx & 63;
        ccx[idx * 2] = a.in[12][((l * 48 + g) * 16 + c) * 64 + p]; ccx[idx * 2 + 1] = a.in[13][((l * 48 + g) * 16 + c) * 64 + p]; }
    __syncthreads();
    for (int idx = tid; idx < 8192; idx += NTHREADS) { const int t = idx >> 10, cp = idx & 1023, p = idx & 63;
        const float Cr = ccx[cp * 2], Ci = ccx[cp * 2 + 1], wr_ = ap8[(t * 64 + p) * 2], wi_ = ap8[(t * 64 + p) * 2 + 1];
        cw[idx * 2] = Cr * wr_ - Ci * wi_; cw[idx * 2 + 1] = Cr * wi_ + Ci * wr_; }
    __syncthreads();
#pragma unroll
    for (int k = 0; k < 4; ++k) { const int o = tid + k * NTHREADS, t = o >> 8, c = (o >> 4) & 15, c2 = o & 15;
        float s = 0.f;
        for (int p = 0; p < 64; ++p) s += cw[((t * 16 + c) * 64 + p) * 2] * bbr[(p * 16 + c2) * 2] - cw[((t * 16 + c) * 64 + p) * 2 + 1] * bbr[(p * 16 + c2) * 2 + 1];
        KTp[((size_t)((g * 2 + dir) * 32 + tb * 8 + t)) * 256 + c * 16 + c2] = s; }
    __syncthreads();
}
__device__ __forceinline__ void s5_te(const Args& a, int l, int task) {
    const int tid = tid_l(), g = task >> 2, qd = task & 3, r = tid >> 2, sub = tid & 3, i = qd * 8 + (r >> 4), c = r & 15;
    const float* KTp = (const float*)(a.ws + WS_KT); const float* APWp = (const float*)(a.ws + WS_APW);
    bf16_t* rowp = (bf16_t*)(a.ws + WS_TE) + ((size_t)g * 512 + i * 16 + c) * 768;
    const float dsk = a.in[14][l * 768 + g * 16 + c];
    const float* kf = KTp + (size_t)((g * 2 + 0) * 32) * 256 + c * 16; const float* kb = KTp + (size_t)((g * 2 + 1) * 32) * 256 + c * 16;
#pragma unroll 2
    for (int jj = 0; jj < 8; ++jj) { const int j = sub * 8 + jj;
        f32x4 v[4];
        if (j < i) {
#pragma unroll
            for (int q = 0; q < 4; ++q) v[q] = *(const f32x4*)(kf + (i - j) * 256 + q * 4);
        } else if (j > i) {
#pragma unroll
            for (int q = 0; q < 4; ++q) v[q] = *(const f32x4*)(kb + (j - i) * 256 + q * 4);
        } else {
#pragma unroll
            for (int q = 0; q < 4; ++q) { v[q] = *(const f32x4*)(kf + q * 4) + *(const f32x4*)(kb + q * 4);
#pragma unroll
                for (int e = 0; e < 4; ++e) v[q][e] += (q * 4 + e == c) ? dsk : 0.f; }
        }
        *(u32x4*)(rowp + j * 16) = pack8(v[0], v[1]); *(u32x4*)(rowp + j * 16 + 8) = pack8(v[2], v[3]); }
    { const int dir = sub >> 1, p0 = (sub & 1) * 32, e = dir == 0 ? i + 1 : 32 - i;
      const float* cr = a.in[12] + ((l * 48 + g) * 16 + c) * 64 + p0; const float* ci = a.in[13] + ((l * 48 + g) * 16 + c) * 64 + p0;
      const float* aw = APWp + ((size_t)((g * 2 + dir) * 33 + e) * 64 + p0) * 2;
#pragma unroll 2
      for (int p4 = 0; p4 < 32; p4 += 4) { const f32x4 Cr = *(const f32x4*)(cr + p4), Ci = *(const f32x4*)(ci + p4), w0 = *(const f32x4*)(aw + p4 * 2), w1 = *(const f32x4*)(aw + p4 * 2 + 4);
          u32x4 ww; ww.x = cvt_pk_bf16(Cr[0] * w0[0] - Ci[0] * w0[1], -(Cr[0] * w0[1] + Ci[0] * w0[0])); ww.y = cvt_pk_bf16(Cr[1] * w0[2] - Ci[1] * w0[3], -(Cr[1] * w0[3] + Ci[1] * w0[2]));
          ww.z = cvt_pk_bf16(Cr[2] * w1[0] - Ci[2] * w1[1], -(Cr[2] * w1[1] + Ci[2] * w1[0])); ww.w = cvt_pk_bf16(Cr[3] * w1[2] - Ci[3] * w1[3], -(Cr[3] * w1[3] + Ci[3] * w1[2]));
          *(u32x4*)(rowp + 512 + dir * 128 + (p0 + p4) * 2) = ww; } }
}

__device__ __forceinline__ void winbf_task(LAS unsigned char* lds, const float* w_in_l, bf16_t* dst, int task) {
    const int tid = tid_l(), g = task & 3, k0 = (task >> 2) * 64;
    LAS float* Wt = (LAS float*)lds;
    LAS float* tc = Wt + 64 * 128; LAS float* ts = tc + 128;
    { const int k = tid >> 3, c16 = (tid & 7) * 16; const float* s = w_in_l + (size_t)(k0 + k) * INW + 1536 + g * 128 + c16;
#pragma unroll
      for (int q = 0; q < 4; ++q) *(LAS f32x4*)(Wt + k * 128 + c16 + q * 4) = *(const f32x4*)(s + q * 4); }
    if (tid < 128) { float sn, cs; sincospif((float)tid * (1.0f / 64.0f), &sn, &cs); tc[tid] = cs; ts[tid] = sn; }
    __syncthreads();
    const int cp = tid & 127, kq = tid >> 7;
    float aC[16], aS[16];
#pragma unroll
    for (int kk = 0; kk < 16; ++kk) { aC[kk] = 0.f; aS[kk] = 0.f; }
    for (int c = 0; c < 128; ++c) { const int idx = (c * cp) & 127; const float vc = tc[idx], vs = ts[idx];
#pragma unroll
        for (int kk = 0; kk < 16; ++kk) { const float w = Wt[(kq * 16 + kk) * 128 + c]; aC[kk] += w * vc; aS[kk] += w * vs; } }
    bf16_t* dc = dst + (size_t)(g * 128 + cp) * 2048 + k0 + kq * 16; bf16_t* ds = dst + (size_t)(512 + g * 128 + cp) * 2048 + k0 + kq * 16;
    u32x4 w; w.x = cvt_pk_bf16(aC[0], aC[1]); w.y = cvt_pk_bf16(aC[2], aC[3]); w.z = cvt_pk_bf16(aC[4], aC[5]); w.w = cvt_pk_bf16(aC[6], aC[7]); *(u32x4*)dc = w;
    w.x = cvt_pk_bf16(aC[8], aC[9]); w.y = cvt_pk_bf16(aC[10], aC[11]); w.z = cvt_pk_bf16(aC[12], aC[13]); w.w = cvt_pk_bf16(aC[14], aC[15]); *(u32x4*)(dc + 8) = w;
    w.x = cvt_pk_bf16(aS[0], aS[1]); w.y = cvt_pk_bf16(aS[2], aS[3]); w.z = cvt_pk_bf16(aS[4], aS[5]); w.w = cvt_pk_bf16(aS[6], aS[7]); *(u32x4*)ds = w;
    w.x = cvt_pk_bf16(aS[8], aS[9]); w.y = cvt_pk_bf16(aS[10], aS[11]); w.z = cvt_pk_bf16(aS[12], aS[13]); w.w = cvt_pk_bf16(aS[14], aS[15]); *(u32x4*)(ds + 8) = w;
    __syncthreads();
}

__device__ __forceinline__ void d256_gen(bf16_t* d256, int bx, int G) {
    for (int idx = bx * NTHREADS + tid_l(); idx < 256 * 512; idx += G * NTHREADS) { const int k1 = idx >> 9, ri = (idx >> 8) & 1, n1 = idx & 255, e = (n1 * k1) & 255;
        float sn, cs; sincospif((float)e * (1.0f / 128.0f), &sn, &cs);
        d256[idx] = f2bf((ri == 0 ? cs : -sn) * 0.0013810679320049757f); }
}
__device__ __forceinline__ void fft16_pass(LAS unsigned char* lds, const bf16_t* zf2, bf16_t* vt, int bx, int G) {
    const int tid = tid_l();
    LAS float* tw = (LAS float*)lds;
    for (int i = tid; i < 4096; i += NTHREADS) { float sn, cs; sincospif((float)i * (1.0f / 2048.0f), &sn, &cs); tw[2 * i] = cs; tw[2 * i + 1] = sn; }
    __syncthreads();
    const int n1 = tid & 255, sub = tid >> 8;
    for (int task = bx * 2 + sub; task < 3072; task += G * 2) {
        const bf16_t* src = zf2 + ((size_t)task * 256 + n1) * 32;
        const u32x4 w0 = *(const u32x4*)src, w1 = *(const u32x4*)(src + 8), w2 = *(const u32x4*)(src + 16), w3 = *(const u32x4*)(src + 24);
        float zr[16], zi[16];
#pragma unroll
        for (int e = 0; e < 4; ++e) { zr[2 * e] = bf_lo(w0[e]); zr[2 * e + 1] = bf_hi(w0[e]); zr[8 + 2 * e] = bf_lo(w1[e]); zr[8 + 2 * e + 1] = bf_hi(w1[e]);
                                      zi[2 * e] = bf_lo(w2[e]); zi[2 * e + 1] = bf_hi(w2[e]); zi[8 + 2 * e] = bf_lo(w3[e]); zi[8 + 2 * e + 1] = bf_hi(w3[e]); }
        float Ar[4][4], Ai[4][4];
#pragma unroll
        for (int q = 0; q < 4; ++q) {
            const float s0r = zr[q] + zr[8 + q], s0i = zi[q] + zi[8 + q], s1r = zr[q] - zr[8 + q], s1i = zi[q] - zi[8 + q];
            const float s2r = zr[4 + q] + zr[12 + q], s2i = zi[4 + q] + zi[12 + q], s3r = zr[4 + q] - zr[12 + q], s3i = zi[4 + q] - zi[12 + q];
            Ar[q][0] = s0r + s2r; Ai[q][0] = s0i + s2i; Ar[q][2] = s0r - s2r; Ai[q][2] = s0i - s2i;
            Ar[q][1] = s1r - s3i; Ai[q][1] = s1i + s3r; Ar[q][3] = s1r + s3i; Ai[q][3] = s1i - s3r; }
        const float c1 = 0.9238795325f, s1 = 0.3826834324f, c2 = 0.7071067812f;
#define CMUL(xr, xi, cr, ci) { const float t_ = xr * (cr) - xi * (ci); xi = xr * (ci) + xi * (cr); xr = t_; }
        CMUL(Ar[1][1], Ai[1][1], c1, s1) CMUL(Ar[1][2], Ai[1][2], c2, c2) CMUL(Ar[1][3], Ai[1][3], s1, c1)
        CMUL(Ar[2][1], Ai[2][1], c2, c2) CMUL(Ar[2][2], Ai[2][2], 0.f, 1.f) CMUL(Ar[2][3], Ai[2][3], -c2, c2)
        CMUL(Ar[3][1], Ai[3][1], s1, c1) CMUL(Ar[3][2], Ai[3][2], -c2, c2) CMUL(Ar[3][3], Ai[3][3], -c1, -s1)
#undef CMUL
        float xr[16], xi[16];
#pragma unroll
        for (int r = 0; r < 4; ++r) {
            const float s0r = Ar[0][r] + Ar[2][r], s0i = Ai[0][r] + Ai[2][r], s1r = Ar[0][r] - Ar[2][r], s1i = Ai[0][r] - Ai[2][r];
            const float s2r = Ar[1][r] + Ar[3][r], s2i = Ai[1][r] + Ai[3][r], s3r = Ar[1][r] - Ar[3][r], s3i = Ai[1][r] - Ai[3][r];
            xr[r] = s0r + s2r; xi[r] = s0i + s2i; xr[r + 8] = s0r - s2r; xi[r + 8] = s0i - s2i;
            xr[r + 4] = s1r - s3i; xi[r + 4] = s1i + s3r; xr[r + 12] = s1r + s3i; xi[r + 12] = s1i - s3r; }
        const int b = task >> 9, gc = task & 511;
        bf16_t* dst = vt + ((size_t)(b * 16) * 512 + gc) * 512 + n1;
#pragma unroll
        for (int k2 = 0; k2 < 16; ++k2) { const int idx = (n1 * k2) & 4095; const float c = tw[2 * idx], sn = tw[2 * idx + 1];
            dst[(size_t)k2 * 512 * 512] = f2bf(xr[k2] * c - xi[k2] * sn); dst[(size_t)k2 * 512 * 512 + 256] = f2bf(xr[k2] * sn + xi[k2] * c); }
    }
    __syncthreads();
}

template <int MODE>
__device__ __forceinline__ void rms_rows(const float* xp, const float* xs, float* xres, const float* gain, bf16_t* outb, int bx, int G) {
    const int tid = tid_l(), lane = tid & 63, wave = tid >> 6;
    f32x4 gv[8];
#pragma unroll
    for (int it = 0; it < 8; ++it) gv[it] = *(const f32x4*)(gain + it * 256 + lane * 4);
    for (int row = bx * 8 + wave; row < T; row += G * 8) {
        const float* src = MODE == 0 ? (row < 16384 ? xp + (size_t)row * 2048 : xs + (size_t)(row - 16384) * 2048) : xres + (size_t)row * 2048;
        f32x4 v[8]; float ss = 0.f;
#pragma unroll
        for (int it = 0; it < 8; ++it) { v[it] = *(const f32x4*)(src + it * 256 + lane * 4); ss += v[it][0] * v[it][0] + v[it][1] * v[it][1] + v[it][2] * v[it][2] + v[it][3] * v[it][3]; }
        ss = wave_sum(ss);
        const float r = 1.0f / sqrtf(ss * (1.0f / 2048.0f) + EPS);
#pragma unroll
        for (int it = 0; it < 8; ++it) {
            const f32x4 o = v[it] * r * gv[it];
            if (MODE == 0) *(f32x4*)(xres + (size_t)row * 2048 + it * 256 + lane * 4) = v[it];
            if (MODE == 2) *(f32x4*)(xres + (size_t)row * 2048 + it * 256 + lane * 4) = o;
            else { u32x2 w; w.x = cvt_pk_bf16(o[0], o[1]); w.y = cvt_pk_bf16(o[2], o[3]); *(u32x2*)(outb + (size_t)row * 2048 + it * 256 + lane * 4) = w; }
        }
    }
}

__device__ __forceinline__ void outnorm_rows(bf16_t* y, const float* og, int bx, int G) {
    const int tid = tid_l(), lane = tid & 63, wave = tid >> 6;
    for (int row = bx * 8 + wave; row < T; row += G * 8) {
        bf16_t* rp = y + (size_t)row * 2048;
        u32x4 w[4]; float ss[3] = {0.f, 0.f, 0.f};
#pragma unroll
        for (int it = 0; it < 4; ++it) { const int ch = it * 64 + lane; w[it] = *(const u32x4*)(rp + ch * 8);
            float s = 0.f;
#pragma unroll
            for (int q = 0; q < 4; ++q) { const float a0 = bf_lo(w[it][q]), a1 = bf_hi(w[it][q]); s += a0 * a0 + a1 * a1; }
            const int seg = ch < 96 ? 0 : (ch < 160 ? 1 : 2);
            ss[0] += seg == 0 ? s : 0.f; ss[1] += seg == 1 ? s : 0.f; ss[2] += seg == 2 ? s : 0.f; }
        ss[0] = wave_sum(ss[0]); ss[1] = wave_sum(ss[1]); ss[2] = wave_sum(ss[2]);
        const float r0 = 1.0f / sqrtf(ss[0] * (1.0f / 768.0f) + EPS), r1 = 1.0f / sqrtf(ss[1] * (1.0f / 512.0f) + EPS), r2 = 1.0f / sqrtf(ss[2] * (1.0f / 768.0f) + EPS);
#pragma unroll
        for (int it = 0; it < 4; ++it) { const int ch = it * 64 + lane; const float r = ch < 96 ? r0 : (ch < 160 ? r1 : r2);
            const f32x4 g0 = *(const f32x4*)(og + ch * 8), g1 = *(const f32x4*)(og + ch * 8 + 4);
            u32x4 o; o.x = cvt_pk_bf16(bf_lo(w[it].x) * r * g0[0], bf_hi(w[it].x) * r * g0[1]); o.y = cvt_pk_bf16(bf_lo(w[it].y) * r * g0[2], bf_hi(w[it].y) * r * g0[3]);
            o.z = cvt_pk_bf16(bf_lo(w[it].z) * r * g1[0], bf_hi(w[it].z) * r * g1[1]); o.w = cvt_pk_bf16(bf_lo(w[it].w) * r * g1[2], bf_hi(w[it].w) * r * g1[3]);
            *(u32x4*)(rp + ch * 8) = o; }
    }
}

__device__ __forceinline__ void gmlp_task(LAS unsigned char* lds, const bf16_t* zina, const bf16_t* wsb, const float* vg, const float* bs, bf16_t* y, int task) {
    const int tid = tid_l(), lane = tid & 63, wid = tid >> 6, fr = lane & 15, fq = lane >> 4;
    const int cidx = task / 6, h = task - cidx * 6, t0 = cidx * 128;
    LAS bf16_t* vT = (LAS bf16_t*)lds;
    { const int k = tid >> 2, dq = (tid & 3) * 32;
      const bf16_t* src = zina + (size_t)(t0 + k) * 1536 + 768 + h * 128 + dq;
      u32x4 w[4]; float ss = 0.f;
#pragma unroll
      for (int q = 0; q < 4; ++q) { w[q] = *(const u32x4*)(src + q * 8);
#pragma unroll
          for (int e = 0; e < 4; ++e) { const float a0 = bf_lo(w[q][e]), a1 = bf_hi(w[q][e]); ss += a0 * a0 + a1 * a1; } }
      ss += __shfl_xor(ss, 1); ss += __shfl_xor(ss, 2);
      const float r = 1.0f / sqrtf(ss * (1.0f / 128.0f) + EPS);
#pragma unroll
      for (int q = 0; q < 4; ++q)
#pragma unroll
          for (int e = 0; e < 4; ++e) { const int d = dq + q * 8 + e * 2;
              vT[d * 136 + k] = f2bf(bf_lo(w[q][e]) * r * vg[h * 128 + d]); vT[(d + 1) * 136 + k] = f2bf(bf_hi(w[q][e]) * r * vg[h * 128 + d + 1]); } }
    __syncthreads();
    const int q0 = (wid >> 1) * 32, d0 = (wid & 1) * 64;
    f32x4 acc[2][4];
#pragma unroll
    for (int mq = 0; mq < 2; ++mq)
#pragma unroll
        for (int nd = 0; nd < 4; ++nd) acc[mq][nd] = (f32x4){0.f, 0.f, 0.f, 0.f};
#pragma unroll
    for (int ks = 0; ks < 4; ++ks) {
        bf16x8 af[2], bfr[4];
#pragma unroll
        for (int mq = 0; mq < 2; ++mq) af[mq] = *(const bf16x8*)(wsb + (size_t)(h * 128 + q0 + mq * 16 + fr) * 128 + ks * 32 + fq * 8);
#pragma unroll
        for (int nd = 0; nd < 4; ++nd) bfr[nd] = *(const LAS bf16x8*)(vT + (d0 + nd * 16 + fr) * 136 + ks * 32 + fq * 8);
#pragma unroll
        for (int mq = 0; mq < 2; ++mq)
#pragma unroll
            for (int nd = 0; nd < 4; ++nd) acc[mq][nd] = __builtin_amdgcn_mfma_f32_16x16x32_bf16(bfr[nd], af[mq], acc[mq][nd], 0, 0, 0);
    }
#pragma unroll
    for (int mq = 0; mq < 2; ++mq) { const int q = q0 + mq * 16 + fr; const float b = bs[h * 128 + q];
#pragma unroll
        for (int nd = 0; nd < 4; ++nd) { const int d = d0 + nd * 16 + 4 * fq;
            const u32x2 uu = *(const u32x2*)(zina + (size_t)(t0 + q) * 1536 + h * 128 + d);
            const f32x4 m = acc[mq][nd] + b;
            u32x2 o; o.x = cvt_pk_bf16(bf_lo(uu.x) * m[0], bf_hi(uu.x) * m[1]); o.y = cvt_pk_bf16(bf_lo(uu.y) * m[2], bf_hi(uu.y) * m[3]);
            *(u32x2*)(y + (size_t)(t0 + q) * 2048 + h * 128 + d) = o; } }
    __syncthreads();
}

__device__ __forceinline__ void carry_scan(const float* xs, const float* ALp, bf16_t* ucat, int bx) {
    const int idx = bx * NTHREADS + tid_l();
    if (idx >= 48 * 6 * 128) return;
    const int p = idx & 63, dir = (idx >> 6) & 1, b = (idx >> 7) % 6, g = idx / 768;
    const f32x2 aL = *(const f32x2*)(ALp + ((g * 2 + dir) * 64 + p) * 2);
    float hr = 0.f, hi = 0.f;
#pragma unroll 8
    for (int s = 0; s < 128; ++s) { const int c = dir == 0 ? s : 127 - s; const size_t chunk = (size_t)g * 768 + b * 128 + c;
        const f32x2 x = *(const f32x2*)(xs + chunk * 256 + dir * 128 + p * 2);
        *(unsigned*)(ucat + chunk * 768 + 512 + dir * 128 + p * 2) = cvt_pk_bf16(hr, hi);
        const float nr = aL.x * hr - aL.y * hi + x.x, ni = aL.x * hi + aL.y * hr + x.y; hr = nr; hi = ni; }
}

constexpr int N_PHASES = 23;
__global__ void __launch_bounds__(NTHREADS, 2) mega_fwd(Args a) {
    extern __shared__ __attribute__((aligned(16))) unsigned char lds_raw[];
    LAS unsigned char* lds = (LAS unsigned char*)lds_raw;
    cg::grid_group grid = cg::this_grid();
#define WINAC ((bf16_t*)(ws + WS_WINAC))
#define WINBF ((bf16_t*)(ws + WS_WINBF))
#define WOUT  ((bf16_t*)(ws + WS_WOUT))
#define WGLU  ((bf16_t*)(ws + WS_WGLU))
#define WSB   ((bf16_t*)(ws + WS_WS))
#define WGU   ((bf16_t*)(ws + WS_WGU))
#define WDOWN ((bf16_t*)(ws + WS_WDOWN))
#define VT    ((bf16_t*)(ws + WS_VT))
#define D256  ((bf16_t*)(ws + WS_D256))
#define AL    ((float*)(ws + WS_AL))
#define SLOT1 ((bf16_t*)(ws + WS_SLOT1))
#define ZINA  ((bf16_t*)(ws + WS_ZINA))
#define ZFT   ((bf16_t*)(ws + WS_ZFT))
#define YCPRE ((bf16_t*)(ws + WS_YCPRE))
#define UCAT  ((bf16_t*)(ws + WS_UCAT))
#define XS    ((float*)(ws + WS_XS))
#define TE    ((bf16_t*)(ws + WS_TE))
#define GM    ((bf16_t*)(ws + WS_GM))
#define HID   ((bf16_t*)(ws + WS_HID))
    int ph = 0;
#ifndef ONLY_PH
#define ONLY_PH -1
#endif
#ifndef PROBE_DUP
#define PROBE_DUP -1
#endif
#define PH_BEGIN(k) if ((ONLY_PH < 0 || ONLY_PH == (k)) && ph >= a.ph_lo && ph < a.ph_hi) { const int nrep_ = ((k) == PROBE_DUP) ? 2 : 1; for (int rep_ = 0; rep_ < nrep_; ++rep_) { unsigned char* ws = a.ws; float* X = a.out; int bx = blockIdx.x, G = gridDim.x; asm volatile("; PHASEMARK %4" : "+s"(ws), "+s"(X), "+s"(bx), "+s"(G) : "i"(k));
#define PH_END   if (rep_ + 1 < nrep_) grid.sync(); } if (ph + 1 < a.ph_hi) grid.sync(); } ++ph;

#pragma unroll 1
    for (int l = 0; l < 2; ++l) {
        PH_BEGIN(0)
            for (int g = bx; g < NGRP; g += G) s5_group_a(lds, a, l, g);
            for (int t = G - 1 - bx; t < NGRP * 8; t += G) s5_ktab(lds, a, l, t);
            for (int t = (bx + G - 48) % G; t < 128; t += G) winbf_task(lds, a.in[3] + (size_t)l * 2048 * INW, WINBF, t);
            if (l == 0) d256_gen(D256, bx, G);
            {
                const float* s = a.in[5] + (size_t)l * 6 * 128 * 128;
                for (int i = bx * NTHREADS + tid_l(); i < 6 * 128 * 128 / 2; i += G * NTHREADS) ((unsigned*)WSB)[i] = cvt_pk_bf16(s[2 * i], s[2 * i + 1]);
            }
            {
                const TrDesc td[7] = {
                    {a.in[3] + (size_t)l * 2048 * INW, INW, 2048, 0, 1536, WINAC, 0, 0},
                    {a.in[3] + (size_t)l * 2048 * INW, INW, 2048, 2048, 768, WINAC, 0, 1536},
                    {a.in[18] + (size_t)l * 2048 * 2048, 2048, 2048, 0, 2048, WOUT, 0, 0},
                    {a.in[15] + (size_t)l * 768 * 768, 768, 768, 0, 768, WGLU, 0, 0},
                    {a.in[20] + (size_t)l * 2048 * DFF, DFF, 2048, 0, DFF, WGU, 1, 0},
                    {a.in[21] + (size_t)l * 2048 * DFF, DFF, 2048, 0, DFF, WGU, 2, 0},
                    {a.in[22] + (size_t)l * DFF * 2048, 2048, DFF, 0, 2048, WDOWN, 0, 0}};
                const int ntile[7] = {32 * 6, 32 * 3, 32 * 8, 12 * 3, 32 * 22, 32 * 22, 88 * 8};
#pragma unroll
                for (int m = 0; m < 7; ++m) for (int t = bx; t < ntile[m]; t += G) transpose_tile(lds, td[m], t);
            }
            if (l == 0) rms_rows<0>(a.in[0], a.in[1], X, a.in[2], SLOT1, bx, G);
            else        rms_rows<1>(nullptr, nullptr, X, a.in[2] + l * 2048, SLOT1, bx, G);
        PH_END
        PH_BEGIN(1)
            { pg8::Sched S{(const char*)SLOT1, (const char*)WINAC, 0, 0, 2048, 2048, T / 256, 9, 1, G, bx, 0}; EpiWin E{ZINA, UCAT}; pg8::gemm_phase(lds, S, 2048, E); }
            { pg8::Sched S{(const char*)WINBF, (const char*)SLOT1, 0, 0, 2048, 2048, 4, T / 256, 1, G, G - 1 - bx, 1}; EpiZft2 E{ZFT}; pg8::gemm_phase(lds, S, 2048, E); }
        PH_END
        PH_BEGIN(2)
            fft16_pass(lds, ZFT, VT, bx, G);
            { pg8::Sched S{(const char*)UCAT, (const char*)GM, (long)768 * 768 * 2, (long)256 * 512 * 2, 768, 512, 3, 1, NGRP, G, bx, 0}; EpiXs E{XS}; pg8::gemm_phase(lds, S, 512, E); }
            for (int t = G - 1 - bx; t < 192 * 6; t += G) gmlp_task(lds, ZINA, WSB, a.in[4] + l * 768, a.in[6] + l * 768, SLOT1, t);
        PH_END
        PH_BEGIN(3)
            if (bx < 72) carry_scan(XS, AL, UCAT, bx);
            else { for (int t = bx - 72; t < NGRP * 4; t += G - 72) s5_te(a, l, t);
                pg8::Sched S{(const char*)D256, (const char*)VT, 0, 0, 512, 512, 1, 192, 1, G - 72, bx - 72, 0}; EpiFour2 E{SLOT1}; pg8::gemm_phase(lds, S, 512, E); }
        PH_END
        PH_BEGIN(4)
            { pg8::Sched S{(const char*)UCAT, (const char*)TE, (long)768 * 768 * 2, (long)512 * 768 * 2, 768, 768, 3, 2, NGRP, G, bx, 0}; EpiYc E{YCPRE}; pg8::gemm_phase(lds, S, 768, E); }
        PH_END
        PH_BEGIN(5)
            { pg8::Sched S{(const char*)YCPRE, (const char*)WGLU, 0, 0, 768, 768, T / 256, 3, 1, G, bx, 0}; EpiGlu E{YCPRE, a.in[16] + l * 768, SLOT1}; pg8::gemm_phase(lds, S, 768, E); }
        PH_END
        PH_BEGIN(6)
            outnorm_rows(SLOT1, a.in[17] + l * 2048, bx, G);
        PH_END
        PH_BEGIN(7)
            { pg8::Sched S{(const char*)SLOT1, (const char*)WOUT, 0, 0, 2048, 2048, T / 256, 8, 1, G, bx, 0}; EpiRes E{X}; pg8::gemm_phase(lds, S, 2048, E); }
        PH_END
        PH_BEGIN(8)
            rms_rows<1>(nullptr, nullptr, X, a.in[19] + l * 2048, SLOT1, bx, G);
        PH_END
        PH_BEGIN(9)
            { pg8::Sched S{(const char*)SLOT1, (const char*)WGU, 0, 0, 2048, 2048, T / 256, 44, 1, G, bx, 0}; EpiSwi E{HID}; pg8::gemm_phase(lds, S, 2048, E); }
        PH_END
        PH_BEGIN(10)
            { pg8::Sched S{(const char*)HID, (const char*)WDOWN, 0, 0, DFF, DFF, T / 256, 8, 1, G, bx, 0}; EpiRes E{X}; pg8::gemm_phase(lds, S, DFF, E); }
        PH_END
    }
    PH_BEGIN(11)
        rms_rows<2>(nullptr, nullptr, X, a.in[23], nullptr, bx, G);
    PH_END
#undef PH_BEGIN
#undef PH_END
}

extern "C" void kernel_launch(void* const* d_in, const int* in_sizes, int n_in, void* d_out, int out_size, void* d_ws, size_t ws_size, hipStream_t stream) {
    static int grid = 0;
    if (grid == 0) {
        if (n_in != 24 || out_size != T * DM || ws_size < WS_END) { fprintf(stderr, "kernel_launch: unexpected shapes / workspace (n_in %d out %d ws %zu need %zu)\n", n_in, out_size, ws_size, (size_t)WS_END); grid = -1; return; }
        int dev = 0, cus = 0, per_cu = 0;
        if (hipGetDevice(&dev) != hipSuccess || hipDeviceGetAttribute(&cus, hipDeviceAttributeMultiprocessorCount, dev) != hipSuccess) { grid = -1; return; }
        if (hipFuncSetAttribute((const void*)mega_fwd, hipFuncAttributeMaxDynamicSharedMemorySize, LDS_BYTES) != hipSuccess) { fprintf(stderr, "kernel_launch: hipFuncSetAttribute failed\n"); grid = -1; return; }
        if (hipOccupancyMaxActiveBlocksPerMultiprocessor(&per_cu, (const void*)mega_fwd, NTHREADS, LDS_BYTES) != hipSuccess || per_cu < 1) { fprintf(stderr, "kernel_launch: occupancy query says %d\n", per_cu); per_cu = 1; }
        (void)hipGetLastError();
        grid = cus * 1;
    }
    if (grid < 0) return;
    Args a{};
    for (int i = 0; i < 24; ++i) a.in[i] = (const float*)d_in[i];
    a.out = (float*)d_out; a.ws = (unsigned char*)d_ws;
#if MK_ONE_LAUNCH
    a.ph_lo = 0; a.ph_hi = N_PHASES;
    void* args[] = {&a};
    hipError_t e = hipLaunchCooperativeKernel((const void*)mega_fwd, dim3(grid), dim3(NTHREADS), args, LDS_BYTES, stream);
    if (e != hipSuccess) fprintf(stderr, "cooperative launch failed: %s (grid %d)\n", hipGetErrorString(e), grid);
#else
    for (int p = 0; p < N_PHASES; ++p) {
        a.ph_lo = p; a.ph_hi = p + 1;
        hipLaunchKernelGGL(mega_fwd, dim3(grid), dim3(NTHREADS), LDS_BYTES, stream, a);
    }
#endif
}
```

```cpp
#include <hip/hip_runtime.h>
#include <hip/hip_cooperative_groups.h>
#include <cstdio>
#include <cstdint>
namespace cg = cooperative_groups;

#ifndef MK_ONE_LAUNCH
#define MK_ONE_LAUNCH 1
#endif

#define LAS __attribute__((address_space(3)))
typedef unsigned short bf16_t;
typedef short bf16x8 __attribute__((ext_vector_type(8)));
typedef float f32x4 __attribute__((ext_vector_type(4)));
typedef float f32x2 __attribute__((ext_vector_type(2)));
typedef unsigned u32x4 __attribute__((ext_vector_type(4)));
typedef unsigned u32x2 __attribute__((ext_vector_type(2)));

constexpr int T = 24576, DM = 2048, NBATCH = 6, SEQ = 4096, DFF = 5632, INW = 2816;
constexpr int NGRP = 48, NCHUNK = T / 32;
constexpr float EPS = 1e-6f;
constexpr int NTHREADS = 512;
constexpr int LDS_BYTES = 131072 + 1024;

constexpr size_t WS_WINAC = 0;
constexpr size_t WS_WINBF = WS_WINAC + (size_t)2304 * 2048 * 2;
constexpr size_t WS_WOUT  = WS_WINBF + (size_t)1024 * 2048 * 2;
constexpr size_t WS_WGLU  = WS_WOUT + (size_t)2048 * 2048 * 2;
constexpr size_t WS_WS    = WS_WGLU + (size_t)768 * 768 * 2;
constexpr size_t WS_WGU   = WS_WS + (size_t)6 * 128 * 128 * 2;
constexpr size_t WS_WDOWN = WS_WGU + (size_t)11264 * 2048 * 2;
constexpr size_t WS_DFT   = WS_WDOWN + (size_t)2048 * 5632 * 2;
constexpr size_t WS_VT    = WS_DFT;
constexpr size_t WS_D256  = WS_DFT + (size_t)49152 * 512 * 2;
constexpr size_t WS_AL    = WS_DFT + (size_t)4096 * 8192 * 2;
constexpr size_t WS_APW   = WS_AL + (size_t)48 * 2 * 64 * 2 * 4;
constexpr size_t WS_KT    = WS_APW + (size_t)48 * 2 * 33 * 64 * 2 * 4;
constexpr size_t WS_SLOT1 = WS_KT + (size_t)48 * 2 * 32 * 256 * 4;
constexpr size_t WS_ACT   = WS_SLOT1 + (size_t)T * 2048 * 2;
constexpr size_t WS_ZINA  = WS_ACT;
constexpr size_t WS_ZFT   = WS_ZINA + (size_t)T * 1536 * 2;
constexpr size_t WS_YCPRE = WS_ZFT;
constexpr size_t WS_UCAT  = WS_ZFT + (size_t)512 * 49152 * 2;
constexpr size_t WS_XS    = WS_UCAT + (size_t)48 * 768 * 768 * 2;
constexpr size_t WS_TE    = WS_XS + (size_t)48 * 768 * 256 * 4;
constexpr size_t WS_GM    = WS_TE + (size_t)48 * 512 * 768 * 2;
constexpr size_t WS_MIXEND = WS_GM + (size_t)48 * 256 * 512 * 2;
constexpr size_t WS_HID   = WS_ACT;
constexpr size_t WS_CTL   = WS_ACT + (size_t)T * 5632 * 2;
constexpr size_t WS_END   = WS_CTL + 256;
static_assert(WS_MIXEND <= WS_CTL, "mixer buffers must fit under the FFN hidden buffer");

struct Args { const float* in[24]; float* out; unsigned char* ws; int ph_lo, ph_hi; };

__device__ __forceinline__ int tid_l() { int t = threadIdx.x; asm volatile("" : "+v"(t)); return t; }
__device__ __forceinline__ unsigned cvt_pk_bf16(float lo, float hi) { unsigned r; asm("v_cvt_pk_bf16_f32 %0, %1, %2" : "=v"(r) : "v"(lo), "v"(hi)); return r; }
__device__ __forceinline__ float bf_lo(unsigned w) { return __uint_as_float(w << 16); }
__device__ __forceinline__ float bf_hi(unsigned w) { return __uint_as_float(w & 0xffff0000u); }
__device__ __forceinline__ bf16_t f2bf(float f) { return (bf16_t)(cvt_pk_bf16(f, 0.f) & 0xffffu); }
__device__ __forceinline__ float sigmoid_f(float v) { return __builtin_amdgcn_rcpf(1.0f + __builtin_amdgcn_exp2f(-1.4426950409f * v)); }
__device__ __forceinline__ float gelu_tanh(float x) { const float z = x * (1.5957691216f + 0.0713548163f * x * x); return x * sigmoid_f(z); }
__device__ __forceinline__ float wave_sum(float v) {
#pragma unroll
    for (int o = 32; o >= 1; o >>= 1) v += __shfl_xor(v, o);
    return v;
}

namespace pg8 {
constexpr int BM = 256, BK = 64, HALF = 128, HTB = HALF * BK * 2, STAGE_BYTES = 8 * HTB, NXCD = 8, WGM = 8;
__device__ __forceinline__ int lds_byte(int r, int c) { const int st = (r >> 4) * 2 + (c >> 5), rr = r & 15, cc = c & 31, ob = rr * 64 + cc * 2; return st * 1024 + (ob ^ (((ob >> 9) & 1) << 5)); }
__device__ __forceinline__ void stage_rc(int b, int& R, int& C) { const int st = b / 1024, sb = b % 1024, swz = sb ^ (((sb >> 9) & 1) << 5); R = (st >> 1) * 16 + swz / 64; C = (st & 1) * 32 + (swz % 64) / 2; }
__device__ __forceinline__ int perm32(int rho) { const int n = rho >> 4, i = rho & 15; return 8 * (i >> 2) + 4 * n + (i & 3); }

struct Unit { const char* A; const char* B; int pm, pn, grp; };
struct Sched {
    const char* A; const char* B; long gsA, gsB; int lda, ldb, nM, nN, nG, G, c, bmap;
    __device__ __forceinline__ bool next(int i, Unit& u) const {
        const int nwg = nM * nN;
        const long L = (long)i * G + c; if (c < 0 || L >= (long)nwg * nG) return false;
        const int grp = (int)(L / nwg); int wgid = (int)(L - (long)grp * nwg);
        { const int q = nwg / NXCD, r = nwg % NXCD, xcd = wgid % NXCD, off = wgid / NXCD; wgid = (xcd < r ? xcd * (q + 1) : r * (q + 1) + (xcd - r) * q) + off; }
        const int nig = WGM * nN, gid = wgid / nig, fm = gid * WGM, gsz = (nM - fm) < WGM ? (nM - fm) : WGM;
        u.pm = fm + ((wgid % nig) % gsz); u.pn = (wgid % nig) / gsz; u.grp = grp;
        u.A = A + (size_t)grp * gsA + (size_t)u.pm * 512 * lda; u.B = B + (size_t)grp * gsB + (bmap ? (size_t)((u.pn >> 4) * 4096 + (u.pn & 15) * 16) * 2 * ldb : (size_t)u.pn * 512 * ldb);
        return true;
    }
};

template <class Epi>
__device__ __forceinline__ void gemm_phase(LAS unsigned char* lds, const Sched& S, const int K, const Epi& E) {
    int tid = threadIdx.x; asm volatile("" : "+v"(tid));
    const int wid = __builtin_amdgcn_readfirstlane(tid >> 6), lane = tid & 63, wr = wid >> 2, wc = wid & 3, fr = lane & 15, fq = lane >> 4;
    const int nt = K / BK;
    unsigned voffA[2], voffB[2];
#pragma unroll
    for (int i = 0; i < 2; ++i) { int R, C; stage_rc(tid * 16 + i * 8192, R, C); const int Rb = Epi::PERM ? ((R & ~31) + perm32(R & 31)) : R;
        const int RbT = Epi::BMAP ? ((Rb >> 4) + 256 * (Rb & 15)) : Rb;
        voffA[i] = (unsigned)(R * S.lda + C) * 2u; voffB[i] = (unsigned)(RbT * S.ldb + C) * 2u; }
    const size_t kstep = (size_t)(BK * 2);
    const size_t hstepA = (size_t)HALF * S.lda * 2, hstepB = (size_t)(Epi::BMAP ? 8 : HALF) * S.ldb * 2;
    const unsigned ldsw = (unsigned)wid * 1024u;
    const int aoff = lds_byte(wr * 64 + fr, fq * 8), boff = lds_byte(wc * 32 + fr, fq * 8);
#define PG8_SA(b, h) (((b) * 2 + (h)) * HTB)
#define PG8_SB(b, h) ((4 + (b) * 2 + (h)) * HTB)
#define PG8_STAGE(bufoff, gbase, voff) do { _Pragma("unroll") for (int _i = 0; _i < 2; ++_i) \
        __builtin_amdgcn_global_load_lds((const unsigned*)((const char*)(gbase) + (voff)[_i]), (LAS unsigned*)(lds + (bufoff) + ldsw + _i * 8192), 16, 0, 0); } while (0)
#define PG8_LDA(dst, b, h) do { _Pragma("unroll") for (int m = 0; m < 4; ++m) _Pragma("unroll") for (int k = 0; k < 2; ++k) dst[m][k] = *(const LAS bf16x8*)(lds + PG8_SA(b, h) + aoff + m * 2048 + k * 1024); } while (0)
#define PG8_LDB(dst, b, h) do { _Pragma("unroll") for (int n = 0; n < 2; ++n) _Pragma("unroll") for (int k = 0; k < 2; ++k) dst[n][k] = *(const LAS bf16x8*)(lds + PG8_SB(b, h) + boff + n * 2048 + k * 1024); } while (0)
#define PG8_MMA(ai, bj, At, Bt) do { __builtin_amdgcn_s_setprio(1); _Pragma("unroll") for (int m = 0; m < 4; ++m) _Pragma("unroll") for (int n = 0; n < 2; ++n) _Pragma("unroll") for (int k = 0; k < 2; ++k) \
        acc[ai][bj][m][n] = __builtin_amdgcn_mfma_f32_16x16x32_bf16(Bt[n][k], At[m][k], acc[ai][bj][m][n], 0, 0, 0); __builtin_amdgcn_s_setprio(0); } while (0)
#define PG8_WAIT_V(n) asm volatile("s_waitcnt vmcnt(" #n ")" ::: "memory")
#define PG8_WAIT_L(n) asm volatile("s_waitcnt lgkmcnt(" #n ")" ::: "memory")
#define PG8_BAR __builtin_amdgcn_s_barrier()
#define PG8_SCHED __builtin_amdgcn_sched_barrier(0)
    Unit cur, nxt; int ui = 0;
    if (!S.next(0, cur)) return;
    f32x4 acc[2][2][4][2];
#pragma unroll
    for (int a = 0; a < 2; ++a)
#pragma unroll
        for (int b = 0; b < 2; ++b)
#pragma unroll
            for (int m = 0; m < 4; ++m)
#pragma unroll
                for (int n = 0; n < 2; ++n) acc[a][b][m][n] = (f32x4){0.f, 0.f, 0.f, 0.f};
    bf16x8 At[4][2], B0[2][2], B1[2][2];
    const char* cA = cur.A; const char* cB = cur.B;
    PG8_STAGE(PG8_SB(0, 0), cB, voffB); PG8_STAGE(PG8_SB(0, 1), cB + hstepB, voffB); PG8_STAGE(PG8_SA(0, 0), cA, voffA); PG8_STAGE(PG8_SA(0, 1), cA + hstepA, voffA);
    if (wr == 1) PG8_BAR;
    PG8_WAIT_V(2); PG8_BAR;
    PG8_STAGE(PG8_SB(1, 0), cB + kstep, voffB); PG8_STAGE(PG8_SA(1, 0), cA + kstep, voffA); PG8_STAGE(PG8_SB(1, 1), cB + hstepB + kstep, voffB);
    PG8_WAIT_V(6); PG8_BAR;
    for (;;) {
        const bool has_next = S.next(ui + 1, nxt);
        const char* nA = has_next ? nxt.A : cA; const char* nB = has_next ? nxt.B : cB;
        for (int t = 0; t < nt; t += 2) {
            const bool last = (t == nt - 2);
            const char* a1 = cA + (size_t)(t + 1) * kstep;
            const char* a2 = last ? nA : cA + (size_t)(t + 2) * kstep; const char* b2 = last ? nB : cB + (size_t)(t + 2) * kstep;
            const char* a3 = a2 + kstep; const char* b3 = b2 + kstep;
            PG8_LDB(B0, 0, 0); PG8_LDB(B1, 0, 1); PG8_SCHED; PG8_LDA(At, 0, 0); PG8_STAGE(PG8_SA(1, 1), a1 + hstepA, voffA);
            PG8_WAIT_V(8); PG8_WAIT_L(0); PG8_BAR; PG8_MMA(0, 0, At, B0); PG8_MMA(0, 1, At, B1); PG8_BAR; PG8_SCHED;
            PG8_LDA(At, 0, 1); PG8_STAGE(PG8_SB(0, 0), b2, voffB); PG8_STAGE(PG8_SB(0, 1), b2 + hstepB, voffB); PG8_STAGE(PG8_SA(0, 0), a2, voffA);
            PG8_WAIT_V(8); PG8_WAIT_L(0); PG8_BAR; PG8_MMA(1, 0, At, B0); PG8_MMA(1, 1, At, B1); PG8_BAR; PG8_SCHED;
            PG8_LDB(B0, 1, 0); PG8_LDB(B1, 1, 1); PG8_SCHED; PG8_LDA(At, 1, 0); PG8_STAGE(PG8_SA(0, 1), a2 + hstepA, voffA);
            PG8_WAIT_V(8); PG8_WAIT_L(0); PG8_BAR; PG8_MMA(0, 0, At, B0); PG8_MMA(0, 1, At, B1); PG8_BAR; PG8_SCHED;
            PG8_LDA(At, 1, 1); PG8_STAGE(PG8_SB(1, 0), b3, voffB); PG8_STAGE(PG8_SB(1, 1), b3 + hstepB, voffB); PG8_STAGE(PG8_SA(1, 0), a3, voffA);
            PG8_WAIT_V(8); PG8_WAIT_L(0); PG8_BAR; PG8_MMA(1, 0, At, B0); PG8_MMA(1, 1, At, B1); PG8_BAR; PG8_SCHED;
        }
        if (wr == 0) PG8_BAR;
        E(acc, cur, wr, wc, fr, fq);
        if (!has_next) break;
#pragma unroll
        for (int a = 0; a < 2; ++a)
#pragma unroll
            for (int b = 0; b < 2; ++b)
#pragma unroll
                for (int m = 0; m < 4; ++m)
#pragma unroll
                    for (int n = 0; n < 2; ++n) acc[a][b][m][n] = (f32x4){0.f, 0.f, 0.f, 0.f};
        cur = nxt; cA = nA; cB = nB; ++ui;
        if (wr == 1) PG8_BAR;
    }
    PG8_WAIT_V(0);
    PG8_BAR;
#undef PG8_SA
#undef PG8_SB
#undef PG8_STAGE
#undef PG8_LDA
#undef PG8_LDB
#undef PG8_MMA
#undef PG8_WAIT_V
#undef PG8_WAIT_L
#undef PG8_BAR
#undef PG8_SCHED
}
}
using pg8::Unit;
typedef const f32x4 (&AccRef)[2][2][4][2];

__device__ __forceinline__ u32x4 pack8(f32x4 v0, f32x4 v1) { u32x4 w; w.x = cvt_pk_bf16(v0[0], v0[1]); w.y = cvt_pk_bf16(v0[2], v0[3]); w.z = cvt_pk_bf16(v1[0], v1[1]); w.w = cvt_pk_bf16(v1[2], v1[3]); return w; }
__device__ __forceinline__ f32x4 gelu4(f32x4 v) { return (f32x4){gelu_tanh(v[0]), gelu_tanh(v[1]), gelu_tanh(v[2]), gelu_tanh(v[3])}; }

struct EpiWin { static constexpr bool PERM = true; static constexpr int BMAP = 0; bf16_t* zina; bf16_t* ucat;
    __device__ __forceinline__ void operator()(AccRef acc, const Unit& u, int wr, int wc, int fr, int fq) const {
        const int row0 = u.pm * 256 + wr * 64 + fr;
        if (u.pn < 6) {
            const int col0 = u.pn * 256 + wc * 32 + 8 * fq;
#pragma unroll
            for (int ai = 0; ai < 2; ++ai)
#pragma unroll
                for (int m = 0; m < 4; ++m) { bf16_t* rowp = zina + (size_t)(row0 + ai * 128 + m * 16) * 1536 + col0;
#pragma unroll
                    for (int bj = 0; bj < 2; ++bj) *(u32x4*)(rowp + bj * 128) = pack8(gelu4(acc[ai][bj][m][0]), gelu4(acc[ai][bj][m][1])); }
        } else {
            const int cc0 = (u.pn - 6) * 256 + wc * 32 + 8 * fq;
#pragma unroll
            for (int ai = 0; ai < 2; ++ai)
#pragma unroll
                for (int m = 0; m < 4; ++m) { const int t = row0 + ai * 128 + m * 16, n = t >> 5, j = t & 31;
#pragma unroll
                    for (int bj = 0; bj < 2; ++bj) { const int cc = cc0 + bj * 128, g = cc >> 4, c0 = cc & 15;
                        *(u32x4*)(ucat + ((size_t)(g * 768 + n) * 768 + j * 16 + c0)) = pack8(acc[ai][bj][m][0], acc[ai][bj][m][1]); } }
        }
    } };
struct EpiZft2 { static constexpr bool PERM = true; static constexpr int BMAP = 1; bf16_t* zf2;
    __device__ __forceinline__ void operator()(AccRef acc, const Unit& u, int wr, int wc, int fr, int fq) const {
        const int row0 = u.pm * 256 + wr * 64 + fr, b = u.pn >> 4, n1b = (u.pn & 15) * 16 + 2 * wc + (fq >> 1), n20 = (fq & 1) * 8;
#pragma unroll
        for (int ai = 0; ai < 2; ++ai)
#pragma unroll
            for (int m = 0; m < 4; ++m) { const int r = row0 + ai * 128 + m * 16, ri = r >> 9, gc = r & 511;
#pragma unroll
                for (int bj = 0; bj < 2; ++bj) { const int n1 = n1b + 8 * bj;
                    *(u32x4*)(zf2 + ((((size_t)b * 512 + gc) * 256 + n1) * 32 + ri * 16 + n20)) = pack8(acc[ai][bj][m][0], acc[ai][bj][m][1]); } }
    } };
struct EpiFour2 { static constexpr bool PERM = true; static constexpr int BMAP = 0; bf16_t* y;
    __device__ __forceinline__ void operator()(AccRef acc, const Unit& u, int wr, int wc, int fr, int fq) const {
        const int bk = u.pn >> 1, b = bk >> 4, k2 = bk & 15, col0 = 768 + (u.pn & 1) * 256 + wc * 32 + 8 * fq, k10 = wr * 64 + fr;
#pragma unroll
        for (int ai = 0; ai < 2; ++ai)
#pragma unroll
            for (int m = 0; m < 4; ++m) { const int k1 = k10 + ai * 128 + m * 16; bf16_t* rowp = y + (size_t)(b * 4096 + 16 * k1 + k2) * 2048 + col0;
#pragma unroll
                for (int bj = 0; bj < 2; ++bj) *(u32x4*)(rowp + bj * 128) = pack8(acc[ai][bj][m][0], acc[ai][bj][m][1]); }
    } };
struct EpiXs { static constexpr bool PERM = false; static constexpr int BMAP = 0; float* xs;
    __device__ __forceinline__ void operator()(AccRef acc, const Unit& u, int wr, int wc, int fr, int fq) const {
        const int row0 = u.pm * 256 + wr * 64 + fr, col0 = wc * 32 + 4 * fq;
#pragma unroll
        for (int ai = 0; ai < 2; ++ai)
#pragma unroll
            for (int m = 0; m < 4; ++m) { float* rowp = xs + ((size_t)u.grp * 768 + row0 + ai * 128 + m * 16) * 256 + col0;
#pragma unroll
                for (int bj = 0; bj < 2; ++bj)
#pragma unroll
                    for (int n = 0; n < 2; ++n) *(f32x4*)(rowp + bj * 128 + n * 16) = acc[ai][bj][m][n]; }
    } };
struct EpiYc { static constexpr bool PERM = true; static constexpr int BMAP = 0; bf16_t* ycpre;
    __device__ __forceinline__ void operator()(AccRef acc, const Unit& u, int wr, int wc, int fr, int fq) const {
        const int row0 = u.pm * 256 + wr * 64 + fr, col0 = u.pn * 256 + wc * 32 + 8 * fq;
#pragma unroll
        for (int ai = 0; ai < 2; ++ai)
#pragma unroll
            for (int m = 0; m < 4; ++m) { const int n = row0 + ai * 128 + m * 16;
#pragma unroll
                for (int bj = 0; bj < 2; ++bj) { const int col = col0 + bj * 128, i = col >> 4, c0 = col & 15;
                    *(u32x4*)(ycpre + ((size_t)(n * 32 + i) * 768 + u.grp * 16 + c0)) = pack8(gelu4(acc[ai][bj][m][0]), gelu4(acc[ai][bj][m][1])); } }
    } };
struct EpiGlu { static constexpr bool PERM = true; static constexpr int BMAP = 0; const bf16_t* ycpre; const float* bias; bf16_t* y;
    __device__ __forceinline__ void operator()(AccRef acc, const Unit& u, int wr, int wc, int fr, int fq) const {
        const int row0 = u.pm * 256 + wr * 64 + fr, col0 = u.pn * 256 + wc * 32 + 8 * fq;
        f32x4 bv[2][2];
#pragma unroll
        for (int bj = 0; bj < 2; ++bj)
#pragma unroll
            for (int n = 0; n < 2; ++n) bv[bj][n] = *(const f32x4*)(bias + col0 + bj * 128 + 4 * n);
#pragma unroll
        for (int ai = 0; ai < 2; ++ai)
#pragma unroll
            for (int m = 0; m < 4; ++m) { const size_t t = (size_t)(row0 + ai * 128 + m * 16);
#pragma unroll
                for (int bj = 0; bj < 2; ++bj) { const int col = col0 + bj * 128;
                    const u32x4 yc = *(const u32x4*)(ycpre + t * 768 + col);
                    const f32x4 v0 = acc[ai][bj][m][0] + bv[bj][0], v1 = acc[ai][bj][m][1] + bv[bj][1];
                    const f32x4 o0 = (f32x4){bf_lo(yc.x) * sigmoid_f(v0[0]), bf_hi(yc.x) * sigmoid_f(v0[1]), bf_lo(yc.y) * sigmoid_f(v0[2]), bf_hi(yc.y) * sigmoid_f(v0[3])};
                    const f32x4 o1 = (f32x4){bf_lo(yc.z) * sigmoid_f(v1[0]), bf_hi(yc.z) * sigmoid_f(v1[1]), bf_lo(yc.w) * sigmoid_f(v1[2]), bf_hi(yc.w) * sigmoid_f(v1[3])};
                    *(u32x4*)(y + t * 2048 + 1280 + col) = pack8(o0, o1); } }
    } };
struct EpiRes { static constexpr bool PERM = false; static constexpr int BMAP = 0; float* x; const float* r0; const float* r1adj;
    __device__ __forceinline__ void operator()(AccRef acc, const Unit& u, int wr, int wc, int fr, int fq) const {
        const int row0 = u.pm * 256 + wr * 64 + fr, col0 = u.pn * 256 + wc * 32 + 4 * fq;
        const float* sb = u.pm < 64 ? r0 : r1adj;
#pragma unroll
        for (int ai = 0; ai < 2; ++ai) {
            const size_t off = (size_t)(row0 + ai * 128) * 2048 + col0;
            f32x4 ld[4][2][2];
#pragma unroll
            for (int m = 0; m < 4; ++m)
#pragma unroll
                for (int bj = 0; bj < 2; ++bj)
#pragma unroll
                    for (int n = 0; n < 2; ++n) ld[m][bj][n] = *(const f32x4*)(sb + off + (size_t)m * 16 * 2048 + bj * 128 + n * 16);
#pragma unroll
            for (int m = 0; m < 4; ++m)
#pragma unroll
                for (int bj = 0; bj < 2; ++bj)
#pragma unroll
                    for (int n = 0; n < 2; ++n) *(f32x4*)(x + off + (size_t)m * 16 * 2048 + bj * 128 + n * 16) = ld[m][bj][n] + acc[ai][bj][m][n];
            asm volatile("" ::: "memory"); }
    } };
struct EpiSwi { static constexpr bool PERM = true; static constexpr int BMAP = 0; bf16_t* hid;
    __device__ __forceinline__ void operator()(AccRef acc, const Unit& u, int wr, int wc, int fr, int fq) const {
        const int row0 = u.pm * 256 + wr * 64 + fr, col0 = u.pn * 128 + wc * 32 + 8 * fq;
#pragma unroll
        for (int ai = 0; ai < 2; ++ai)
#pragma unroll
            for (int m = 0; m < 4; ++m) {
                f32x4 o[2];
#pragma unroll
                for (int n = 0; n < 2; ++n) { const f32x4 g = acc[ai][0][m][n], up = acc[ai][1][m][n];
                    o[n] = (f32x4){g[0] * sigmoid_f(g[0]) * up[0], g[1] * sigmoid_f(g[1]) * up[1], g[2] * sigmoid_f(g[2]) * up[2], g[3] * sigmoid_f(g[3]) * up[3]}; }
                *(u32x4*)(hid + (size_t)(row0 + ai * 128 + m * 16) * 5632 + col0) = pack8(o[0], o[1]); }
    } };

struct TrDesc { const float* src; int ldsrc, K, c0, nc; bf16_t* dst; int mode, doff; };
template <class SEL, class CTX>
__device__ __forceinline__ void transpose_run(LAS unsigned char* lds, const CTX& ctx, int t0, int t1, int stride) {
    const int tid = tid_l();
    LAS unsigned* tl = (LAS unsigned*)lds;
    const int k = tid >> 3, n8 = (tid & 7) * 8;
    f32x4 v[4][2];
    TrDesc d; int lt;
    if (t0 < t1) { SEL::get(ctx, t0, d, lt); const int nkt = d.K >> 6, kt = lt % nkt, ct = lt / nkt;
        const float* s = d.src + (size_t)(kt * 64 + k) * d.ldsrc + d.c0 + ct * 256 + n8;
#pragma unroll
        for (int q = 0; q < 4; ++q) { v[q][0] = *(const f32x4*)(s + q * 64); v[q][1] = *(const f32x4*)(s + q * 64 + 4); } }
    for (int t = t0; t < t1; t += stride) {
        SEL::get(ctx, t, d, lt);
        const int nkt = d.K >> 6, kt = lt % nkt, ct = lt / nkt;
        unsigned w[4][4];
#pragma unroll
        for (int q = 0; q < 4; ++q)
#pragma unroll
            for (int j = 0; j < 4; ++j) { const float lo = v[q][0][j], hi = v[q][1][j];
                const float recv = __shfl_xor((k & 1) ? lo : hi, 8);
                w[q][j] = (k & 1) ? cvt_pk_bf16(recv, hi) : cvt_pk_bf16(lo, recv); }
        if (t + stride < t1) { TrDesc dn; int ltn; SEL::get(ctx, t + stride, dn, ltn); const int nktn = dn.K >> 6, ktn = ltn % nktn, ctn = ltn / nktn;
            const float* s = dn.src + (size_t)(ktn * 64 + k) * dn.ldsrc + dn.c0 + ctn * 256 + n8;
#pragma unroll
            for (int q = 0; q < 4; ++q) { v[q][0] = *(const f32x4*)(s + q * 64); v[q][1] = *(const f32x4*)(s + q * 64 + 4); } }
#pragma unroll
        for (int q = 0; q < 4; ++q)
#pragma unroll
            for (int j = 0; j < 4; ++j) tl[(q * 64 + n8 + j + ((k & 1) ? 4 : 0)) * 33 + (k >> 1)] = w[q][j];
        __syncthreads();
        { const int n = tid >> 3, k8 = (tid & 7) * 8;
#pragma unroll
          for (int q = 0; q < 4; ++q) {
              const LAS unsigned* p = tl + (q * 64 + n) * 33 + (k8 >> 1);
              u32x4 ww; ww.x = p[0]; ww.y = p[1]; ww.z = p[2]; ww.w = p[3];
              const int cc = ct * 256 + q * 64 + n;
              const int drow = d.mode == 0 ? d.doff + cc : ((cc >> 7) * 256 + (cc & 127) + (d.mode == 2 ? 128 : 0));
              *(u32x4*)(d.dst + (size_t)drow * d.K + kt * 64 + k8) = ww; } }
        __syncthreads();
    }
}
struct SelOne { static __device__ __forceinline__ void get(const TrDesc& c, int t, TrDesc& d, int& lt) { d = c; lt = t; } };
struct FfnCtx { const float* wg; const float* wu; const float* wd; bf16_t* wgu; bf16_t* wdown; };
struct SelFfn { static __device__ __forceinline__ void get(const FfnCtx& c, int t, TrDesc& d, int& lt) {
    if (t < 704)       { d = TrDesc{c.wg, DFF, 2048, 0, DFF, c.wgu, 1, 0}; lt = t; }
    else if (t < 1408) { d = TrDesc{c.wu, DFF, 2048, 0, DFF, c.wgu, 2, 0}; lt = t - 704; }
    else               { d = TrDesc{c.wd, 2048, DFF, 0, 2048, c.wdown, 0, 0}; lt = t - 1408; } } };

__device__ __forceinline__ double kd(double c) { asm volatile("" : "+v"(c)); return c; }
__device__ __forceinline__ double exp_d(double x) {
    const double y = x * 0.125; double term = 1.0, sum = 1.0;
#pragma unroll 1
    for (int n = 1; n <= 22; ++n) { term *= y / (double)n; sum += term; }
    sum *= sum; sum *= sum; sum *= sum; return sum;
}
__device__ __forceinline__ void sincos_d(double x, double& s, double& c) {
    const double k = rint(x * kd(0.15915494309189535));
    double r = fma(-k, kd(6.283185307179586232), x); r = fma(-k, kd(2.4492935982947064e-16), r);
    const double y = r * 0.125, my2 = -(y * y);
    double sn = y, cs = 1.0, ts = y, tc = 1.0;
#pragma unroll 1
    for (int n = 1; n <= 10; ++n) { tc *= my2 / (double)((2 * n - 1) * (2 * n)); cs += tc; ts *= my2 / (double)((2 * n) * (2 * n + 1)); sn += ts; }
#pragma unroll 1
    for (int i = 0; i < 3; ++i) { const double c2 = cs * cs - sn * sn, s2 = 2.0 * sn * cs; cs = c2; sn = s2; }
    s = sn; c = cs;
}

__device__ __forceinline__ void s5_disc(const Args& a, int l, int g, int dir, int p, double& ar, double& ai, double& qr, double& qi) {
    const double lr = (double)a.in[7][((l * 2 + dir) * 48 + g) * 64 + p], li = (double)a.in[8][((l * 2 + dir) * 48 + g) * 64 + p];
    const double st = exp_d((double)a.in[9][(l * 2 + dir) * 48 + g]);
    const double mag = exp_d(lr * st); double sn, cs; sincos_d(li * st, sn, cs);
    ar = mag * cs; ai = mag * sn; const double den = lr * lr + li * li, nr = ar - 1.0;
    qr = (nr * lr + ai * li) / den; qi = (ai * lr - nr * li) / den;
}
__device__ __forceinline__ void s5_group_a(LAS unsigned char* lds, const Args& a, int l, int g) {
    const int tid = tid_l();
    LAS float* apw = (LAS float*)lds;
    LAS float* bbr = apw + 2 * 33 * 64 * 2;
    bf16_t* GMp = (bf16_t*)(a.ws + WS_GM); float* ALp = (float*)(a.ws + WS_AL); float* APWp = (float*)(a.ws + WS_APW);
    if (tid < 128) {
        const int dir = tid >> 6, p = tid & 63;
        double ar, ai, qr, qi; s5_disc(a, l, g, dir, p, ar, ai, qr, qi);
        double pr = 1.0, pi = 0.0;
#pragma unroll 1
        for (int tau = 0; tau <= 32; ++tau) { const float fr_ = (float)pr, fi_ = (float)pi;
            apw[((dir * 33 + tau) * 64 + p) * 2] = fr_; apw[((dir * 33 + tau) * 64 + p) * 2 + 1] = fi_;
            *(f32x2*)(APWp + ((size_t)((g * 2 + dir) * 33 + tau) * 64 + p) * 2) = (f32x2){fr_, fi_};
            const double nr2 = pr * ar - pi * ai, ni2 = pr * ai + pi * ar; pr = nr2; pi = ni2; }
        ALp[((g * 2 + dir) * 64 + p) * 2] = apw[((dir * 33 + 32) * 64 + p) * 2]; ALp[((g * 2 + dir) * 64 + p) * 2 + 1] = apw[((dir * 33 + 32) * 64 + p) * 2 + 1];
#pragma unroll 1
        for (int c = 0; c < 16; ++c) { const double br = (double)a.in[10][((l * 48 + g) * 64 + p) * 16 + c], bi = (double)a.in[11][((l * 48 + g) * 64 + p) * 16 + c];
            bbr[((dir * 64 + p) * 16 + c) * 2] = (float)(qr * br - qi * bi); bbr[((dir * 64 + p) * 16 + c) * 2 + 1] = (float)(qr * bi + qi * br); }
    }
    __syncthreads();
    {
        const int row = tid >> 1, half = tid & 1, dir = row >> 7, p = (row >> 1) & 63, ri = row & 1;
        bf16_t* rowp = GMp + ((size_t)g * 256 + row) * 512;
        for (int jj = 0; jj < 16; ++jj) { const int j = half * 16 + jj, e = dir == 0 ? 31 - j : j;
            const float wr_ = apw[((dir * 33 + e) * 64 + p) * 2], wi_ = apw[((dir * 33 + e) * 64 + p) * 2 + 1];
            float v[16];
#pragma unroll
            for (int c2 = 0; c2 < 16; ++c2) { const float Br = bbr[((dir * 64 + p) * 16 + c2) * 2], Bi = bbr[((dir * 64 + p) * 16 + c2) * 2 + 1];
                v[c2] = ri == 0 ? wr_ * Br - wi_ * Bi : wr_ * Bi + wi_ * Br; }
            u32x4 w0, w1; w0.x = cvt_pk_bf16(v[0], v[1]); w0.y = cvt_pk_bf16(v[2], v[3]); w0.z = cvt_pk_bf16(v[4], v[5]); w0.w = cvt_pk_bf16(v[6], v[7]);
            w1.x = cvt_pk_bf16(v[8], v[9]); w1.y = cvt_pk_bf16(v[10], v[11]); w1.z = cvt_pk_bf16(v[12], v[13]); w1.w = cvt_pk_bf16(v[14], v[15]);
            *(u32x4*)(rowp + j * 16) = w0; *(u32x4*)(rowp + j * 16 + 8) = w1; }
    }
    __syncthreads();
}
__device__ __forceinline__ void s5_ktab(LAS unsigned char* lds, const Args& a, int l, int task) {
    const int tid = tid_l(), g = task >> 3, dir = (task >> 2) & 1, tb = task & 3;
    LAS float* ap8 = (LAS float*)lds;
    LAS float* bbr = ap8 + 8 * 64 * 2;
    LAS float* ccx = bbr + 64 * 16 * 2;
    LAS float* cw  = ccx + 16 * 64 * 2;
    float* KTp = (float*)(a.ws + WS_KT);
    if (tid < 64) {
        const int p = tid; double ar, ai, qr, qi; s5_disc(a, l, g, dir, p, ar, ai, qr, qi);
        double pr = 1.0, pi = 0.0;
#pragma unroll 1
        for (int t = 0; t < tb * 8; ++t) { const double nr2 = pr * ar - pi * ai, ni2 = pr * ai + pi * ar; pr = nr2; pi = ni2; }
#pragma unroll 1
        for (int t = 0; t < 8; ++t) { ap8[(t * 64 + p) * 2] = (float)pr; ap8[(t * 64 + p) * 2 + 1] = (float)pi;
            const double nr2 = pr * ar - pi * ai, ni2 = pr * ai + pi * ar; pr = nr2; pi = ni2; }
#pragma unroll 1
        for (int c = 0; c < 16; ++c) { const double br = (double)a.in[10][((l * 48 + g) * 64 + p) * 16 + c], bi = (double)a.in[11][((l * 48 + g) * 64 + p) * 16 + c];
            bbr[(p * 16 + c) * 2] = (float)(qr * br - qi * bi); bbr[(p * 16 + c) * 2 + 1] = (float)(qr * bi + qi * br); }
    }
    for (int idx = tid; idx < 1024; idx += NTHREADS) { const int c = idx >> 6, p = idx & 63;
        ccx[idx * 2] = a.in[12][((l * 48 + g) * 16 + c) * 64 + p]; ccx[idx * 2 + 1] = a.in[13][((l * 48 + g) * 16 + c) * 64 + p]; }
    __syncthreads();
    for (int idx = tid; idx < 8192; idx += NTHREADS) { const int t = idx >> 10, cp = idx & 1023, p = idx & 63;
        const float Cr = ccx[cp * 2], Ci = ccx[cp * 2 + 1], wr_ = ap8[(t * 64 + p) * 2], wi_ = ap8[(t * 64 + p) * 2 + 1];
        cw[idx * 2] = Cr * wr_ - Ci * wi_; cw[idx * 2 + 1] = Cr * wi_ + Ci * wr_; }
    __syncthreads();
#pragma unroll
    for (int k = 0; k < 4; ++k) { const int o = tid + k * NTHREADS, t = o >> 8, c = (o >> 4) & 15, c2 = o & 15;
        float s = 0.f;
        for (int p = 0; p < 64; ++p) s += cw[((t * 16 + c) * 64 + p) * 2] * bbr[(p * 16 + c2) * 2] - cw[((t * 16 + c) * 64 + p) * 2 + 1] * bbr[(p * 16 + c2) * 2 + 1];
        KTp[((size_t)((g * 2 + dir) * 32 + tb * 8 + t)) * 256 + c * 16 + c2] = s; }
    __syncthreads();
}
__device__ __forceinline__ void s5_te(const Args& a, int l, int task) {
    const int tid = tid_l(), g = task >> 2, qd = task & 3, r = tid >> 2, sub = tid & 3, i = qd * 8 + (r >> 4), c = r & 15;
    const float* KTp = (const float*)(a.ws + WS_KT); const float* APWp = (const float*)(a.ws + WS_APW);
    bf16_t* rowp = (bf16_t*)(a.ws + WS_TE) + ((size_t)g * 512 + i * 16 + c) * 768;
    const float dsk = a.in[14][l * 768 + g * 16 + c];
    const float* kf = KTp + (size_t)((g * 2 + 0) * 32) * 256 + c * 16; const float* kb = KTp + (size_t)((g * 2 + 1) * 32) * 256 + c * 16;
#pragma unroll 2
    for (int jj = 0; jj < 8; ++jj) { const int j = sub * 8 + jj;
        f32x4 v[4];
        if (j < i) {
#pragma unroll
            for (int q = 0; q < 4; ++q) v[q] = *(const f32x4*)(kf + (i - j) * 256 + q * 4);
        } else if (j > i) {
#pragma unroll
            for (int q = 0; q < 4; ++q) v[q] = *(const f32x4*)(kb + (j - i) * 256 + q * 4);
        } else {
#pragma unroll
            for (int q = 0; q < 4; ++q) { v[q] = *(const f32x4*)(kf + q * 4) + *(const f32x4*)(kb + q * 4);
#pragma unroll
                for (int e = 0; e < 4; ++e) v[q][e] += (q * 4 + e == c) ? dsk : 0.f; }
        }
        *(u32x4*)(rowp + j * 16) = pack8(v[0], v[1]); *(u32x4*)(rowp + j * 16 + 8) = pack8(v[2], v[3]); }
    { const int dir = sub >> 1, p0 = (sub & 1) * 32, e = dir == 0 ? i + 1 : 32 - i;
      const float* cr = a.in[12] + ((l * 48 + g) * 16 + c) * 64 + p0; const float* ci = a.in[13] + ((l * 48 + g) * 16 + c) * 64 + p0;
      const float* aw = APWp + ((size_t)((g * 2 + dir) * 33 + e) * 64 + p0) * 2;
#pragma unroll 2
      for (int p4 = 0; p4 < 32; p4 += 4) { const f32x4 Cr = *(const f32x4*)(cr + p4), Ci = *(const f32x4*)(ci + p4), w0 = *(const f32x4*)(aw + p4 * 2), w1 = *(const f32x4*)(aw + p4 * 2 + 4);
          u32x4 ww; ww.x = cvt_pk_bf16(Cr[0] * w0[0] - Ci[0] * w0[1], -(Cr[0] * w0[1] + Ci[0] * w0[0])); ww.y = cvt_pk_bf16(Cr[1] * w0[2] - Ci[1] * w0[3], -(Cr[1] * w0[3] + Ci[1] * w0[2]));
          ww.z = cvt_pk_bf16(Cr[2] * w1[0] - Ci[2] * w1[1], -(Cr[2] * w1[1] + Ci[2] * w1[0])); ww.w = cvt_pk_bf16(Cr[3] * w1[2] - Ci[3] * w1[3], -(Cr[3] * w1[3] + Ci[3] * w1[2]));
          *(u32x4*)(rowp + 512 + dir * 128 + (p0 + p4) * 2) = ww; } }
}

__device__ __forceinline__ void winbf_task(LAS unsigned char* lds, const float* w_in_l, bf16_t* dst, int task) {
    const int tid = tid_l(), g = task & 3, k0 = (task >> 2) * 64;
    LAS float* Wt = (LAS float*)lds;
    LAS float* tc = Wt + 64 * 128; LAS float* ts = tc + 128;
    { const int k = tid >> 3, c16 = (tid & 7) * 16; const float* s = w_in_l + (size_t)(k0 + k) * INW + 1536 + g * 128 + c16;
#pragma unroll
      for (int q = 0; q < 4; ++q) *(LAS f32x4*)(Wt + k * 128 + c16 + q * 4) = *(const f32x4*)(s + q * 4); }
    if (tid < 128) { float sn, cs; sincospif((float)tid * (1.0f / 64.0f), &sn, &cs); tc[tid] = cs; ts[tid] = sn; }
    __syncthreads();
    const int cp = tid & 127, kq = tid >> 7;
    float aC[16], aS[16];
#pragma unroll
    for (int kk = 0; kk < 16; ++kk) { aC[kk] = 0.f; aS[kk] = 0.f; }
    for (int c = 0; c < 128; ++c) { const int idx = (c * cp) & 127; const float vc = tc[idx], vs = ts[idx];
#pragma unroll
        for (int kk = 0; kk < 16; ++kk) { const float w = Wt[(kq * 16 + kk) * 128 + c]; aC[kk] += w * vc; aS[kk] += w * vs; } }
    bf16_t* dc = dst + (size_t)(g * 128 + cp) * 2048 + k0 + kq * 16; bf16_t* ds = dst + (size_t)(512 + g * 128 + cp) * 2048 + k0 + kq * 16;
    u32x4 w; w.x = cvt_pk_bf16(aC[0], aC[1]); w.y = cvt_pk_bf16(aC[2], aC[3]); w.z = cvt_pk_bf16(aC[4], aC[5]); w.w = cvt_pk_bf16(aC[6], aC[7]); *(u32x4*)dc = w;
    w.x = cvt_pk_bf16(aC[8], aC[9]); w.y = cvt_pk_bf16(aC[10], aC[11]); w.z = cvt_pk_bf16(aC[12], aC[13]); w.w = cvt_pk_bf16(aC[14], aC[15]); *(u32x4*)(dc + 8) = w;
    w.x = cvt_pk_bf16(aS[0], aS[1]); w.y = cvt_pk_bf16(aS[2], aS[3]); w.z = cvt_pk_bf16(aS[4], aS[5]); w.w = cvt_pk_bf16(aS[6], aS[7]); *(u32x4*)ds = w;
    w.x = cvt_pk_bf16(aS[8], aS[9]); w.y = cvt_pk_bf16(aS[10], aS[11]); w.z = cvt_pk_bf16(aS[12], aS[13]); w.w = cvt_pk_bf16(aS[14], aS[15]); *(u32x4*)(ds + 8) = w;
    __syncthreads();
}

__device__ __forceinline__ void d256_gen(bf16_t* d256, int bx, int G) {
    for (int idx = bx * NTHREADS + tid_l(); idx < 256 * 512; idx += G * NTHREADS) { const int k1 = idx >> 9, ri = (idx >> 8) & 1, n1 = idx & 255, e = (n1 * k1) & 255;
        float sn, cs; sincospif((float)e * (1.0f / 128.0f), &sn, &cs);
        d256[idx] = f2bf((ri == 0 ? cs : -sn) * 0.0013810679320049757f); }
}
__device__ __forceinline__ void fft16_pass(LAS unsigned char* lds, const bf16_t* zf2, bf16_t* vt, int bx, int G) {
    const int tid = tid_l();
    LAS float* tw = (LAS float*)lds;
    for (int i = tid; i < 4096; i += NTHREADS) { float sn, cs; sincospif((float)i * (1.0f / 2048.0f), &sn, &cs); tw[2 * i] = cs; tw[2 * i + 1] = sn; }
    __syncthreads();
    const int n1 = tid & 255, sub = tid >> 8;
    for (int task = bx * 2 + sub; task < 3072; task += G * 2) {
        const bf16_t* src = zf2 + ((size_t)task * 256 + n1) * 32;
        const u32x4 w0 = *(const u32x4*)src, w1 = *(const u32x4*)(src + 8), w2 = *(const u32x4*)(src + 16), w3 = *(const u32x4*)(src + 24);
        float zr[16], zi[16];
#pragma unroll
        for (int e = 0; e < 4; ++e) { zr[2 * e] = bf_lo(w0[e]); zr[2 * e + 1] = bf_hi(w0[e]); zr[8 + 2 * e] = bf_lo(w1[e]); zr[8 + 2 * e + 1] = bf_hi(w1[e]);
                                      zi[2 * e] = bf_lo(w2[e]); zi[2 * e + 1] = bf_hi(w2[e]); zi[8 + 2 * e] = bf_lo(w3[e]); zi[8 + 2 * e + 1] = bf_hi(w3[e]); }
        float Ar[4][4], Ai[4][4];
#pragma unroll
        for (int q = 0; q < 4; ++q) {
            const float s0r = zr[q] + zr[8 + q], s0i = zi[q] + zi[8 + q], s1r = zr[q] - zr[8 + q], s1i = zi[q] - zi[8 + q];
            const float s2r = zr[4 + q] + zr[12 + q], s2i = zi[4 + q] + zi[12 + q], s3r = zr[4 + q] - zr[12 + q], s3i = zi[4 + q] - zi[12 + q];
            Ar[q][0] = s0r + s2r; Ai[q][0] = s0i + s2i; Ar[q][2] = s0r - s2r; Ai[q][2] = s0i - s2i;
            Ar[q][1] = s1r - s3i; Ai[q][1] = s1i + s3r; Ar[q][3] = s1r + s3i; Ai[q][3] = s1i - s3r; }
        const float c1 = 0.9238795325f, s1 = 0.3826834324f, c2 = 0.7071067812f;
#define CMUL(xr, xi, cr, ci) { const float t_ = xr * (cr) - xi * (ci); xi = xr * (ci) + xi * (cr); xr = t_; }
        CMUL(Ar[1][1], Ai[1][1], c1, s1) CMUL(Ar[1][2], Ai[1][2], c2, c2) CMUL(Ar[1][3], Ai[1][3], s1, c1)
        CMUL(Ar[2][1], Ai[2][1], c2, c2) CMUL(Ar[2][2], Ai[2][2], 0.f, 1.f) CMUL(Ar[2][3], Ai[2][3], -c2, c2)
        CMUL(Ar[3][1], Ai[3][1], s1, c1) CMUL(Ar[3][2], Ai[3][2], -c2, c2) CMUL(Ar[3][3], Ai[3][3], -c1, -s1)
#undef CMUL
        float xr[16], xi[16];
#pragma unroll
        for (int r = 0; r < 4; ++r) {
            const float s0r = Ar[0][r] + Ar[2][r], s0i = Ai[0][r] + Ai[2][r], s1r = Ar[0][r] - Ar[2][r], s1i = Ai[0][r] - Ai[2][r];
            const float s2r = Ar[1][r] + Ar[3][r], s2i = Ai[1][r] + Ai[3][r], s3r = Ar[1][r] - Ar[3][r], s3i = Ai[1][r] - Ai[3][r];
            xr[r] = s0r + s2r; xi[r] = s0i + s2i; xr[r + 8] = s0r - s2r; xi[r + 8] = s0i - s2i;
            xr[r + 4] = s1r - s3i; xi[r + 4] = s1i + s3r; xr[r + 12] = s1r + s3i; xi[r + 12] = s1i - s3r; }
        const int b = task >> 9, gc = task & 511;
        bf16_t* dst = vt + ((size_t)(b * 16) * 512 + gc) * 512 + n1;
#pragma unroll
        for (int k2 = 0; k2 < 16; ++k2) { const int idx = (n1 * k2) & 4095; const float c = tw[2 * idx], sn = tw[2 * idx + 1];
            dst[(size_t)k2 * 512 * 512] = f2bf(xr[k2] * c - xi[k2] * sn); dst[(size_t)k2 * 512 * 512 + 256] = f2bf(xr[k2] * sn + xi[k2] * c); }
    }
    __syncthreads();
}

template <int MODE>
__device__ __forceinline__ void rms_rows(const float* xp, const float* xs, float* xres, const float* gain, bf16_t* outb, int bx, int G) {
    const int tid = tid_l(), lane = tid & 63, wave = tid >> 6;
    f32x4 gv[8];
#pragma unroll
    for (int it = 0; it < 8; ++it) gv[it] = *(const f32x4*)(gain + it * 256 + lane * 4);
    for (int row = bx * 8 + wave; row < T; row += G * 8) {
        const float* src = MODE == 0 ? (row < 16384 ? xp + (size_t)row * 2048 : xs + (size_t)(row - 16384) * 2048) : xres + (size_t)row * 2048;
        f32x4 v[8]; float ss = 0.f;
#pragma unroll
        for (int it = 0; it < 8; ++it) { v[it] = *(const f32x4*)(src + it * 256 + lane * 4); ss += v[it][0] * v[it][0] + v[it][1] * v[it][1] + v[it][2] * v[it][2] + v[it][3] * v[it][3]; }
        ss = wave_sum(ss);
        const float r = 1.0f / sqrtf(ss * (1.0f / 2048.0f) + EPS);
#pragma unroll
        for (int it = 0; it < 8; ++it) {
            const f32x4 o = v[it] * r * gv[it];
            if (MODE == 2) *(f32x4*)(xres + (size_t)row * 2048 + it * 256 + lane * 4) = o;
            else { u32x2 w; w.x = cvt_pk_bf16(o[0], o[1]); w.y = cvt_pk_bf16(o[2], o[3]); *(u32x2*)(outb + (size_t)row * 2048 + it * 256 + lane * 4) = w; }
        }
    }
}

__device__ __forceinline__ void outnorm_rows(bf16_t* y, const float* og, int bx, int G) {
    const int tid = tid_l(), lane = tid & 63, wave = tid >> 6;
    for (int row = (bx * 8 + wave) * 2; row < T; row += G * 16) {
        u32x4 w[2][4]; float ss[2][3];
#pragma unroll
        for (int rr = 0; rr < 2; ++rr)
#pragma unroll
            for (int it = 0; it < 4; ++it) w[rr][it] = *(const u32x4*)(y + (size_t)(row + rr) * 2048 + (it * 64 + lane) * 8);
#pragma unroll
        for (int rr = 0; rr < 2; ++rr) { ss[rr][0] = 0.f; ss[rr][1] = 0.f; ss[rr][2] = 0.f;
#pragma unroll
            for (int it = 0; it < 4; ++it) { const int ch = it * 64 + lane; float s = 0.f;
#pragma unroll
                for (int q = 0; q < 4; ++q) { const float a0 = bf_lo(w[rr][it][q]), a1 = bf_hi(w[rr][it][q]); s += a0 * a0 + a1 * a1; }
                const int seg = ch < 96 ? 0 : (ch < 160 ? 1 : 2);
                ss[rr][0] += seg == 0 ? s : 0.f; ss[rr][1] += seg == 1 ? s : 0.f; ss[rr][2] += seg == 2 ? s : 0.f; }
            ss[rr][0] = wave_sum(ss[rr][0]); ss[rr][1] = wave_sum(ss[rr][1]); ss[rr][2] = wave_sum(ss[rr][2]); }
#pragma unroll
        for (int rr = 0; rr < 2; ++rr) {
            const float r0 = 1.0f / sqrtf(ss[rr][0] * (1.0f / 768.0f) + EPS), r1 = 1.0f / sqrtf(ss[rr][1] * (1.0f / 512.0f) + EPS), r2 = 1.0f / sqrtf(ss[rr][2] * (1.0f / 768.0f) + EPS);
#pragma unroll
            for (int it = 0; it < 4; ++it) { const int ch = it * 64 + lane; const float r = ch < 96 ? r0 : (ch < 160 ? r1 : r2);
                const f32x4 g0 = *(const f32x4*)(og + ch * 8), g1 = *(const f32x4*)(og + ch * 8 + 4);
                const u32x4 ww = w[rr][it];
                u32x4 o; o.x = cvt_pk_bf16(bf_lo(ww.x) * r * g0[0], bf_hi(ww.x) * r * g0[1]); o.y = cvt_pk_bf16(bf_lo(ww.y) * r * g0[2], bf_hi(ww.y) * r * g0[3]);
                o.z = cvt_pk_bf16(bf_lo(ww.z) * r * g1[0], bf_hi(ww.z) * r * g1[1]); o.w = cvt_pk_bf16(bf_lo(ww.w) * r * g1[2], bf_hi(ww.w) * r * g1[3]);
                *(u32x4*)(y + (size_t)(row + rr) * 2048 + ch * 8) = o; } }
    }
}

__device__ __forceinline__ void gmlp_task(LAS unsigned char* lds, const bf16_t* zina, const bf16_t* wsb, const float* vg, const float* bs, bf16_t* y, int task) {
    const int tid = tid_l(), lane = tid & 63, wid = tid >> 6, fr = lane & 15, fq = lane >> 4;
    const int cidx = task / 6, h = task - cidx * 6, t0 = cidx * 128;
    LAS bf16_t* vT = (LAS bf16_t*)lds;
    { const int k = tid >> 2, dq = (tid & 3) * 32;
      const bf16_t* src = zina + (size_t)(t0 + k) * 1536 + 768 + h * 128 + dq;
      u32x4 w[4]; float ss = 0.f;
#pragma unroll
      for (int q = 0; q < 4; ++q) { w[q] = *(const u32x4*)(src + q * 8);
#pragma unroll
          for (int e = 0; e < 4; ++e) { const float a0 = bf_lo(w[q][e]), a1 = bf_hi(w[q][e]); ss += a0 * a0 + a1 * a1; } }
      ss += __shfl_xor(ss, 1); ss += __shfl_xor(ss, 2);
      const float r = 1.0f / sqrtf(ss * (1.0f / 128.0f) + EPS);
#pragma unroll
      for (int q = 0; q < 4; ++q)
#pragma unroll
          for (int e = 0; e < 4; ++e) { const int d = dq + q * 8 + e * 2;
              vT[d * 136 + k] = f2bf(bf_lo(w[q][e]) * r * vg[h * 128 + d]); vT[(d + 1) * 136 + k] = f2bf(bf_hi(w[q][e]) * r * vg[h * 128 + d + 1]); } }
    __syncthreads();
    const int q0 = (wid >> 1) * 32, d0 = (wid & 1) * 64;
    f32x4 acc[2][4];
#pragma unroll
    for (int mq = 0; mq < 2; ++mq)
#pragma unroll
        for (int nd = 0; nd < 4; ++nd) acc[mq][nd] = (f32x4){0.f, 0.f, 0.f, 0.f};
#pragma unroll
    for (int ks = 0; ks < 4; ++ks) {
        bf16x8 af[2], bfr[4];
#pragma unroll
        for (int mq = 0; mq < 2; ++mq) af[mq] = *(const bf16x8*)(wsb + (size_t)(h * 128 + q0 + mq * 16 + fr) * 128 + ks * 32 + fq * 8);
#pragma unroll
        for (int nd = 0; nd < 4; ++nd) bfr[nd] = *(const LAS bf16x8*)(vT + (d0 + nd * 16 + fr) * 136 + ks * 32 + fq * 8);
#pragma unroll
        for (int mq = 0; mq < 2; ++mq)
#pragma unroll
            for (int nd = 0; nd < 4; ++nd) acc[mq][nd] = __builtin_amdgcn_mfma_f32_16x16x32_bf16(bfr[nd], af[mq], acc[mq][nd], 0, 0, 0);
    }
#pragma unroll
    for (int mq = 0; mq < 2; ++mq) { const int q = q0 + mq * 16 + fr; const float b = bs[h * 128 + q];
#pragma unroll
        for (int nd = 0; nd < 4; ++nd) { const int d = d0 + nd * 16 + 4 * fq;
            const u32x2 uu = *(const u32x2*)(zina + (size_t)(t0 + q) * 1536 + h * 128 + d);
            const f32x4 m = acc[mq][nd] + b;
            u32x2 o; o.x = cvt_pk_bf16(bf_lo(uu.x) * m[0], bf_hi(uu.x) * m[1]); o.y = cvt_pk_bf16(bf_lo(uu.y) * m[2], bf_hi(uu.y) * m[3]);
            *(u32x2*)(y + (size_t)(t0 + q) * 2048 + h * 128 + d) = o; } }
    __syncthreads();
}

__device__ __forceinline__ void carry_scan(const float* xs, const float* ALp, bf16_t* ucat, int bx) {
    const int idx = bx * NTHREADS + tid_l();
    if (idx >= 48 * 6 * 128) return;
    const int p = idx & 63, dir = (idx >> 6) & 1, b = (idx >> 7) % 6, g = idx / 768;
    const f32x2 aL = *(const f32x2*)(ALp + ((g * 2 + dir) * 64 + p) * 2);
    float hr = 0.f, hi = 0.f;
#pragma unroll 32
    for (int s = 0; s < 128; ++s) { const int c = dir == 0 ? s : 127 - s; const size_t chunk = (size_t)g * 768 + b * 128 + c;
        const f32x2 x = *(const f32x2*)(xs + chunk * 256 + dir * 128 + p * 2);
        *(unsigned*)(ucat + chunk * 768 + 512 + dir * 128 + p * 2) = cvt_pk_bf16(hr, hi);
        const float nr = aL.x * hr - aL.y * hi + x.x, ni = aL.x * hi + aL.y * hr + x.y; hr = nr; hi = ni; }
}

__device__ __forceinline__ void grid_bar(unsigned* cnt, unsigned target) {
    asm volatile("s_waitcnt vmcnt(0)" ::: "memory");
    __syncthreads();
    if (threadIdx.x == 0) {
        __builtin_amdgcn_fence(__ATOMIC_RELEASE, "agent");
        asm volatile("s_waitcnt vmcnt(0)" ::: "memory");
        (void)__hip_atomic_fetch_add(cnt, 1u, __ATOMIC_RELAXED, __HIP_MEMORY_SCOPE_AGENT);
        unsigned sp = 0;
        while (__hip_atomic_load(cnt, __ATOMIC_RELAXED, __HIP_MEMORY_SCOPE_AGENT) < target) { __builtin_amdgcn_s_sleep(1); if (++sp > (1u << 22)) break; }
        __builtin_amdgcn_fence(__ATOMIC_ACQUIRE, "agent");
        asm volatile("s_waitcnt vmcnt(0)" ::: "memory");
    }
    __syncthreads();
}

constexpr int N_PHASES = 23;
__global__ void __launch_bounds__(NTHREADS, 2) mega_fwd(Args a) {
    extern __shared__ __attribute__((aligned(16))) unsigned char lds_raw[];
    LAS unsigned char* lds = (LAS unsigned char*)lds_raw;
    cg::grid_group grid = cg::this_grid();
#define WINAC ((bf16_t*)(ws + WS_WINAC))
#define WINBF ((bf16_t*)(ws + WS_WINBF))
#define WOUT  ((bf16_t*)(ws + WS_WOUT))
#define WGLU  ((bf16_t*)(ws + WS_WGLU))
#define WSB   ((bf16_t*)(ws + WS_WS))
#define WGU   ((bf16_t*)(ws + WS_WGU))
#define WDOWN ((bf16_t*)(ws + WS_WDOWN))
#define VT    ((bf16_t*)(ws + WS_VT))
#define D256  ((bf16_t*)(ws + WS_D256))
#define AL    ((float*)(ws + WS_AL))
#define SLOT1 ((bf16_t*)(ws + WS_SLOT1))
#define ZINA  ((bf16_t*)(ws + WS_ZINA))
#define ZFT   ((bf16_t*)(ws + WS_ZFT))
#define YCPRE ((bf16_t*)(ws + WS_YCPRE))
#define UCAT  ((bf16_t*)(ws + WS_UCAT))
#define XS    ((float*)(ws + WS_XS))
#define TE    ((bf16_t*)(ws + WS_TE))
#define GM    ((bf16_t*)(ws + WS_GM))
#define HID   ((bf16_t*)(ws + WS_HID))
    int ph = 0; unsigned nbar = 0;
#define GRID_SYNC() do { if (nbar == 0u) { grid.sync(); } else { grid_bar((unsigned*)(a.ws + WS_CTL), nbar * gridDim.x); } ++nbar; } while (0)
#ifndef ONLY_PH
#define ONLY_PH -1
#endif
#ifndef PROBE_DUP
#define PROBE_DUP -1
#endif
#define PH_BEGIN(k) if ((ONLY_PH < 0 || ONLY_PH == (k)) && ph >= a.ph_lo && ph < a.ph_hi) { const int nrep_ = ((k) == PROBE_DUP) ? 2 : 1; for (int rep_ = 0; rep_ < nrep_; ++rep_) { unsigned char* ws = a.ws; float* X = a.out; int bx = blockIdx.x, G = gridDim.x; asm volatile("; PHASEMARK %4" : "+s"(ws), "+s"(X), "+s"(bx), "+s"(G) : "i"(k));
#define PH_END   if (rep_ + 1 < nrep_) GRID_SYNC(); } if (ph + 1 < a.ph_hi) GRID_SYNC(); } ++ph;

#define FFN_CONVERT(t0, t1) do { if (bx >= 32) { \
        const FfnCtx fc{a.in[20] + (size_t)l * 2048 * DFF, a.in[21] + (size_t)l * 2048 * DFF, a.in[22] + (size_t)l * DFF * 2048, WGU, WDOWN}; \
        transpose_run<SelFfn>(lds, fc, (t0) + bx - 32, (t1), G - 32); } } while (0)
#pragma unroll 1
    for (int l = 0; l < 2; ++l) {
        PH_BEGIN(0)
            for (int g = bx; g < NGRP; g += G) s5_group_a(lds, a, l, g);
            for (int t = G - 1 - bx; t < NGRP * 8; t += G) s5_ktab(lds, a, l, t);
            for (int t = (bx + G - 48) % G; t < 128; t += G) winbf_task(lds, a.in[3] + (size_t)l * 2048 * INW, WINBF, t);
            if (l == 0) d256_gen(D256, bx, G);
            {
                const float* s = a.in[5] + (size_t)l * 6 * 128 * 128;
                for (int i = bx * NTHREADS + tid_l(); i < 6 * 128 * 128 / 2; i += G * NTHREADS) ((unsigned*)WSB)[i] = cvt_pk_bf16(s[2 * i], s[2 * i + 1]);
            }
            {
                const TrDesc td[4] = {
                    {a.in[3] + (size_t)l * 2048 * INW, INW, 2048, 0, 1536, WINAC, 0, 0},
                    {a.in[3] + (size_t)l * 2048 * INW, INW, 2048, 2048, 768, WINAC, 0, 1536},
                    {a.in[18] + (size_t)l * 2048 * 2048, 2048, 2048, 0, 2048, WOUT, 0, 0},
                    {a.in[15] + (size_t)l * 768 * 768, 768, 768, 0, 768, WGLU, 0, 0}};
                const int ntile[4] = {32 * 6, 32 * 3, 32 * 8, 12 * 3};
#pragma unroll
                for (int m = 0; m < 4; ++m) transpose_run<SelOne>(lds, td[m], bx, ntile[m], G);
            }
            if (l == 0) rms_rows<0>(a.in[0], a.in[1], X, a.in[2], SLOT1, bx, G);
            else        rms_rows<1>(nullptr, nullptr, X, a.in[2] + l * 2048, SLOT1, bx, G);
        PH_END
        PH_BEGIN(1)
            { pg8::Sched S{(const char*)SLOT1, (const char*)WINAC, 0, 0, 2048, 2048, T / 256, 9, 1, G, bx, 0}; EpiWin E{ZINA, UCAT}; pg8::gemm_phase(lds, S, 2048, E); }
            { pg8::Sched S{(const char*)WINBF, (const char*)SLOT1, 0, 0, 2048, 2048, 4, T / 256, 1, G, G - 1 - bx, 1}; EpiZft2 E{ZFT}; pg8::gemm_phase(lds, S, 2048, E); }
        PH_END
        PH_BEGIN(2)
            fft16_pass(lds, ZFT, VT, bx, G);
            { pg8::Sched S{(const char*)UCAT, (const char*)GM, (long)768 * 768 * 2, (long)256 * 512 * 2, 768, 512, 3, 1, NGRP, G, bx, 0}; EpiXs E{XS}; pg8::gemm_phase(lds, S, 512, E); }
            for (int t = G - 1 - bx; t < 192 * 6; t += G) gmlp_task(lds, ZINA, WSB, a.in[4] + l * 768, a.in[6] + l * 768, SLOT1, t);
            for (int t = bx; t < NGRP * 4; t += G) s5_te(a, l, t);
        PH_END
        PH_BEGIN(3)
            if (bx < 72) carry_scan(XS, AL, UCAT, bx);
            else { pg8::Sched S{(const char*)D256, (const char*)VT, 0, 0, 512, 512, 1, 192, 1, G - 72, bx - 72, 0}; EpiFour2 E{SLOT1}; pg8::gemm_phase(lds, S, 512, E); }
        PH_END
        PH_BEGIN(4)
            { pg8::Sched S{(const char*)UCAT, (const char*)TE, (long)768 * 768 * 2, (long)512 * 768 * 2, 768, 768, 3, 2, NGRP, G, bx, 0}; EpiYc E{YCPRE}; pg8::gemm_phase(lds, S, 768, E); }
            FFN_CONVERT(0, 1056);
        PH_END
        PH_BEGIN(5)
            { pg8::Sched S{(const char*)YCPRE, (const char*)WGLU, 0, 0, 768, 768, T / 256, 3, 1, G, bx, 0}; EpiGlu E{YCPRE, a.in[16] + l * 768, SLOT1}; pg8::gemm_phase(lds, S, 768, E); }
            FFN_CONVERT(1056, 2112);
        PH_END
        PH_BEGIN(6)
            outnorm_rows(SLOT1, a.in[17] + l * 2048, bx, G);
        PH_END
        PH_BEGIN(7)
            { pg8::Sched S{(const char*)SLOT1, (const char*)WOUT, 0, 0, 2048, 2048, T / 256, 8, 1, G, bx, 0}; EpiRes E{X, l == 0 ? a.in[0] : X, (l == 0 ? a.in[1] : X + (size_t)16384 * 2048) - (size_t)16384 * 2048}; pg8::gemm_phase(lds, S, 2048, E); }
        PH_END
        PH_BEGIN(8)
            rms_rows<1>(nullptr, nullptr, X, a.in[19] + l * 2048, SLOT1, bx, G);
        PH_END
        PH_BEGIN(9)
            { pg8::Sched S{(const char*)SLOT1, (const char*)WGU, 0, 0, 2048, 2048, T / 256, 44, 1, G, bx, 0}; EpiSwi E{HID}; pg8::gemm_phase(lds, S, 2048, E); }
        PH_END
        PH_BEGIN(10)
            { pg8::Sched S{(const char*)HID, (const char*)WDOWN, 0, 0, DFF, DFF, T / 256, 8, 1, G, bx, 0}; EpiRes E{X, X, X}; pg8::gemm_phase(lds, S, DFF, E); }
        PH_END
    }
    PH_BEGIN(11)
        rms_rows<2>(nullptr, nullptr, X, a.in[23], nullptr, bx, G);
    PH_END
#undef PH_BEGIN
#undef PH_END
}

extern "C" void kernel_launch(void* const* d_in, const int* in_sizes, int n_in, void* d_out, int out_size, void* d_ws, size_t ws_size, hipStream_t stream) {
    static int grid = 0;
    if (grid == 0) {
        if (n_in != 24 || out_size != T * DM || ws_size < WS_END) { fprintf(stderr, "kernel_launch: unexpected shapes / workspace (n_in %d out %d ws %zu need %zu)\n", n_in, out_size, ws_size, (size_t)WS_END); grid = -1; return; }
        int dev = 0, cus = 0, per_cu = 0;
        if (hipGetDevice(&dev) != hipSuccess || hipDeviceGetAttribute(&cus, hipDeviceAttributeMultiprocessorCount, dev) != hipSuccess) { grid = -1; return; }
        if (hipFuncSetAttribute((const void*)mega_fwd, hipFuncAttributeMaxDynamicSharedMemorySize, LDS_BYTES) != hipSuccess) { fprintf(stderr, "kernel_launch: hipFuncSetAttribute failed\n"); grid = -1; return; }
        if (hipOccupancyMaxActiveBlocksPerMultiprocessor(&per_cu, (const void*)mega_fwd, NTHREADS, LDS_BYTES) != hipSuccess || per_cu < 1) { fprintf(stderr, "kernel_launch: occupancy query says %d\n", per_cu); per_cu = 1; }
        (void)hipGetLastError();
        grid = cus * 1;
    }
    if (grid < 0) return;
    if (hipMemsetAsync((char*)d_ws + WS_CTL, 0, 256, stream) != hipSuccess) { fprintf(stderr, "kernel_launch: memset of the barrier word failed\n"); return; }
    Args a{};
    for (int i = 0; i < 24; ++i) a.in[i] = (const float*)d_in[i];
    a.out = (float*)d_out; a.ws = (unsigned char*)d_ws;
#if MK_ONE_LAUNCH
    a.ph_lo = 0; a.ph_hi = N_PHASES;
    void* args[] = {&a};
    hipError_t e = hipLaunchCooperativeKernel((const void*)mega_fwd, dim3(grid), dim3(NTHREADS), args, LDS_BYTES, stream);
    if (e != hipSuccess) fprintf(stderr, "cooperative launch failed: %s (grid %d)\n", hipGetErrorString(e), grid);
#else
    for (int p = 0; p < N_PHASES; ++p) {
        a.ph_lo = p; a.ph_hi = p + 1;
        hipLaunchKernelGGL(mega_fwd, dim3(grid), dim3(NTHREADS), LDS_BYTES, stream, a);
    }
#endif
}
```

```cpp
#include <hip/hip_runtime.h>
#include <hip/hip_cooperative_groups.h>
#include <cstdio>
#include <cstdint>
namespace cg = cooperative_groups;

#ifndef MK_ONE_LAUNCH
#define MK_ONE_LAUNCH 1
#endif

#define LAS __attribute__((address_space(3)))
typedef unsigned short bf16_t;
typedef short bf16x8 __attribute__((ext_vector_type(8)));
typedef float f32x4 __attribute__((ext_vector_type(4)));
typedef float f32x2 __attribute__((ext_vector_type(2)));
typedef unsigned u32x4 __attribute__((ext_vector_type(4)));
typedef unsigned u32x2 __attribute__((ext_vector_type(2)));

constexpr int T = 24576, DM = 2048, NBATCH = 6, SEQ = 4096, DFF = 5632, INW = 2816;
constexpr int NGRP = 48, NCHUNK = T / 32;
constexpr float EPS = 1e-6f;
constexpr int NTHREADS = 512;
constexpr int LDS_BYTES = 131072 + 1024;

constexpr size_t WS_WINAC = 0;
constexpr size_t WS_WINBF = WS_WINAC + (size_t)2304 * 2048 * 2;
constexpr size_t WS_WOUT  = WS_WINBF + (size_t)1024 * 2048 * 2;
constexpr size_t WS_WGLU  = WS_WOUT + (size_t)2048 * 2048 * 2;
constexpr size_t WS_WS    = WS_WGLU + (size_t)768 * 768 * 2;
constexpr size_t WS_WGU   = WS_WS + (size_t)6 * 128 * 128 * 2;
constexpr size_t WS_WDOWN = WS_WGU + (size_t)11264 * 2048 * 2;
constexpr size_t WS_DFT   = WS_WDOWN + (size_t)2048 * 5632 * 2;
constexpr size_t WS_VT    = WS_DFT;
constexpr size_t WS_D256  = WS_DFT + (size_t)49152 * 512 * 2;
constexpr size_t WS_AL    = WS_DFT + (size_t)4096 * 8192 * 2;
constexpr size_t WS_APW   = WS_AL + (size_t)48 * 2 * 64 * 2 * 4;
constexpr size_t WS_KT    = WS_APW + (size_t)48 * 2 * 33 * 64 * 2 * 4;
constexpr size_t WS_SLOT1 = WS_KT + (size_t)48 * 2 * 32 * 256 * 4;
constexpr size_t WS_ACT   = WS_SLOT1 + (size_t)T * 2048 * 2;
constexpr size_t WS_ZINA  = WS_ACT;
constexpr size_t WS_ZFT   = WS_ZINA + (size_t)T * 1536 * 2;
constexpr size_t WS_YCPRE = WS_ZFT;
constexpr size_t WS_UCAT  = WS_ZFT + (size_t)512 * 49152 * 2;
constexpr size_t WS_XS    = WS_UCAT + (size_t)48 * 768 * 768 * 2;
constexpr size_t WS_TE    = WS_XS + (size_t)48 * 768 * 256 * 4;
constexpr size_t WS_GM    = WS_TE + (size_t)48 * 512 * 768 * 2;
constexpr size_t WS_MIXEND = WS_GM + (size_t)48 * 256 * 512 * 2;
constexpr size_t WS_HID   = WS_ACT;
constexpr size_t WS_CTL   = WS_ACT + (size_t)T * 5632 * 2;
constexpr size_t WS_END   = WS_CTL + 256;
static_assert(WS_MIXEND <= WS_CTL, "mixer buffers must fit under the FFN hidden buffer");

struct Args { const float* in[24]; float* out; unsigned char* ws; int ph_lo, ph_hi; };

__device__ __forceinline__ int tid_l() { int t = threadIdx.x; asm volatile("" : "+v"(t)); return t; }
__device__ __forceinline__ unsigned cvt_pk_bf16(float lo, float hi) { unsigned r; asm("v_cvt_pk_bf16_f32 %0, %1, %2" : "=v"(r) : "v"(lo), "v"(hi)); return r; }
__device__ __forceinline__ float bf_lo(unsigned w) { return __uint_as_float(w << 16); }
__device__ __forceinline__ float bf_hi(unsigned w) { return __uint_as_float(w & 0xffff0000u); }
__device__ __forceinline__ bf16_t f2bf(float f) { return (bf16_t)(cvt_pk_bf16(f, 0.f) & 0xffffu); }
__device__ __forceinline__ float sigmoid_f(float v) { return __builtin_amdgcn_rcpf(1.0f + __builtin_amdgcn_exp2f(-1.4426950409f * v)); }
__device__ __forceinline__ float gelu_tanh(float x) { const float z = x * (1.5957691216f + 0.0713548163f * x * x); return x * sigmoid_f(z); }
__device__ __forceinline__ float wave_sum(float v) {
#pragma unroll
    for (int o = 32; o >= 1; o >>= 1) v += __shfl_xor(v, o);
    return v;
}

namespace pg8 {
constexpr int BM = 256, BK = 64, HALF = 128, HTB = HALF * BK * 2, STAGE_BYTES = 8 * HTB, NXCD = 8, WGM = 8;
__device__ __forceinline__ int lds_byte(int r, int c) { const int st = (r >> 4) * 2 + (c >> 5), rr = r & 15, cc = c & 31, ob = rr * 64 + cc * 2; return st * 1024 + (ob ^ (((ob >> 9) & 1) << 5)); }
__device__ __forceinline__ void stage_rc(int b, int& R, int& C) { const int st = b / 1024, sb = b % 1024, swz = sb ^ (((sb >> 9) & 1) << 5); R = (st >> 1) * 16 + swz / 64; C = (st & 1) * 32 + (swz % 64) / 2; }
__device__ __forceinline__ int perm32(int rho) { const int n = rho >> 4, i = rho & 15; return 8 * (i >> 2) + 4 * n + (i & 3); }

struct Unit { const char* A; const char* B; int pm, pn, grp; };
struct Sched {
    const char* A; const char* B; long gsA, gsB; int lda, ldb, nM, nN, nG, G, c, bmap, wgm;
    __device__ __forceinline__ bool next(int i, Unit& u) const {
        const int nwg = nM * nN;
        const long L = (long)i * G + c; if (c < 0 || L >= (long)nwg * nG) return false;
        const int grp = (int)(L / nwg); int wgid = (int)(L - (long)grp * nwg);
        { const int q = nwg / NXCD, r = nwg % NXCD, xcd = wgid % NXCD, off = wgid / NXCD; wgid = (xcd < r ? xcd * (q + 1) : r * (q + 1) + (xcd - r) * q) + off; }
        const int nig = wgm * nN, gid = wgid / nig, fm = gid * wgm, gsz = (nM - fm) < wgm ? (nM - fm) : wgm;
        u.pm = fm + ((wgid % nig) % gsz); u.pn = (wgid % nig) / gsz; u.grp = grp;
        u.A = A + (size_t)grp * gsA + (size_t)u.pm * 512 * lda; u.B = B + (size_t)grp * gsB + (bmap ? (size_t)((u.pn >> 4) * 4096 + (u.pn & 15) * 16) * 2 * ldb : (size_t)u.pn * 512 * ldb);
        return true;
    }
};

template <class Epi>
__device__ __forceinline__ void gemm_phase(LAS unsigned char* lds, const Sched& S, const int K, const Epi& E) {
    int tid = threadIdx.x; asm volatile("" : "+v"(tid));
    const int wid = __builtin_amdgcn_readfirstlane(tid >> 6), lane = tid & 63, wr = wid >> 2, wc = wid & 3, fr = lane & 15, fq = lane >> 4;
    const int nt = K / BK;
    unsigned voffA[2], voffB[2];
#pragma unroll
    for (int i = 0; i < 2; ++i) { int R, C; stage_rc(tid * 16 + i * 8192, R, C); const int Rb = Epi::PERM ? ((R & ~31) + perm32(R & 31)) : R;
        const int RbT = Epi::BMAP ? ((Rb >> 4) + 256 * (Rb & 15)) : Rb;
        voffA[i] = (unsigned)(R * S.lda + C) * 2u; voffB[i] = (unsigned)(RbT * S.ldb + C) * 2u; }
    const size_t kstep = (size_t)(BK * 2);
    const size_t hstepA = (size_t)HALF * S.lda * 2, hstepB = (size_t)(Epi::BMAP ? 8 : HALF) * S.ldb * 2;
    const unsigned ldsw = (unsigned)wid * 1024u;
    const int aoff = lds_byte(wr * 64 + fr, fq * 8), boff = lds_byte(wc * 32 + fr, fq * 8);
#define PG8_SA(b, h) (((b) * 2 + (h)) * HTB)
#define PG8_SB(b, h) ((4 + (b) * 2 + (h)) * HTB)
#define PG8_STAGE(bufoff, gbase, voff) do { _Pragma("unroll") for (int _i = 0; _i < 2; ++_i) \
        __builtin_amdgcn_global_load_lds((const unsigned*)((const char*)(gbase) + (voff)[_i]), (LAS unsigned*)(lds + (bufoff) + ldsw + _i * 8192), 16, 0, 0); } while (0)
#define PG8_LDA(dst, b, h) do { _Pragma("unroll") for (int m = 0; m < 4; ++m) _Pragma("unroll") for (int k = 0; k < 2; ++k) dst[m][k] = *(const LAS bf16x8*)(lds + PG8_SA(b, h) + aoff + m * 2048 + k * 1024); } while (0)
#define PG8_LDB(dst, b, h) do { _Pragma("unroll") for (int n = 0; n < 2; ++n) _Pragma("unroll") for (int k = 0; k < 2; ++k) dst[n][k] = *(const LAS bf16x8*)(lds + PG8_SB(b, h) + boff + n * 2048 + k * 1024); } while (0)
#define PG8_MMA(ai, bj, At, Bt) do { __builtin_amdgcn_s_setprio(1); _Pragma("unroll") for (int m = 0; m < 4; ++m) _Pragma("unroll") for (int n = 0; n < 2; ++n) _Pragma("unroll") for (int k = 0; k < 2; ++k) \
        acc[ai][bj][m][n] = __builtin_amdgcn_mfma_f32_16x16x32_bf16(Bt[n][k], At[m][k], acc[ai][bj][m][n], 0, 0, 0); __builtin_amdgcn_s_setprio(0); } while (0)
#define PG8_WAIT_V(n) asm volatile("s_waitcnt vmcnt(" #n ")" ::: "memory")
#define PG8_WAIT_L(n) asm volatile("s_waitcnt lgkmcnt(" #n ")" ::: "memory")
#define PG8_BAR __builtin_amdgcn_s_barrier()
#define PG8_SCHED __builtin_amdgcn_sched_barrier(0)
    Unit cur, nxt; int ui = 0;
    if (!S.next(0, cur)) return;
    f32x4 acc[2][2][4][2];
#pragma unroll
    for (int a = 0; a < 2; ++a)
#pragma unroll
        for (int b = 0; b < 2; ++b)
#pragma unroll
            for (int m = 0; m < 4; ++m)
#pragma unroll
                for (int n = 0; n < 2; ++n) acc[a][b][m][n] = (f32x4){0.f, 0.f, 0.f, 0.f};
    bf16x8 At[4][2], B0[2][2], B1[2][2];
    const char* cA = cur.A; const char* cB = cur.B;
    PG8_STAGE(PG8_SB(0, 0), cB, voffB); PG8_STAGE(PG8_SB(0, 1), cB + hstepB, voffB); PG8_STAGE(PG8_SA(0, 0), cA, voffA); PG8_STAGE(PG8_SA(0, 1), cA + hstepA, voffA);
    if (wr == 1) PG8_BAR;
    PG8_WAIT_V(2); PG8_BAR;
    PG8_STAGE(PG8_SB(1, 0), cB + kstep, voffB); PG8_STAGE(PG8_SA(1, 0), cA + kstep, voffA); PG8_STAGE(PG8_SB(1, 1), cB + hstepB + kstep, voffB);
    PG8_WAIT_V(6); PG8_BAR;
    for (;;) {
        const bool has_next = S.next(ui + 1, nxt);
        const char* nA = has_next ? nxt.A : cA; const char* nB = has_next ? nxt.B : cB;
        for (int t = 0; t < nt; t += 2) {
            const bool last = (t == nt - 2);
            const char* a1 = cA + (size_t)(t + 1) * kstep;
            const char* a2 = last ? nA : cA + (size_t)(t + 2) * kstep; const char* b2 = last ? nB : cB + (size_t)(t + 2) * kstep;
            const char* a3 = a2 + kstep; const char* b3 = b2 + kstep;
            PG8_LDB(B0, 0, 0); PG8_LDB(B1, 0, 1); PG8_SCHED; PG8_LDA(At, 0, 0); PG8_STAGE(PG8_SA(1, 1), a1 + hstepA, voffA);
            PG8_WAIT_V(8); PG8_WAIT_L(0); PG8_BAR; PG8_MMA(0, 0, At, B0); PG8_MMA(0, 1, At, B1); PG8_BAR; PG8_SCHED;
            PG8_LDA(At, 0, 1); PG8_STAGE(PG8_SB(0, 0), b2, voffB); PG8_STAGE(PG8_SB(0, 1), b2 + hstepB, voffB); PG8_STAGE(PG8_SA(0, 0), a2, voffA);
            PG8_WAIT_V(8); PG8_WAIT_L(0); PG8_BAR; PG8_MMA(1, 0, At, B0); PG8_MMA(1, 1, At, B1); PG8_BAR; PG8_SCHED;
            PG8_LDB(B0, 1, 0); PG8_LDB(B1, 1, 1); PG8_SCHED; PG8_LDA(At, 1, 0); PG8_STAGE(PG8_SA(0, 1), a2 + hstepA, voffA);
            PG8_WAIT_V(8); PG8_WAIT_L(0); PG8_BAR; PG8_MMA(0, 0, At, B0); PG8_MMA(0, 1, At, B1); PG8_BAR; PG8_SCHED;
            PG8_LDA(At, 1, 1); PG8_STAGE(PG8_SB(1, 0), b3, voffB); PG8_STAGE(PG8_SB(1, 1), b3 + hstepB, voffB); PG8_STAGE(PG8_SA(1, 0), a3, voffA);
            PG8_WAIT_V(8); PG8_WAIT_L(0); PG8_BAR; PG8_MMA(1, 0, At, B0); PG8_MMA(1, 1, At, B1); PG8_BAR; PG8_SCHED;
        }
        if (wr == 0) PG8_BAR;
        E(acc, cur, wr, wc, fr, fq);
        if (!has_next) break;
#pragma unroll
        for (int a = 0; a < 2; ++a)
#pragma unroll
            for (int b = 0; b < 2; ++b)
#pragma unroll
                for (int m = 0; m < 4; ++m)
#pragma unroll
                    for (int n = 0; n < 2; ++n) acc[a][b][m][n] = (f32x4){0.f, 0.f, 0.f, 0.f};
        cur = nxt; cA = nA; cB = nB; ++ui;
        if (wr == 1) PG8_BAR;
    }
    PG8_WAIT_V(0);
    PG8_BAR;
#undef PG8_SA
#undef PG8_SB
#undef PG8_STAGE
#undef PG8_LDA
#undef PG8_LDB
#undef PG8_MMA
#undef PG8_WAIT_V
#undef PG8_WAIT_L
#undef PG8_BAR
#undef PG8_SCHED
}
}
using pg8::Unit;
typedef const f32x4 (&AccRef)[2][2][4][2];

__device__ __forceinline__ u32x4 pack8(f32x4 v0, f32x4 v1) { u32x4 w; w.x = cvt_pk_bf16(v0[0], v0[1]); w.y = cvt_pk_bf16(v0[2], v0[3]); w.z = cvt_pk_bf16(v1[0], v1[1]); w.w = cvt_pk_bf16(v1[2], v1[3]); return w; }
__device__ __forceinline__ f32x4 gelu4(f32x4 v) { return (f32x4){gelu_tanh(v[0]), gelu_tanh(v[1]), gelu_tanh(v[2]), gelu_tanh(v[3])}; }

struct EpiWin { static constexpr bool PERM = true; static constexpr int BMAP = 0; bf16_t* zina; bf16_t* ucat;
    __device__ __forceinline__ void operator()(AccRef acc, const Unit& u, int wr, int wc, int fr, int fq) const {
        const int row0 = u.pm * 256 + wr * 64 + fr;
        if (u.pn < 6) {
            const int col0 = u.pn * 256 + wc * 32 + 8 * fq;
#pragma unroll
            for (int ai = 0; ai < 2; ++ai)
#pragma unroll
                for (int m = 0; m < 4; ++m) { bf16_t* rowp = zina + (size_t)(row0 + ai * 128 + m * 16) * 1536 + col0;
#pragma unroll
                    for (int bj = 0; bj < 2; ++bj) *(u32x4*)(rowp + bj * 128) = pack8(gelu4(acc[ai][bj][m][0]), gelu4(acc[ai][bj][m][1])); }
        } else {
            const int cc0 = (u.pn - 6) * 256 + wc * 32 + 8 * fq;
#pragma unroll
            for (int ai = 0; ai < 2; ++ai)
#pragma unroll
                for (int m = 0; m < 4; ++m) { const int t = row0 + ai * 128 + m * 16, n = t >> 5, j = t & 31;
#pragma unroll
                    for (int bj = 0; bj < 2; ++bj) { const int cc = cc0 + bj * 128, g = cc >> 4, c0 = cc & 15;
                        *(u32x4*)(ucat + ((size_t)(g * 768 + n) * 768 + j * 16 + c0)) = pack8(acc[ai][bj][m][0], acc[ai][bj][m][1]); } }
        }
    } };
struct EpiZft2 { static constexpr bool PERM = true; static constexpr int BMAP = 1; bf16_t* zf2;
    __device__ __forceinline__ void operator()(AccRef acc, const Unit& u, int wr, int wc, int fr, int fq) const {
        const int row0 = u.pm * 256 + wr * 64 + fr, b = u.pn >> 4, n1b = (u.pn & 15) * 16 + 2 * wc + (fq >> 1), n20 = (fq & 1) * 8;
#pragma unroll
        for (int ai = 0; ai < 2; ++ai)
#pragma unroll
            for (int m = 0; m < 4; ++m) { const int r = row0 + ai * 128 + m * 16, ri = r >> 9, gc = r & 511;
#pragma unroll
                for (int bj = 0; bj < 2; ++bj) { const int n1 = n1b + 8 * bj;
                    *(u32x4*)(zf2 + ((((size_t)b * 512 + gc) * 256 + n1) * 32 + ri * 16 + n20)) = pack8(acc[ai][bj][m][0], acc[ai][bj][m][1]); } }
    } };
struct EpiFour2 { static constexpr bool PERM = true; static constexpr int BMAP = 0; bf16_t* y;
    __device__ __forceinline__ void operator()(AccRef acc, const Unit& u, int wr, int wc, int fr, int fq) const {
        const int bk = u.pn >> 1, b = bk >> 4, k2 = bk & 15, col0 = 768 + (u.pn & 1) * 256 + wc * 32 + 8 * fq, k10 = wr * 64 + fr;
#pragma unroll
        for (int ai = 0; ai < 2; ++ai)
#pragma unroll
            for (int m = 0; m < 4; ++m) { const int k1 = k10 + ai * 128 + m * 16; bf16_t* rowp = y + (size_t)(b * 4096 + 16 * k1 + k2) * 2048 + col0;
#pragma unroll
                for (int bj = 0; bj < 2; ++bj) *(u32x4*)(rowp + bj * 128) = pack8(acc[ai][bj][m][0], acc[ai][bj][m][1]); }
    } };
struct EpiXs { static constexpr bool PERM = false; static constexpr int BMAP = 0; float* xs;
    __device__ __forceinline__ void operator()(AccRef acc, const Unit& u, int wr, int wc, int fr, int fq) const {
        const int row0 = u.pm * 256 + wr * 64 + fr, col0 = wc * 32 + 4 * fq;
#pragma unroll
        for (int ai = 0; ai < 2; ++ai)
#pragma unroll
            for (int m = 0; m < 4; ++m) { float* rowp = xs + ((size_t)u.grp * 768 + row0 + ai * 128 + m * 16) * 256 + col0;
#pragma unroll
                for (int bj = 0; bj < 2; ++bj)
#pragma unroll
                    for (int n = 0; n < 2; ++n) *(f32x4*)(rowp + bj * 128 + n * 16) = acc[ai][bj][m][n]; }
    } };
struct EpiYc { static constexpr bool PERM = true; static constexpr int BMAP = 0; bf16_t* ycpre;
    __device__ __forceinline__ void operator()(AccRef acc, const Unit& u, int wr, int wc, int fr, int fq) const {
        const int row0 = u.pm * 256 + wr * 64 + fr, col0 = u.pn * 256 + wc * 32 + 8 * fq;
#pragma unroll
        for (int ai = 0; ai < 2; ++ai)
#pragma unroll
            for (int m = 0; m < 4; ++m) { const int n = row0 + ai * 128 + m * 16;
#pragma unroll
                for (int bj = 0; bj < 2; ++bj) { const int col = col0 + bj * 128, i = col >> 4, c0 = col & 15;
                    *(u32x4*)(ycpre + ((size_t)(n * 32 + i) * 768 + u.grp * 16 + c0)) = pack8(gelu4(acc[ai][bj][m][0]), gelu4(acc[ai][bj][m][1])); } }
    } };
struct EpiGlu { static constexpr bool PERM = true; static constexpr int BMAP = 0; const bf16_t* ycpre; const float* bias; bf16_t* y;
    __device__ __forceinline__ void operator()(AccRef acc, const Unit& u, int wr, int wc, int fr, int fq) const {
        const int row0 = u.pm * 256 + wr * 64 + fr, col0 = u.pn * 256 + wc * 32 + 8 * fq;
        f32x4 bv[2][2];
#pragma unroll
        for (int bj = 0; bj < 2; ++bj)
#pragma unroll
            for (int n = 0; n < 2; ++n) bv[bj][n] = *(const f32x4*)(bias + col0 + bj * 128 + 4 * n);
#pragma unroll
        for (int ai = 0; ai < 2; ++ai) {
            u32x4 yc[4][2];
#pragma unroll
            for (int m = 0; m < 4; ++m)
#pragma unroll
                for (int bj = 0; bj < 2; ++bj) yc[m][bj] = *(const u32x4*)(ycpre + (size_t)(row0 + ai * 128 + m * 16) * 768 + col0 + bj * 128);
#pragma unroll
            for (int m = 0; m < 4; ++m) { const size_t t = (size_t)(row0 + ai * 128 + m * 16);
#pragma unroll
                for (int bj = 0; bj < 2; ++bj) { const int col = col0 + bj * 128; const u32x4 w = yc[m][bj];
                    const f32x4 v0 = acc[ai][bj][m][0] + bv[bj][0], v1 = acc[ai][bj][m][1] + bv[bj][1];
                    const f32x4 o0 = (f32x4){bf_lo(w.x) * sigmoid_f(v0[0]), bf_hi(w.x) * sigmoid_f(v0[1]), bf_lo(w.y) * sigmoid_f(v0[2]), bf_hi(w.y) * sigmoid_f(v0[3])};
                    const f32x4 o1 = (f32x4){bf_lo(w.z) * sigmoid_f(v1[0]), bf_hi(w.z) * sigmoid_f(v1[1]), bf_lo(w.w) * sigmoid_f(v1[2]), bf_hi(w.w) * sigmoid_f(v1[3])};
                    *(u32x4*)(y + t * 2048 + 1280 + col) = pack8(o0, o1); } }
            asm volatile("" ::: "memory"); }
    } };
struct EpiRes { static constexpr bool PERM = false; static constexpr int BMAP = 0; float* x; const float* r0; const float* r1adj;
    __device__ __forceinline__ void operator()(AccRef acc, const Unit& u, int wr, int wc, int fr, int fq) const {
        const int row0 = u.pm * 256 + wr * 64 + fr, col0 = u.pn * 256 + wc * 32 + 4 * fq;
        const float* sb = u.pm < 64 ? r0 : r1adj;
#pragma unroll
        for (int ai = 0; ai < 2; ++ai) {
            const size_t off = (size_t)(row0 + ai * 128) * 2048 + col0;
            f32x4 ld[4][2][2];
#pragma unroll
            for (int m = 0; m < 4; ++m)
#pragma unroll
                for (int bj = 0; bj < 2; ++bj)
#pragma unroll
                    for (int n = 0; n < 2; ++n) ld[m][bj][n] = *(const f32x4*)(sb + off + (size_t)m * 16 * 2048 + bj * 128 + n * 16);
#pragma unroll
            for (int m = 0; m < 4; ++m)
#pragma unroll
                for (int bj = 0; bj < 2; ++bj)
#pragma unroll
                    for (int n = 0; n < 2; ++n) *(f32x4*)(x + off + (size_t)m * 16 * 2048 + bj * 128 + n * 16) = ld[m][bj][n] + acc[ai][bj][m][n];
            asm volatile("" ::: "memory"); }
    } };
struct EpiSwi { static constexpr bool PERM = true; static constexpr int BMAP = 0; bf16_t* hid;
    __device__ __forceinline__ void operator()(AccRef acc, const Unit& u, int wr, int wc, int fr, int fq) const {
        const int row0 = u.pm * 256 + wr * 64 + fr, col0 = u.pn * 128 + wc * 32 + 8 * fq;
#pragma unroll
        for (int ai = 0; ai < 2; ++ai)
#pragma unroll
            for (int m = 0; m < 4; ++m) {
                f32x4 o[2];
#pragma unroll
                for (int n = 0; n < 2; ++n) { const f32x4 g = acc[ai][0][m][n], up = acc[ai][1][m][n];
                    o[n] = (f32x4){g[0] * sigmoid_f(g[0]) * up[0], g[1] * sigmoid_f(g[1]) * up[1], g[2] * sigmoid_f(g[2]) * up[2], g[3] * sigmoid_f(g[3]) * up[3]}; }
                *(u32x4*)(hid + (size_t)(row0 + ai * 128 + m * 16) * 5632 + col0) = pack8(o[0], o[1]); }
    } };

struct TrDesc { const float* src; int ldsrc, K, c0, nc; bf16_t* dst; int mode, doff; };
template <class SEL, class CTX>
__device__ __forceinline__ void transpose_run(LAS unsigned char* lds, const CTX& ctx, int t0, int t1, int stride) {
    const int tid = tid_l();
    LAS unsigned* tl = (LAS unsigned*)lds;
    const int k = tid >> 3, n8 = (tid & 7) * 8;
    f32x4 v[4][2];
    TrDesc d; int lt;
    if (t0 < t1) { SEL::get(ctx, t0, d, lt); const int nkt = d.K >> 6, kt = lt % nkt, ct = lt / nkt;
        const float* s = d.src + (size_t)(kt * 64 + k) * d.ldsrc + d.c0 + ct * 256 + n8;
#pragma unroll
        for (int q = 0; q < 4; ++q) { v[q][0] = *(const f32x4*)(s + q * 64); v[q][1] = *(const f32x4*)(s + q * 64 + 4); } }
    for (int t = t0; t < t1; t += stride) {
        SEL::get(ctx, t, d, lt);
        const int nkt = d.K >> 6, kt = lt % nkt, ct = lt / nkt;
        unsigned w[4][4];
#pragma unroll
        for (int q = 0; q < 4; ++q)
#pragma unroll
            for (int j = 0; j < 4; ++j) { const float lo = v[q][0][j], hi = v[q][1][j];
                const float recv = __shfl_xor((k & 1) ? lo : hi, 8);
                w[q][j] = (k & 1) ? cvt_pk_bf16(recv, hi) : cvt_pk_bf16(lo, recv); }
        if (t + stride < t1) { TrDesc dn; int ltn; SEL::get(ctx, t + stride, dn, ltn); const int nktn = dn.K >> 6, ktn = ltn % nktn, ctn = ltn / nktn;
            const float* s = dn.src + (size_t)(ktn * 64 + k) * dn.ldsrc + dn.c0 + ctn * 256 + n8;
#pragma unroll
            for (int q = 0; q < 4; ++q) { v[q][0] = *(const f32x4*)(s + q * 64); v[q][1] = *(const f32x4*)(s + q * 64 + 4); } }
#pragma unroll
        for (int q = 0; q < 4; ++q)
#pragma unroll
            for (int j = 0; j < 4; ++j) tl[(q * 64 + n8 + j + ((k & 1) ? 4 : 0)) * 33 + (k >> 1)] = w[q][j];
        __syncthreads();
        { const int n = tid >> 3, k8 = (tid & 7) * 8;
#pragma unroll
          for (int q = 0; q < 4; ++q) {
              const LAS unsigned* p = tl + (q * 64 + n) * 33 + (k8 >> 1);
              u32x4 ww; ww.x = p[0]; ww.y = p[1]; ww.z = p[2]; ww.w = p[3];
              const int cc = ct * 256 + q * 64 + n;
              const int drow = d.mode == 0 ? d.doff + cc : ((cc >> 7) * 256 + (cc & 127) + (d.mode == 2 ? 128 : 0));
              *(u32x4*)(d.dst + (size_t)drow * d.K + kt * 64 + k8) = ww; } }
        __syncthreads();
    }
}
struct SelOne { static __device__ __forceinline__ void get(const TrDesc& c, int t, TrDesc& d, int& lt) { d = c; lt = t; } };
struct FfnCtx { const float* wg; const float* wu; const float* wd; bf16_t* wgu; bf16_t* wdown; };
struct SelFfn { static __device__ __forceinline__ void get(const FfnCtx& c, int t, TrDesc& d, int& lt) {
    if (t < 704)       { d = TrDesc{c.wg, DFF, 2048, 0, DFF, c.wgu, 1, 0}; lt = t; }
    else if (t < 1408) { d = TrDesc{c.wu, DFF, 2048, 0, DFF, c.wgu, 2, 0}; lt = t - 704; }
    else               { d = TrDesc{c.wd, 2048, DFF, 0, 2048, c.wdown, 0, 0}; lt = t - 1408; } } };

__device__ __forceinline__ double kd(double c) { asm volatile("" : "+v"(c)); return c; }
__device__ __forceinline__ double exp_d(double x) {
    const double y = x * 0.125; double term = 1.0, sum = 1.0;
#pragma unroll 1
    for (int n = 1; n <= 22; ++n) { term *= y / (double)n; sum += term; }
    sum *= sum; sum *= sum; sum *= sum; return sum;
}
__device__ __forceinline__ void sincos_d(double x, double& s, double& c) {
    const double k = rint(x * kd(0.15915494309189535));
    double r = fma(-k, kd(6.283185307179586232), x); r = fma(-k, kd(2.4492935982947064e-16), r);
    const double y = r * 0.125, my2 = -(y * y);
    double sn = y, cs = 1.0, ts = y, tc = 1.0;
#pragma unroll 1
    for (int n = 1; n <= 10; ++n) { tc *= my2 / (double)((2 * n - 1) * (2 * n)); cs += tc; ts *= my2 / (double)((2 * n) * (2 * n + 1)); sn += ts; }
#pragma unroll 1
    for (int i = 0; i < 3; ++i) { const double c2 = cs * cs - sn * sn, s2 = 2.0 * sn * cs; cs = c2; sn = s2; }
    s = sn; c = cs;
}

__device__ __forceinline__ void s5_disc(const Args& a, int l, int g, int dir, int p, double& ar, double& ai, double& qr, double& qi) {
    const double lr = (double)a.in[7][((l * 2 + dir) * 48 + g) * 64 + p], li = (double)a.in[8][((l * 2 + dir) * 48 + g) * 64 + p];
    const double st = exp_d((double)a.in[9][(l * 2 + dir) * 48 + g]);
    const double mag = exp_d(lr * st); double sn, cs; sincos_d(li * st, sn, cs);
    ar = mag * cs; ai = mag * sn; const double den = lr * lr + li * li, nr = ar - 1.0;
    qr = (nr * lr + ai * li) / den; qi = (ai * lr - nr * li) / den;
}
__device__ __forceinline__ void s5_group_a(LAS unsigned char* lds, const Args& a, int l, int g) {
    const int tid = tid_l();
    LAS float* apw = (LAS float*)lds;
    LAS float* bbr = apw + 2 * 33 * 64 * 2;
    bf16_t* GMp = (bf16_t*)(a.ws + WS_GM); float* ALp = (float*)(a.ws + WS_AL); float* APWp = (float*)(a.ws + WS_APW);
    if (tid < 128) {
        const int dir = tid >> 6, p = tid & 63;
        double ar, ai, qr, qi; s5_disc(a, l, g, dir, p, ar, ai, qr, qi);
        double pr = 1.0, pi = 0.0;
#pragma unroll 1
        for (int tau = 0; tau <= 32; ++tau) { const float fr_ = (float)pr, fi_ = (float)pi;
            apw[((dir * 33 + tau) * 64 + p) * 2] = fr_; apw[((dir * 33 + tau) * 64 + p) * 2 + 1] = fi_;
            *(f32x2*)(APWp + ((size_t)((g * 2 + dir) * 33 + tau) * 64 + p) * 2) = (f32x2){fr_, fi_};
            const double nr2 = pr * ar - pi * ai, ni2 = pr * ai + pi * ar; pr = nr2; pi = ni2; }
        ALp[((g * 2 + dir) * 64 + p) * 2] = apw[((dir * 33 + 32) * 64 + p) * 2]; ALp[((g * 2 + dir) * 64 + p) * 2 + 1] = apw[((dir * 33 + 32) * 64 + p) * 2 + 1];
#pragma unroll 1
        for (int c = 0; c < 16; ++c) { const double br = (double)a.in[10][((l * 48 + g) * 64 + p) * 16 + c], bi = (double)a.in[11][((l * 48 + g) * 64 + p) * 16 + c];
            bbr[((dir * 64 + p) * 16 + c) * 2] = (float)(qr * br - qi * bi); bbr[((dir * 64 + p) * 16 + c) * 2 + 1] = (float)(qr * bi + qi * br); }
    }
    __syncthreads();
    {
        const int row = tid >> 1, half = tid & 1, dir = row >> 7, p = (row >> 1) & 63, ri = row & 1;
        bf16_t* rowp = GMp + ((size_t)g * 256 + row) * 512;
        for (int jj = 0; jj < 16; ++jj) { const int j = half * 16 + jj, e = dir == 0 ? 31 - j : j;
            const float wr_ = apw[((dir * 33 + e) * 64 + p) * 2], wi_ = apw[((dir * 33 + e) * 64 + p) * 2 + 1];
            float v[16];
#pragma unroll
            for (int c2 = 0; c2 < 16; ++c2) { const float Br = bbr[((dir * 64 + p) * 16 + c2) * 2], Bi = bbr[((dir * 64 + p) * 16 + c2) * 2 + 1];
                v[c2] = ri == 0 ? wr_ * Br - wi_ * Bi : wr_ * Bi + wi_ * Br; }
            u32x4 w0, w1; w0.x = cvt_pk_bf16(v[0], v[1]); w0.y = cvt_pk_bf16(v[2], v[3]); w0.z = cvt_pk_bf16(v[4], v[5]); w0.w = cvt_pk_bf16(v[6], v[7]);
            w1.x = cvt_pk_bf16(v[8], v[9]); w1.y = cvt_pk_bf16(v[10], v[11]); w1.z = cvt_pk_bf16(v[12], v[13]); w1.w = cvt_pk_bf16(v[14], v[15]);
            *(u32x4*)(rowp + j * 16) = w0; *(u32x4*)(rowp + j * 16 + 8) = w1; }
    }
    __syncthreads();
}
__device__ __forceinline__ void s5_ktab(LAS unsigned char* lds, const Args& a, int l, int task) {
    const int tid = tid_l(), g = task >> 3, dir = (task >> 2) & 1, tb = task & 3;
    LAS float* ap8 = (LAS float*)lds;
    LAS float* bbr = ap8 + 8 * 64 * 2;
    LAS float* ccx = bbr + 64 * 16 * 2;
    LAS float* cw  = ccx + 16 * 64 * 2;
    float* KTp = (float*)(a.ws + WS_KT);
    if (tid < 64) {
        const int p = tid; double ar, ai, qr, qi; s5_disc(a, l, g, dir, p, ar, ai, qr, qi);
        double pr = 1.0, pi = 0.0;
#pragma unroll 1
        for (int t = 0; t < tb * 8; ++t) { const double nr2 = pr * ar - pi * ai, ni2 = pr * ai + pi * ar; pr = nr2; pi = ni2; }
#pragma unroll 1
        for (int t = 0; t < 8; ++t) { ap8[(t * 64 + p) * 2] = (float)pr; ap8[(t * 64 + p) * 2 + 1] = (float)pi;
            const double nr2 = pr * ar - pi * ai, ni2 = pr * ai + pi * ar; pr = nr2; pi = ni2; }
#pragma unroll 1
        for (int c = 0; c < 16; ++c) { const double br = (double)a.in[10][((l * 48 + g) * 64 + p) * 16 + c], bi = (double)a.in[11][((l * 48 + g) * 64 + p) * 16 + c];
            bbr[(p * 16 + c) * 2] = (float)(qr * br - qi * bi); bbr[(p * 16 + c) * 2 + 1] = (float)(qr * bi + qi * br); }
    }
    for (int idx = tid; idx < 1024; idx += NTHREADS) { const int c = idx >> 6, p = idx & 63;
        ccx[idx * 2] = a.in[12][((l * 48 + g) * 16 + c) * 64 + p]; ccx[idx * 2 + 1] = a.in[13][((l * 48 + g) * 16 + c) * 64 + p]; }
    __syncthreads();
    for (int idx = tid; idx < 8192; idx += NTHREADS) { const int t = idx >> 10, cp = idx & 1023, p = idx & 63;
        const float Cr = ccx[cp * 2], Ci = ccx[cp * 2 + 1], wr_ = ap8[(t * 64 + p) * 2], wi_ = ap8[(t * 64 + p) * 2 + 1];
        cw[idx * 2] = Cr * wr_ - Ci * wi_; cw[idx * 2 + 1] = Cr * wi_ + Ci * wr_; }
    __syncthreads();
#pragma unroll
    for (int k = 0; k < 4; ++k) { const int o = tid + k * NTHREADS, t = o >> 8, c = (o >> 4) & 15, c2 = o & 15;
        float s = 0.f;
        for (int p = 0; p < 64; ++p) s += cw[((t * 16 + c) * 64 + p) * 2] * bbr[(p * 16 + c2) * 2] - cw[((t * 16 + c) * 64 + p) * 2 + 1] * bbr[(p * 16 + c2) * 2 + 1];
        KTp[((size_t)((g * 2 + dir) * 32 + tb * 8 + t)) * 256 + c * 16 + c2] = s; }
    __syncthreads();
}
__device__ __forceinline__ void s5_te(const Args& a, int l, int task) {
    const int tid = tid_l(), g = task >> 2, qd = task & 3, r = tid >> 2, sub = tid & 3, i = qd * 8 + (r >> 4), c = r & 15;
    const float* KTp = (const float*)(a.ws + WS_KT); const float* APWp = (const float*)(a.ws + WS_APW);
    bf16_t* rowp = (bf16_t*)(a.ws + WS_TE) + ((size_t)g * 512 + i * 16 + c) * 768;
    const float dsk = a.in[14][l * 768 + g * 16 + c];
    const float* kf = KTp + (size_t)((g * 2 + 0) * 32) * 256 + c * 16; const float* kb = KTp + (size_t)((g * 2 + 1) * 32) * 256 + c * 16;
#pragma unroll
    for (int jb = 0; jb < 8; jb += 4) {
        f32x4 v[4][4];
#pragma unroll
        for (int jq = 0; jq < 4; ++jq) { const int j = sub * 8 + jb + jq;
            const float* kp = j < i ? kf + (i - j) * 256 : (j > i ? kb + (j - i) * 256 : kf);
#pragma unroll
            for (int q = 0; q < 4; ++q) v[jq][q] = *(const f32x4*)(kp + q * 4);
            if (j == i) {
#pragma unroll
                for (int q = 0; q < 4; ++q) { v[jq][q] += *(const f32x4*)(kb + q * 4);
#pragma unroll
                    for (int e = 0; e < 4; ++e) v[jq][q][e] += (q * 4 + e == c) ? dsk : 0.f; } } }
#pragma unroll
        for (int jq = 0; jq < 4; ++jq) { const int j = sub * 8 + jb + jq;
            *(u32x4*)(rowp + j * 16) = pack8(v[jq][0], v[jq][1]); *(u32x4*)(rowp + j * 16 + 8) = pack8(v[jq][2], v[jq][3]); } }
    { const int dir = sub >> 1, p0 = (sub & 1) * 32, e = dir == 0 ? i + 1 : 32 - i;
      const float* cr = a.in[12] + ((l * 48 + g) * 16 + c) * 64 + p0; const float* ci = a.in[13] + ((l * 48 + g) * 16 + c) * 64 + p0;
      const float* aw = APWp + ((size_t)((g * 2 + dir) * 33 + e) * 64 + p0) * 2;
#pragma unroll 2
      for (int p4 = 0; p4 < 32; p4 += 4) { const f32x4 Cr = *(const f32x4*)(cr + p4), Ci = *(const f32x4*)(ci + p4), w0 = *(const f32x4*)(aw + p4 * 2), w1 = *(const f32x4*)(aw + p4 * 2 + 4);
          u32x4 ww; ww.x = cvt_pk_bf16(Cr[0] * w0[0] - Ci[0] * w0[1], -(Cr[0] * w0[1] + Ci[0] * w0[0])); ww.y = cvt_pk_bf16(Cr[1] * w0[2] - Ci[1] * w0[3], -(Cr[1] * w0[3] + Ci[1] * w0[2]));
          ww.z = cvt_pk_bf16(Cr[2] * w1[0] - Ci[2] * w1[1], -(Cr[2] * w1[1] + Ci[2] * w1[0])); ww.w = cvt_pk_bf16(Cr[3] * w1[2] - Ci[3] * w1[3], -(Cr[3] * w1[3] + Ci[3] * w1[2]));
          *(u32x4*)(rowp + 512 + dir * 128 + (p0 + p4) * 2) = ww; } }
}

__device__ __forceinline__ void winbf_task(LAS unsigned char* lds, const float* w_in_l, bf16_t* dst, int task) {
    const int tid = tid_l(), g = task & 3, k0 = (task >> 2) * 64;
    LAS float* Wt = (LAS float*)lds;
    LAS float* tc = Wt + 64 * 128; LAS float* ts = tc + 128;
    { const int k = tid >> 3, c16 = (tid & 7) * 16; const float* s = w_in_l + (size_t)(k0 + k) * INW + 1536 + g * 128 + c16;
#pragma unroll
      for (int q = 0; q < 4; ++q) *(LAS f32x4*)(Wt + k * 128 + c16 + q * 4) = *(const f32x4*)(s + q * 4); }
    if (tid < 128) { float sn, cs; sincospif((float)tid * (1.0f / 64.0f), &sn, &cs); tc[tid] = cs; ts[tid] = sn; }
    __syncthreads();
    const int cp = tid & 127, kq = tid >> 7;
    float aC[16], aS[16];
#pragma unroll
    for (int kk = 0; kk < 16; ++kk) { aC[kk] = 0.f; aS[kk] = 0.f; }
    for (int c = 0; c < 128; ++c) { const int idx = (c * cp) & 127; const float vc = tc[idx], vs = ts[idx];
#pragma unroll
        for (int kk = 0; kk < 16; ++kk) { const float w = Wt[(kq * 16 + kk) * 128 + c]; aC[kk] += w * vc; aS[kk] += w * vs; } }
    bf16_t* dc = dst + (size_t)(g * 128 + cp) * 2048 + k0 + kq * 16; bf16_t* ds = dst + (size_t)(512 + g * 128 + cp) * 2048 + k0 + kq * 16;
    u32x4 w; w.x = cvt_pk_bf16(aC[0], aC[1]); w.y = cvt_pk_bf16(aC[2], aC[3]); w.z = cvt_pk_bf16(aC[4], aC[5]); w.w = cvt_pk_bf16(aC[6], aC[7]); *(u32x4*)dc = w;
    w.x = cvt_pk_bf16(aC[8], aC[9]); w.y = cvt_pk_bf16(aC[10], aC[11]); w.z = cvt_pk_bf16(aC[12], aC[13]); w.w = cvt_pk_bf16(aC[14], aC[15]); *(u32x4*)(dc + 8) = w;
    w.x = cvt_pk_bf16(aS[0], aS[1]); w.y = cvt_pk_bf16(aS[2], aS[3]); w.z = cvt_pk_bf16(aS[4], aS[5]); w.w = cvt_pk_bf16(aS[6], aS[7]); *(u32x4*)ds = w;
    w.x = cvt_pk_bf16(aS[8], aS[9]); w.y = cvt_pk_bf16(aS[10], aS[11]); w.z = cvt_pk_bf16(aS[12], aS[13]); w.w = cvt_pk_bf16(aS[14], aS[15]); *(u32x4*)(ds + 8) = w;
    __syncthreads();
}

__device__ __forceinline__ void d256_gen(bf16_t* d256, int bx, int G) {
    for (int idx = bx * NTHREADS + tid_l(); idx < 256 * 512; idx += G * NTHREADS) { const int k1 = idx >> 9, ri = (idx >> 8) & 1, n1 = idx & 255, e = (n1 * k1) & 255;
        float sn, cs; sincospif((float)e * (1.0f / 128.0f), &sn, &cs);
        d256[idx] = f2bf((ri == 0 ? cs : -sn) * 0.0013810679320049757f); }
}
__device__ __forceinline__ void fft16_pass(LAS unsigned char* lds, const bf16_t* zf2, bf16_t* vt, int bx, int G) {
    const int tid = tid_l();
    LAS float* tw = (LAS float*)lds;
    for (int i = tid; i < 4096; i += NTHREADS) { float sn, cs; sincospif((float)i * (1.0f / 2048.0f), &sn, &cs); tw[2 * i] = cs; tw[2 * i + 1] = sn; }
    __syncthreads();
    const int n1 = tid & 255, sub = tid >> 8;
    u32x4 pw0, pw1, pw2, pw3;
    { const int task0 = bx * 2 + sub; if (task0 < 3072) { const bf16_t* src = zf2 + ((size_t)task0 * 256 + n1) * 32; pw0 = *(const u32x4*)src; pw1 = *(const u32x4*)(src + 8); pw2 = *(const u32x4*)(src + 16); pw3 = *(const u32x4*)(src + 24); } }
    for (int task = bx * 2 + sub; task < 3072; task += G * 2) {
        const u32x4 w0 = pw0, w1 = pw1, w2 = pw2, w3 = pw3;
        if (task + G * 2 < 3072) { const bf16_t* src = zf2 + ((size_t)(task + G * 2) * 256 + n1) * 32; pw0 = *(const u32x4*)src; pw1 = *(const u32x4*)(src + 8); pw2 = *(const u32x4*)(src + 16); pw3 = *(const u32x4*)(src + 24); }
        float zr[16], zi[16];
#pragma unroll
        for (int e = 0; e < 4; ++e) { zr[2 * e] = bf_lo(w0[e]); zr[2 * e + 1] = bf_hi(w0[e]); zr[8 + 2 * e] = bf_lo(w1[e]); zr[8 + 2 * e + 1] = bf_hi(w1[e]);
                                      zi[2 * e] = bf_lo(w2[e]); zi[2 * e + 1] = bf_hi(w2[e]); zi[8 + 2 * e] = bf_lo(w3[e]); zi[8 + 2 * e + 1] = bf_hi(w3[e]); }
        float Ar[4][4], Ai[4][4];
#pragma unroll
        for (int q = 0; q < 4; ++q) {
            const float s0r = zr[q] + zr[8 + q], s0i = zi[q] + zi[8 + q], s1r = zr[q] - zr[8 + q], s1i = zi[q] - zi[8 + q];
            const float s2r = zr[4 + q] + zr[12 + q], s2i = zi[4 + q] + zi[12 + q], s3r = zr[4 + q] - zr[12 + q], s3i = zi[4 + q] - zi[12 + q];
            Ar[q][0] = s0r + s2r; Ai[q][0] = s0i + s2i; Ar[q][2] = s0r - s2r; Ai[q][2] = s0i - s2i;
            Ar[q][1] = s1r - s3i; Ai[q][1] = s1i + s3r; Ar[q][3] = s1r + s3i; Ai[q][3] = s1i - s3r; }
        const float c1 = 0.9238795325f, s1 = 0.3826834324f, c2 = 0.7071067812f;
#define CMUL(xr, xi, cr, ci) { const float t_ = xr * (cr) - xi * (ci); xi = xr * (ci) + xi * (cr); xr = t_; }
        CMUL(Ar[1][1], Ai[1][1], c1, s1) CMUL(Ar[1][2], Ai[1][2], c2, c2) CMUL(Ar[1][3], Ai[1][3], s1, c1)
        CMUL(Ar[2][1], Ai[2][1], c2, c2) CMUL(Ar[2][2], Ai[2][2], 0.f, 1.f) CMUL(Ar[2][3], Ai[2][3], -c2, c2)
        CMUL(Ar[3][1], Ai[3][1], s1, c1) CMUL(Ar[3][2], Ai[3][2], -c2, c2) CMUL(Ar[3][3], Ai[3][3], -c1, -s1)
#undef CMUL
        float xr[16], xi[16];
#pragma unroll
        for (int r = 0; r < 4; ++r) {
            const float s0r = Ar[0][r] + Ar[2][r], s0i = Ai[0][r] + Ai[2][r], s1r = Ar[0][r] - Ar[2][r], s1i = Ai[0][r] - Ai[2][r];
            const float s2r = Ar[1][r] + Ar[3][r], s2i = Ai[1][r] + Ai[3][r], s3r = Ar[1][r] - Ar[3][r], s3i = Ai[1][r] - Ai[3][r];
            xr[r] = s0r + s2r; xi[r] = s0i + s2i; xr[r + 8] = s0r - s2r; xi[r + 8] = s0i - s2i;
            xr[r + 4] = s1r - s3i; xi[r + 4] = s1i + s3r; xr[r + 12] = s1r + s3i; xi[r + 12] = s1i - s3r; }
        const int b = task >> 9, gc = task & 511;
        bf16_t* dst = vt + ((size_t)(b * 16) * 512 + gc) * 512 + n1;
#pragma unroll
        for (int k2 = 0; k2 < 16; ++k2) { const int idx = (n1 * k2) & 4095; const float c = tw[2 * idx], sn = tw[2 * idx + 1];
            dst[(size_t)k2 * 512 * 512] = f2bf(xr[k2] * c - xi[k2] * sn); dst[(size_t)k2 * 512 * 512 + 256] = f2bf(xr[k2] * sn + xi[k2] * c); }
    }
    __syncthreads();
}

template <int MODE>
__device__ __forceinline__ void rms_rows(const float* xp, const float* xs, float* xres, const float* gain, bf16_t* outb, int bx, int G) {
    const int tid = tid_l(), lane = tid & 63, wave = tid >> 6;
    f32x4 gv[8];
#pragma unroll
    for (int it = 0; it < 8; ++it) gv[it] = *(const f32x4*)(gain + it * 256 + lane * 4);
    for (int row = (bx * 8 + wave) * 2; row < T; row += G * 16) {
        f32x4 v[2][8]; float ss[2] = {0.f, 0.f};
#pragma unroll
        for (int rr = 0; rr < 2; ++rr) { const int r_ = row + rr;
            const float* src = MODE == 0 ? (r_ < 16384 ? xp + (size_t)r_ * 2048 : xs + (size_t)(r_ - 16384) * 2048) : xres + (size_t)r_ * 2048;
#pragma unroll
            for (int it = 0; it < 8; ++it) v[rr][it] = *(const f32x4*)(src + it * 256 + lane * 4); }
#pragma unroll
        for (int rr = 0; rr < 2; ++rr) {
#pragma unroll
            for (int it = 0; it < 8; ++it) ss[rr] += v[rr][it][0] * v[rr][it][0] + v[rr][it][1] * v[rr][it][1] + v[rr][it][2] * v[rr][it][2] + v[rr][it][3] * v[rr][it][3];
            ss[rr] = wave_sum(ss[rr]); }
#pragma unroll
        for (int rr = 0; rr < 2; ++rr) { const float r = 1.0f / sqrtf(ss[rr] * (1.0f / 2048.0f) + EPS);
#pragma unroll
            for (int it = 0; it < 8; ++it) {
                const f32x4 o = v[rr][it] * r * gv[it];
                if (MODE == 2) *(f32x4*)(xres + (size_t)(row + rr) * 2048 + it * 256 + lane * 4) = o;
                else { u32x2 w; w.x = cvt_pk_bf16(o[0], o[1]); w.y = cvt_pk_bf16(o[2], o[3]); *(u32x2*)(outb + (size_t)(row + rr) * 2048 + it * 256 + lane * 4) = w; }
            } }
    }
}

__device__ __forceinline__ void outnorm_rows(bf16_t* y, const float* og, int bx, int G) {
    const int tid = tid_l(), lane = tid & 63, wave = tid >> 6;
    for (int row = (bx * 8 + wave) * 2; row < T; row += G * 16) {
        u32x4 w[2][4]; float ss[2][3];
#pragma unroll
        for (int rr = 0; rr < 2; ++rr)
#pragma unroll
            for (int it = 0; it < 4; ++it) w[rr][it] = *(const u32x4*)(y + (size_t)(row + rr) * 2048 + (it * 64 + lane) * 8);
#pragma unroll
        for (int rr = 0; rr < 2; ++rr) { ss[rr][0] = 0.f; ss[rr][1] = 0.f; ss[rr][2] = 0.f;
#pragma unroll
            for (int it = 0; it < 4; ++it) { const int ch = it * 64 + lane; float s = 0.f;
#pragma unroll
                for (int q = 0; q < 4; ++q) { const float a0 = bf_lo(w[rr][it][q]), a1 = bf_hi(w[rr][it][q]); s += a0 * a0 + a1 * a1; }
                const int seg = ch < 96 ? 0 : (ch < 160 ? 1 : 2);
                ss[rr][0] += seg == 0 ? s : 0.f; ss[rr][1] += seg == 1 ? s : 0.f; ss[rr][2] += seg == 2 ? s : 0.f; }
            ss[rr][0] = wave_sum(ss[rr][0]); ss[rr][1] = wave_sum(ss[rr][1]); ss[rr][2] = wave_sum(ss[rr][2]); }
#pragma unroll
        for (int rr = 0; rr < 2; ++rr) {
            const float r0 = 1.0f / sqrtf(ss[rr][0] * (1.0f / 768.0f) + EPS), r1 = 1.0f / sqrtf(ss[rr][1] * (1.0f / 512.0f) + EPS), r2 = 1.0f / sqrtf(ss[rr][2] * (1.0f / 768.0f) + EPS);
#pragma unroll
            for (int it = 0; it < 4; ++it) { const int ch = it * 64 + lane; const float r = ch < 96 ? r0 : (ch < 160 ? r1 : r2);
                const f32x4 g0 = *(const f32x4*)(og + ch * 8), g1 = *(const f32x4*)(og + ch * 8 + 4);
                const u32x4 ww = w[rr][it];
                u32x4 o; o.x = cvt_pk_bf16(bf_lo(ww.x) * r * g0[0], bf_hi(ww.x) * r * g0[1]); o.y = cvt_pk_bf16(bf_lo(ww.y) * r * g0[2], bf_hi(ww.y) * r * g0[3]);
                o.z = cvt_pk_bf16(bf_lo(ww.z) * r * g1[0], bf_hi(ww.z) * r * g1[1]); o.w = cvt_pk_bf16(bf_lo(ww.w) * r * g1[2], bf_hi(ww.w) * r * g1[3]);
                *(u32x4*)(y + (size_t)(row + rr) * 2048 + ch * 8) = o; } }
    }
}

__device__ __forceinline__ void gmlp_task(LAS unsigned char* lds, const bf16_t* zina, const bf16_t* wsb, const float* vg, const float* bs, bf16_t* y, int task) {
    const int tid = tid_l(), lane = tid & 63, wid = tid >> 6, fr = lane & 15, fq = lane >> 4;
    const int cidx = task / 6, h = task - cidx * 6, t0 = cidx * 128;
    LAS bf16_t* vT = (LAS bf16_t*)lds;
    { const int k = tid >> 2, dq = (tid & 3) * 32;
      const bf16_t* src = zina + (size_t)(t0 + k) * 1536 + 768 + h * 128 + dq;
      u32x4 w[4]; float ss = 0.f;
#pragma unroll
      for (int q = 0; q < 4; ++q) { w[q] = *(const u32x4*)(src + q * 8);
#pragma unroll
          for (int e = 0; e < 4; ++e) { const float a0 = bf_lo(w[q][e]), a1 = bf_hi(w[q][e]); ss += a0 * a0 + a1 * a1; } }
      ss += __shfl_xor(ss, 1); ss += __shfl_xor(ss, 2);
      const float r = 1.0f / sqrtf(ss * (1.0f / 128.0f) + EPS);
#pragma unroll
      for (int q = 0; q < 4; ++q)
#pragma unroll
          for (int e = 0; e < 4; ++e) { const int d = dq + q * 8 + e * 2;
              vT[d * 136 + k] = f2bf(bf_lo(w[q][e]) * r * vg[h * 128 + d]); vT[(d + 1) * 136 + k] = f2bf(bf_hi(w[q][e]) * r * vg[h * 128 + d + 1]); } }
    __syncthreads();
    const int q0 = (wid >> 1) * 32, d0 = (wid & 1) * 64;
    f32x4 acc[2][4];
#pragma unroll
    for (int mq = 0; mq < 2; ++mq)
#pragma unroll
        for (int nd = 0; nd < 4; ++nd) acc[mq][nd] = (f32x4){0.f, 0.f, 0.f, 0.f};
#pragma unroll
    for (int ks = 0; ks < 4; ++ks) {
        bf16x8 af[2], bfr[4];
#pragma unroll
        for (int mq = 0; mq < 2; ++mq) af[mq] = *(const bf16x8*)(wsb + (size_t)(h * 128 + q0 + mq * 16 + fr) * 128 + ks * 32 + fq * 8);
#pragma unroll
        for (int nd = 0; nd < 4; ++nd) bfr[nd] = *(const LAS bf16x8*)(vT + (d0 + nd * 16 + fr) * 136 + ks * 32 + fq * 8);
#pragma unroll
        for (int mq = 0; mq < 2; ++mq)
#pragma unroll
            for (int nd = 0; nd < 4; ++nd) acc[mq][nd] = __builtin_amdgcn_mfma_f32_16x16x32_bf16(bfr[nd], af[mq], acc[mq][nd], 0, 0, 0);
    }
    u32x2 uq[2][4];
#pragma unroll
    for (int mq = 0; mq < 2; ++mq)
#pragma unroll
        for (int nd = 0; nd < 4; ++nd) uq[mq][nd] = *(const u32x2*)(zina + (size_t)(t0 + q0 + mq * 16 + fr) * 1536 + h * 128 + d0 + nd * 16 + 4 * fq);
#pragma unroll
    for (int mq = 0; mq < 2; ++mq) { const int q = q0 + mq * 16 + fr; const float b = bs[h * 128 + q];
#pragma unroll
        for (int nd = 0; nd < 4; ++nd) { const int d = d0 + nd * 16 + 4 * fq;
            const u32x2 uu = uq[mq][nd];
            const f32x4 m = acc[mq][nd] + b;
            u32x2 o; o.x = cvt_pk_bf16(bf_lo(uu.x) * m[0], bf_hi(uu.x) * m[1]); o.y = cvt_pk_bf16(bf_lo(uu.y) * m[2], bf_hi(uu.y) * m[3]);
            *(u32x2*)(y + (size_t)(t0 + q) * 2048 + h * 128 + d) = o; } }
    __syncthreads();
}

__device__ __forceinline__ void carry_scan(const float* xs, const float* ALp, bf16_t* ucat, int bx) {
    const int idx = bx * NTHREADS + tid_l();
    if (idx >= 48 * 6 * 128) return;
    const int p = idx & 63, dir = (idx >> 6) & 1, b = (idx >> 7) % 6, g = idx / 768;
    const f32x2 aL = *(const f32x2*)(ALp + ((g * 2 + dir) * 64 + p) * 2);
    float hr = 0.f, hi = 0.f;
#pragma unroll 32
    for (int s = 0; s < 128; ++s) { const int c = dir == 0 ? s : 127 - s; const size_t chunk = (size_t)g * 768 + b * 128 + c;
        const f32x2 x = *(const f32x2*)(xs + chunk * 256 + dir * 128 + p * 2);
        *(unsigned*)(ucat + chunk * 768 + 512 + dir * 128 + p * 2) = cvt_pk_bf16(hr, hi);
        const float nr = aL.x * hr - aL.y * hi + x.x, ni = aL.x * hi + aL.y * hr + x.y; hr = nr; hi = ni; }
}

__device__ __forceinline__ void grid_bar(unsigned* cnt, unsigned target) {
    asm volatile("s_waitcnt vmcnt(0)" ::: "memory");
    __syncthreads();
    if (threadIdx.x == 0) {
        __builtin_amdgcn_fence(__ATOMIC_RELEASE, "agent");
        asm volatile("s_waitcnt vmcnt(0)" ::: "memory");
        (void)__hip_atomic_fetch_add(cnt, 1u, __ATOMIC_RELAXED, __HIP_MEMORY_SCOPE_AGENT);
        unsigned sp = 0;
        while (__hip_atomic_load(cnt, __ATOMIC_RELAXED, __HIP_MEMORY_SCOPE_AGENT) < target) { __builtin_amdgcn_s_sleep(1); if (++sp > (1u << 22)) break; }
        __builtin_amdgcn_fence(__ATOMIC_ACQUIRE, "agent");
        asm volatile("s_waitcnt vmcnt(0)" ::: "memory");
    }
    __syncthreads();
}

constexpr int N_PHASES = 23;
__global__ void __launch_bounds__(NTHREADS, 2) mega_fwd(Args a) {
    extern __shared__ __attribute__((aligned(16))) unsigned char lds_raw[];
    LAS unsigned char* lds = (LAS unsigned char*)lds_raw;
    cg::grid_group grid = cg::this_grid();
#define WINAC ((bf16_t*)(ws + WS_WINAC))
#define WINBF ((bf16_t*)(ws + WS_WINBF))
#define WOUT  ((bf16_t*)(ws + WS_WOUT))
#define WGLU  ((bf16_t*)(ws + WS_WGLU))
#define WSB   ((bf16_t*)(ws + WS_WS))
#define WGU   ((bf16_t*)(ws + WS_WGU))
#define WDOWN ((bf16_t*)(ws + WS_WDOWN))
#define VT    ((bf16_t*)(ws + WS_VT))
#define D256  ((bf16_t*)(ws + WS_D256))
#define AL    ((float*)(ws + WS_AL))
#define SLOT1 ((bf16_t*)(ws + WS_SLOT1))
#define ZINA  ((bf16_t*)(ws + WS_ZINA))
#define ZFT   ((bf16_t*)(ws + WS_ZFT))
#define YCPRE ((bf16_t*)(ws + WS_YCPRE))
#define UCAT  ((bf16_t*)(ws + WS_UCAT))
#define XS    ((float*)(ws + WS_XS))
#define TE    ((bf16_t*)(ws + WS_TE))
#define GM    ((bf16_t*)(ws + WS_GM))
#define HID   ((bf16_t*)(ws + WS_HID))
    int ph = 0; unsigned nbar = 0;
#define GRID_SYNC() do { if (nbar == 0u) { grid.sync(); } else { grid_bar((unsigned*)(a.ws + WS_CTL), nbar * gridDim.x); } ++nbar; } while (0)
#ifndef ONLY_PH
#define ONLY_PH -1
#endif
#ifndef PROBE_DUP
#define PROBE_DUP -1
#endif
#define PH_BEGIN(k) if ((ONLY_PH < 0 || ONLY_PH == (k)) && ph >= a.ph_lo && ph < a.ph_hi) { const int nrep_ = ((k) == PROBE_DUP) ? 2 : 1; for (int rep_ = 0; rep_ < nrep_; ++rep_) { unsigned char* ws = a.ws; float* X = a.out; int bx = blockIdx.x, G = gridDim.x; asm volatile("; PHASEMARK %4" : "+s"(ws), "+s"(X), "+s"(bx), "+s"(G) : "i"(k));
#define PH_END   if (rep_ + 1 < nrep_) GRID_SYNC(); } if (ph + 1 < a.ph_hi) GRID_SYNC(); } ++ph;

#define FFN_CONVERT(t0, t1) do { if (bx >= 32) { \
        const FfnCtx fc{a.in[20] + (size_t)l * 2048 * DFF, a.in[21] + (size_t)l * 2048 * DFF, a.in[22] + (size_t)l * DFF * 2048, WGU, WDOWN}; \
        transpose_run<SelFfn>(lds, fc, (t0) + bx - 32, (t1), G - 32); } } while (0)
#pragma unroll 1
    for (int l = 0; l < 2; ++l) {
        PH_BEGIN(0)
            for (int g = bx; g < NGRP; g += G) s5_group_a(lds, a, l, g);
            for (int t = G - 1 - bx; t < NGRP * 8; t += G) s5_ktab(lds, a, l, t);
            for (int t = (bx + G - 48) % G; t < 128; t += G) winbf_task(lds, a.in[3] + (size_t)l * 2048 * INW, WINBF, t);
            if (l == 0) d256_gen(D256, bx, G);
            {
                const float* s = a.in[5] + (size_t)l * 6 * 128 * 128;
                for (int i = bx * NTHREADS + tid_l(); i < 6 * 128 * 128 / 2; i += G * NTHREADS) ((unsigned*)WSB)[i] = cvt_pk_bf16(s[2 * i], s[2 * i + 1]);
            }
            {
                const TrDesc td[4] = {
                    {a.in[3] + (size_t)l * 2048 * INW, INW, 2048, 0, 1536, WINAC, 0, 0},
                    {a.in[3] + (size_t)l * 2048 * INW, INW, 2048, 2048, 768, WINAC, 0, 1536},
                    {a.in[18] + (size_t)l * 2048 * 2048, 2048, 2048, 0, 2048, WOUT, 0, 0},
                    {a.in[15] + (size_t)l * 768 * 768, 768, 768, 0, 768, WGLU, 0, 0}};
                const int ntile[4] = {32 * 6, 32 * 3, 32 * 8, 12 * 3};
#pragma unroll
                for (int m = 0; m < 4; ++m) transpose_run<SelOne>(lds, td[m], bx, ntile[m], G);
            }
            if (l == 0) rms_rows<0>(a.in[0], a.in[1], X, a.in[2], SLOT1, bx, G);
            else        rms_rows<1>(nullptr, nullptr, X, a.in[2] + l * 2048, SLOT1, bx, G);
        PH_END
        PH_BEGIN(1)
            { pg8::Sched S{(const char*)SLOT1, (const char*)WINAC, 0, 0, 2048, 2048, T / 256, 9, 1, G, bx, 0, 8}; EpiWin E{ZINA, UCAT}; pg8::gemm_phase(lds, S, 2048, E); }
            { pg8::Sched S{(const char*)WINBF, (const char*)SLOT1, 0, 0, 2048, 2048, 4, T / 256, 1, G, G - 1 - bx, 1, 8}; EpiZft2 E{ZFT}; pg8::gemm_phase(lds, S, 2048, E); }
        PH_END
        PH_BEGIN(2)
            fft16_pass(lds, ZFT, VT, bx, G);
            { pg8::Sched S{(const char*)UCAT, (const char*)GM, (long)768 * 768 * 2, (long)256 * 512 * 2, 768, 512, 3, 1, NGRP, G, bx, 0, 8}; EpiXs E{XS}; pg8::gemm_phase(lds, S, 512, E); }
            for (int t = G - 1 - bx; t < 192 * 6; t += G) gmlp_task(lds, ZINA, WSB, a.in[4] + l * 768, a.in[6] + l * 768, SLOT1, t);
            for (int t = bx; t < NGRP * 4; t += G) s5_te(a, l, t);
        PH_END
        PH_BEGIN(3)
            if (bx < 72) carry_scan(XS, AL, UCAT, bx);
            if (bx >= 64) { pg8::Sched S{(const char*)D256, (const char*)VT, 0, 0, 512, 512, 1, 192, 1, G - 64, bx - 64, 0, 8}; EpiFour2 E{SLOT1}; pg8::gemm_phase(lds, S, 512, E); }
        PH_END
        PH_BEGIN(4)
            { pg8::Sched S{(const char*)UCAT, (const char*)TE, (long)768 * 768 * 2, (long)512 * 768 * 2, 768, 768, 3, 2, NGRP, G, bx, 0, 8}; EpiYc E{YCPRE}; pg8::gemm_phase(lds, S, 768, E); }
            FFN_CONVERT(0, 1056);
        PH_END
        PH_BEGIN(5)
            { pg8::Sched S{(const char*)YCPRE, (const char*)WGLU, 0, 0, 768, 768, T / 256, 3, 1, G, bx, 0, 8}; EpiGlu E{YCPRE, a.in[16] + l * 768, SLOT1}; pg8::gemm_phase(lds, S, 768, E); }
            FFN_CONVERT(1056, 2112);
        PH_END
        PH_BEGIN(6)
            outnorm_rows(SLOT1, a.in[17] + l * 2048, bx, G);
        PH_END
        PH_BEGIN(7)
            { pg8::Sched S{(const char*)SLOT1, (const char*)WOUT, 0, 0, 2048, 2048, T / 256, 8, 1, G, bx, 0, 4}; EpiRes E{X, l == 0 ? a.in[0] : X, (l == 0 ? a.in[1] : X + (size_t)16384 * 2048) - (size_t)16384 * 2048}; pg8::gemm_phase(lds, S, 2048, E); }
        PH_END
        PH_BEGIN(8)
            rms_rows<1>(nullptr, nullptr, X, a.in[19] + l * 2048, SLOT1, bx, G);
        PH_END
        PH_BEGIN(9)
            { pg8::Sched S{(const char*)SLOT1, (const char*)WGU, 0, 0, 2048, 2048, T / 256, 44, 1, G, bx, 0, 4}; EpiSwi E{HID}; pg8::gemm_phase(lds, S, 2048, E); }
        PH_END
        PH_BEGIN(10)
            { pg8::Sched S{(const char*)HID, (const char*)WDOWN, 0, 0, DFF, DFF, T / 256, 8, 1, G, bx, 0, 4}; EpiRes E{X, X, X}; pg8::gemm_phase(lds, S, DFF, E); }
        PH_END
    }
    PH_BEGIN(11)
        rms_rows<2>(nullptr, nullptr, X, a.in[23], nullptr, bx, G);
    PH_END
#undef PH_BEGIN
#undef PH_END
}

extern "C" void kernel_launch(void* const* d_in, const int* in_sizes, int n_in, void* d_out, int out_size, void* d_ws, size_t ws_size, hipStream_t stream) {
    static int grid = 0;
    if (grid == 0) {
        if (n_in != 24 || out_size != T * DM || ws_size < WS_END) { fprintf(stderr, "kernel_launch: unexpected shapes / workspace (n_in %d out %d ws %zu need %zu)\n", n_in, out_size, ws_size, (size_t)WS_END); grid = -1; return; }
        int dev = 0, cus = 0, per_cu = 0;
        if (hipGetDevice(&dev) != hipSuccess || hipDeviceGetAttribute(&cus, hipDeviceAttributeMultiprocessorCount, dev) != hipSuccess) { grid = -1; return; }
        if (hipFuncSetAttribute((const void*)mega_fwd, hipFuncAttributeMaxDynamicSharedMemorySize, LDS_BYTES) != hipSuccess) { fprintf(stderr, "kernel_launch: hipFuncSetAttribute failed\n"); grid = -1; return; }
        if (hipOccupancyMaxActiveBlocksPerMultiprocessor(&per_cu, (const void*)mega_fwd, NTHREADS, LDS_BYTES) != hipSuccess || per_cu < 1) { fprintf(stderr, "kernel_launch: occupancy query says %d\n", per_cu); per_cu = 1; }
        (void)hipGetLastError();
        grid = cus * 1;
    }
    if (grid < 0) return;
    if (hipMemsetAsync((char*)d_ws + WS_CTL, 0, 256, stream) != hipSuccess) { fprintf(stderr, "kernel_launch: memset of the barrier word failed\n"); return; }
    Args a{};
    for (int i = 0; i < 24; ++i) a.in[i] = (const float*)d_in[i];
    a.out = (float*)d_out; a.ws = (unsigned char*)d_ws;
#if MK_ONE_LAUNCH
    a.ph_lo = 0; a.ph_hi = N_PHASES;
    void* args[] = {&a};
    hipError_t e = hipLaunchCooperativeKernel((const void*)mega_fwd, dim3(grid), dim3(NTHREADS), args, LDS_BYTES, stream);
    if (e != hipSuccess) fprintf(stderr, "cooperative launch failed: %s (grid %d)\n", hipGetErrorString(e), grid);
#else
    for (int p = 0; p < N_PHASES; ++p) {
        a.ph_lo = p; a.ph_hi = p + 1;
        hipLaunchKernelGGL(mega_fwd, dim3(grid), dim3(NTHREADS), LDS_BYTES, stream, a);
    }
#endif
}
```

```cpp
#include <hip/hip_runtime.h>
#include <hip/hip_cooperative_groups.h>
#include <cstdio>
#include <cstdint>
namespace cg = cooperative_groups;

#ifndef MK_ONE_LAUNCH
#define MK_ONE_LAUNCH 1
#endif

#define LAS __attribute__((address_space(3)))
typedef unsigned short bf16_t;
typedef short bf16x8 __attribute__((ext_vector_type(8)));
typedef float f32x4 __attribute__((ext_vector_type(4)));
typedef float f32x2 __attribute__((ext_vector_type(2)));
typedef unsigned u32x4 __attribute__((ext_vector_type(4)));
typedef unsigned u32x2 __attribute__((ext_vector_type(2)));

constexpr int T = 24576, DM = 2048, NBATCH = 6, SEQ = 4096, DFF = 5632, INW = 2816;
constexpr int NGRP = 48, NCHUNK = T / 32;
constexpr float EPS = 1e-6f;
constexpr int NTHREADS = 512;
constexpr int LDS_BYTES = 131072 + 1024;

constexpr size_t WS_WINAC = 0;
constexpr size_t WS_WINBF = WS_WINAC + (size_t)2304 * 2048 * 2;
constexpr size_t WS_WOUT  = WS_WINBF + (size_t)1024 * 2048 * 2;
constexpr size_t WS_WGLU  = WS_WOUT + (size_t)2048 * 2048 * 2;
constexpr size_t WS_WS    = WS_WGLU + (size_t)768 * 768 * 2;
constexpr size_t WS_WGU   = WS_WS + (size_t)6 * 128 * 128 * 2;
constexpr size_t WS_WDOWN = WS_WGU + (size_t)11264 * 2048 * 2;
constexpr size_t WS_DFT   = WS_WDOWN + (size_t)2048 * 5632 * 2;
constexpr size_t WS_VT    = WS_DFT;
constexpr size_t WS_D256  = WS_DFT + (size_t)49152 * 512 * 2;
constexpr size_t WS_AL    = WS_DFT + (size_t)4096 * 8192 * 2;
constexpr size_t WS_APW   = WS_AL + (size_t)48 * 2 * 64 * 2 * 4;
constexpr size_t WS_KT    = WS_APW + (size_t)48 * 2 * 33 * 64 * 2 * 4;
constexpr size_t WS_SLOT1 = WS_KT + (size_t)48 * 2 * 32 * 256 * 4;
constexpr size_t WS_ACT   = WS_SLOT1 + (size_t)T * 2048 * 2;
constexpr size_t WS_ZINA  = WS_ACT;
constexpr size_t WS_ZFT   = WS_ZINA + (size_t)T * 1536 * 2;
constexpr size_t WS_YCPRE = WS_ZFT;
constexpr size_t WS_UCAT  = WS_ZFT + (size_t)512 * 49152 * 2;
constexpr size_t WS_XS    = WS_UCAT + (size_t)48 * 768 * 768 * 2;
constexpr size_t WS_TE    = WS_XS + (size_t)48 * 768 * 256 * 4;
constexpr size_t WS_GM    = WS_TE + (size_t)48 * 512 * 768 * 2;
constexpr size_t WS_MIXEND = WS_GM + (size_t)48 * 256 * 512 * 2;
constexpr size_t WS_HID   = WS_ACT;
constexpr size_t WS_CTL   = WS_ACT + (size_t)T * 5632 * 2;
constexpr size_t WS_END   = WS_CTL + 16384;
static_assert(WS_MIXEND <= WS_CTL, "mixer buffers must fit under the FFN hidden buffer");

struct Args { const float* in[24]; float* out; unsigned char* ws; int ph_lo, ph_hi; };

__device__ __forceinline__ int tid_l() { int t = threadIdx.x; asm volatile("" : "+v"(t)); return t; }
__device__ __forceinline__ unsigned cvt_pk_bf16(float lo, float hi) { unsigned r; asm("v_cvt_pk_bf16_f32 %0, %1, %2" : "=v"(r) : "v"(lo), "v"(hi)); return r; }
__device__ __forceinline__ float bf_lo(unsigned w) { return __uint_as_float(w << 16); }
__device__ __forceinline__ float bf_hi(unsigned w) { return __uint_as_float(w & 0xffff0000u); }
__device__ __forceinline__ bf16_t f2bf(float f) { return (bf16_t)(cvt_pk_bf16(f, 0.f) & 0xffffu); }
__device__ __forceinline__ float sigmoid_f(float v) { return __builtin_amdgcn_rcpf(1.0f + __builtin_amdgcn_exp2f(-1.4426950409f * v)); }
__device__ __forceinline__ float gelu_tanh(float x) { const float z = x * (1.5957691216f + 0.0713548163f * x * x); return x * sigmoid_f(z); }
__device__ __forceinline__ float wave_sum(float v) {
#pragma unroll
    for (int o = 32; o >= 1; o >>= 1) v += __shfl_xor(v, o);
    return v;
}

namespace pg8 {
constexpr int BM = 256, BK = 64, HALF = 128, HTB = HALF * BK * 2, STAGE_BYTES = 8 * HTB, NXCD = 8, WGM = 8;
__device__ __forceinline__ int lds_byte(int r, int c) { const int st = (r >> 4) * 2 + (c >> 5), rr = r & 15, cc = c & 31, ob = rr * 64 + cc * 2; return st * 1024 + (ob ^ (((ob >> 9) & 1) << 5)); }
__device__ __forceinline__ void stage_rc(int b, int& R, int& C) { const int st = b / 1024, sb = b % 1024, swz = sb ^ (((sb >> 9) & 1) << 5); R = (st >> 1) * 16 + swz / 64; C = (st & 1) * 32 + (swz % 64) / 2; }
__device__ __forceinline__ int perm32(int rho) { const int n = rho >> 4, i = rho & 15; return 8 * (i >> 2) + 4 * n + (i & 3); }

struct Unit { const char* A; const char* B; int pm, pn, grp; };
struct Sched {
    const char* A; const char* B; long gsA, gsB; int lda, ldb, nM, nN, nG, G, c, bmap, wgm;
    __device__ __forceinline__ bool next(int i, Unit& u) const {
        const int nwg = nM * nN;
        const long L = (long)i * G + c; if (c < 0 || L >= (long)nwg * nG) return false;
        const int grp = (int)(L / nwg); int wgid = (int)(L - (long)grp * nwg);
        { const int q = nwg / NXCD, r = nwg % NXCD, xcd = wgid % NXCD, off = wgid / NXCD; wgid = (xcd < r ? xcd * (q + 1) : r * (q + 1) + (xcd - r) * q) + off; }
        const int nig = wgm * nN, gid = wgid / nig, fm = gid * wgm, gsz = (nM - fm) < wgm ? (nM - fm) : wgm;
        u.pm = fm + ((wgid % nig) % gsz); u.pn = (wgid % nig) / gsz; u.grp = grp;
        u.A = A + (size_t)grp * gsA + (size_t)u.pm * 512 * lda; u.B = B + (size_t)grp * gsB + (bmap ? (size_t)((u.pn >> 4) * 4096 + (u.pn & 15) * 16) * 2 * ldb : (size_t)u.pn * 512 * ldb);
        return true;
    }
};

template <class Epi>
__device__ __forceinline__ void gemm_phase(LAS unsigned char* lds, const Sched& S, const int K, const Epi& E) {
    int tid = threadIdx.x; asm volatile("" : "+v"(tid));
    const int wid = __builtin_amdgcn_readfirstlane(tid >> 6), lane = tid & 63, wr = wid >> 2, wc = wid & 3, fr = lane & 15, fq = lane >> 4;
    const int nt = K / BK;
    unsigned voffA[2], voffB[2];
#pragma unroll
    for (int i = 0; i < 2; ++i) { int R, C; stage_rc(tid * 16 + i * 8192, R, C); const int Rb = Epi::PERM ? ((R & ~31) + perm32(R & 31)) : R;
        const int RbT = Epi::BMAP ? ((Rb >> 4) + 256 * (Rb & 15)) : Rb;
        voffA[i] = (unsigned)(R * S.lda + C) * 2u; voffB[i] = (unsigned)(RbT * S.ldb + C) * 2u; }
    const size_t kstep = (size_t)(BK * 2);
    const size_t hstepA = (size_t)HALF * S.lda * 2, hstepB = (size_t)(Epi::BMAP ? 8 : HALF) * S.ldb * 2;
    const unsigned ldsw = (unsigned)wid * 1024u;
    const int aoff = lds_byte(wr * 64 + fr, fq * 8), boff = lds_byte(wc * 32 + fr, fq * 8);
#define PG8_SA(b, h) (((b) * 2 + (h)) * HTB)
#define PG8_SB(b, h) ((4 + (b) * 2 + (h)) * HTB)
#define PG8_STAGE(bufoff, gbase, voff) do { _Pragma("unroll") for (int _i = 0; _i < 2; ++_i) \
        __builtin_amdgcn_global_load_lds((const unsigned*)((const char*)(gbase) + (voff)[_i]), (LAS unsigned*)(lds + (bufoff) + ldsw + _i * 8192), 16, 0, 0); } while (0)
#define PG8_LDA(dst, b, h) do { _Pragma("unroll") for (int m = 0; m < 4; ++m) _Pragma("unroll") for (int k = 0; k < 2; ++k) dst[m][k] = *(const LAS bf16x8*)(lds + PG8_SA(b, h) + aoff + m * 2048 + k * 1024); } while (0)
#define PG8_LDB(dst, b, h) do { _Pragma("unroll") for (int n = 0; n < 2; ++n) _Pragma("unroll") for (int k = 0; k < 2; ++k) dst[n][k] = *(const LAS bf16x8*)(lds + PG8_SB(b, h) + boff + n * 2048 + k * 1024); } while (0)
#define PG8_MMA(ai, bj, At, Bt) do { __builtin_amdgcn_s_setprio(1); _Pragma("unroll") for (int m = 0; m < 4; ++m) _Pragma("unroll") for (int n = 0; n < 2; ++n) _Pragma("unroll") for (int k = 0; k < 2; ++k) \
        acc[ai][bj][m][n] = __builtin_amdgcn_mfma_f32_16x16x32_bf16(Bt[n][k], At[m][k], acc[ai][bj][m][n], 0, 0, 0); __builtin_amdgcn_s_setprio(0); } while (0)
#define PG8_WAIT_V(n) asm volatile("s_waitcnt vmcnt(" #n ")" ::: "memory")
#define PG8_WAIT_L(n) asm volatile("s_waitcnt lgkmcnt(" #n ")" ::: "memory")
#define PG8_BAR __builtin_amdgcn_s_barrier()
#define PG8_SCHED __builtin_amdgcn_sched_barrier(0)
    Unit cur, nxt; int ui = 0;
    if (!S.next(0, cur)) return;
    f32x4 acc[2][2][4][2];
#pragma unroll
    for (int a = 0; a < 2; ++a)
#pragma unroll
        for (int b = 0; b < 2; ++b)
#pragma unroll
            for (int m = 0; m < 4; ++m)
#pragma unroll
                for (int n = 0; n < 2; ++n) acc[a][b][m][n] = (f32x4){0.f, 0.f, 0.f, 0.f};
    bf16x8 At[4][2], B0[2][2], B1[2][2];
    const char* cA = cur.A; const char* cB = cur.B;
    PG8_STAGE(PG8_SB(0, 0), cB, voffB); PG8_STAGE(PG8_SB(0, 1), cB + hstepB, voffB); PG8_STAGE(PG8_SA(0, 0), cA, voffA); PG8_STAGE(PG8_SA(0, 1), cA + hstepA, voffA);
    if (wr == 1) PG8_BAR;
    PG8_WAIT_V(2); PG8_BAR;
    PG8_STAGE(PG8_SB(1, 0), cB + kstep, voffB); PG8_STAGE(PG8_SA(1, 0), cA + kstep, voffA); PG8_STAGE(PG8_SB(1, 1), cB + hstepB + kstep, voffB);
    PG8_WAIT_V(6); PG8_BAR;
    for (;;) {
        const bool has_next = S.next(ui + 1, nxt);
        const char* nA = has_next ? nxt.A : cA; const char* nB = has_next ? nxt.B : cB;
        for (int t = 0; t < nt; t += 2) {
            const bool last = (t == nt - 2);
            const char* a1 = cA + (size_t)(t + 1) * kstep;
            const char* a2 = last ? nA : cA + (size_t)(t + 2) * kstep; const char* b2 = last ? nB : cB + (size_t)(t + 2) * kstep;
            const char* a3 = a2 + kstep; const char* b3 = b2 + kstep;
            PG8_LDB(B0, 0, 0); PG8_LDB(B1, 0, 1); PG8_SCHED; PG8_LDA(At, 0, 0); PG8_STAGE(PG8_SA(1, 1), a1 + hstepA, voffA);
            PG8_WAIT_V(8); PG8_WAIT_L(0); PG8_BAR; PG8_MMA(0, 0, At, B0); PG8_MMA(0, 1, At, B1); PG8_BAR; PG8_SCHED;
            PG8_LDA(At, 0, 1); PG8_STAGE(PG8_SB(0, 0), b2, voffB); PG8_STAGE(PG8_SB(0, 1), b2 + hstepB, voffB); PG8_STAGE(PG8_SA(0, 0), a2, voffA);
            PG8_WAIT_V(8); PG8_WAIT_L(0); PG8_BAR; PG8_MMA(1, 0, At, B0); PG8_MMA(1, 1, At, B1); PG8_BAR; PG8_SCHED;
            PG8_LDB(B0, 1, 0); PG8_LDB(B1, 1, 1); PG8_SCHED; PG8_LDA(At, 1, 0); PG8_STAGE(PG8_SA(0, 1), a2 + hstepA, voffA);
            PG8_WAIT_V(8); PG8_WAIT_L(0); PG8_BAR; PG8_MMA(0, 0, At, B0); PG8_MMA(0, 1, At, B1); PG8_BAR; PG8_SCHED;
            PG8_LDA(At, 1, 1); PG8_STAGE(PG8_SB(1, 0), b3, voffB); PG8_STAGE(PG8_SB(1, 1), b3 + hstepB, voffB); PG8_STAGE(PG8_SA(1, 0), a3, voffA);
            PG8_WAIT_V(8); PG8_WAIT_L(0); PG8_BAR; PG8_MMA(1, 0, At, B0); PG8_MMA(1, 1, At, B1); PG8_BAR; PG8_SCHED;
        }
        if (wr == 0) PG8_BAR;
        E(acc, cur, wr, wc, fr, fq);
        if (!has_next) break;
#pragma unroll
        for (int a = 0; a < 2; ++a)
#pragma unroll
            for (int b = 0; b < 2; ++b)
#pragma unroll
                for (int m = 0; m < 4; ++m)
#pragma unroll
                    for (int n = 0; n < 2; ++n) acc[a][b][m][n] = (f32x4){0.f, 0.f, 0.f, 0.f};
        cur = nxt; cA = nA; cB = nB; ++ui;
        if (wr == 1) PG8_BAR;
    }
    PG8_WAIT_V(0);
    PG8_BAR;
#undef PG8_SA
#undef PG8_SB
#undef PG8_STAGE
#undef PG8_LDA
#undef PG8_LDB
#undef PG8_MMA
#undef PG8_WAIT_V
#undef PG8_WAIT_L
#undef PG8_BAR
#undef PG8_SCHED
}
}
using pg8::Unit;
typedef const f32x4 (&AccRef)[2][2][4][2];

__device__ __forceinline__ u32x4 pack8(f32x4 v0, f32x4 v1) { u32x4 w; w.x = cvt_pk_bf16(v0[0], v0[1]); w.y = cvt_pk_bf16(v0[2], v0[3]); w.z = cvt_pk_bf16(v1[0], v1[1]); w.w = cvt_pk_bf16(v1[2], v1[3]); return w; }
__device__ __forceinline__ f32x4 gelu4(f32x4 v) { return (f32x4){gelu_tanh(v[0]), gelu_tanh(v[1]), gelu_tanh(v[2]), gelu_tanh(v[3])}; }

struct EpiWin { static constexpr bool PERM = true; static constexpr int BMAP = 0; bf16_t* zina; bf16_t* ucat;
    __device__ __forceinline__ void operator()(AccRef acc, const Unit& u, int wr, int wc, int fr, int fq) const {
        const int row0 = u.pm * 256 + wr * 64 + fr;
        if (u.pn < 6) {
            const int col0 = u.pn * 256 + wc * 32 + 8 * fq;
#pragma unroll
            for (int ai = 0; ai < 2; ++ai)
#pragma unroll
                for (int m = 0; m < 4; ++m) { bf16_t* rowp = zina + (size_t)(row0 + ai * 128 + m * 16) * 1536 + col0;
#pragma unroll
                    for (int bj = 0; bj < 2; ++bj) *(u32x4*)(rowp + bj * 128) = pack8(gelu4(acc[ai][bj][m][0]), gelu4(acc[ai][bj][m][1])); }
        } else {
            const int cc0 = (u.pn - 6) * 256 + wc * 32 + 8 * fq;
#pragma unroll
            for (int ai = 0; ai < 2; ++ai)
#pragma unroll
                for (int m = 0; m < 4; ++m) { const int t = row0 + ai * 128 + m * 16, n = t >> 5, j = t & 31;
#pragma unroll
                    for (int bj = 0; bj < 2; ++bj) { const int cc = cc0 + bj * 128, g = cc >> 4, c0 = cc & 15;
                        *(u32x4*)(ucat + ((size_t)(g * 768 + n) * 768 + j * 16 + c0)) = pack8(acc[ai][bj][m][0], acc[ai][bj][m][1]); } }
        }
    } };
struct EpiZft2 { static constexpr bool PERM = true; static constexpr int BMAP = 1; bf16_t* zf2;
    __device__ __forceinline__ void operator()(AccRef acc, const Unit& u, int wr, int wc, int fr, int fq) const {
        const int row0 = u.pm * 256 + wr * 64 + fr, b = u.pn >> 4, n1b = (u.pn & 15) * 16 + 2 * wc + (fq >> 1), n20 = (fq & 1) * 8;
#pragma unroll
        for (int ai = 0; ai < 2; ++ai)
#pragma unroll
            for (int m = 0; m < 4; ++m) { const int r = row0 + ai * 128 + m * 16, ri = r >> 9, gc = r & 511;
#pragma unroll
                for (int bj = 0; bj < 2; ++bj) { const int n1 = n1b + 8 * bj;
                    *(u32x4*)(zf2 + ((((size_t)b * 512 + gc) * 256 + n1) * 32 + ri * 16 + n20)) = pack8(acc[ai][bj][m][0], acc[ai][bj][m][1]); } }
    } };
struct EpiFour2 { static constexpr bool PERM = true; static constexpr int BMAP = 0; bf16_t* y;
    __device__ __forceinline__ void operator()(AccRef acc, const Unit& u, int wr, int wc, int fr, int fq) const {
        const int bk = u.pn >> 1, b = bk >> 4, k2 = bk & 15, col0 = 768 + (u.pn & 1) * 256 + wc * 32 + 8 * fq, k10 = wr * 64 + fr;
#pragma unroll
        for (int ai = 0; ai < 2; ++ai)
#pragma unroll
            for (int m = 0; m < 4; ++m) { const int k1 = k10 + ai * 128 + m * 16; bf16_t* rowp = y + (size_t)(b * 4096 + 16 * k1 + k2) * 2048 + col0;
#pragma unroll
                for (int bj = 0; bj < 2; ++bj) *(u32x4*)(rowp + bj * 128) = pack8(acc[ai][bj][m][0], acc[ai][bj][m][1]); }
    } };
struct EpiXs { static constexpr bool PERM = false; static constexpr int BMAP = 0; float* xs;
    __device__ __forceinline__ void operator()(AccRef acc, const Unit& u, int wr, int wc, int fr, int fq) const {
        const int row0 = u.pm * 256 + wr * 64 + fr, col0 = wc * 32 + 4 * fq;
#pragma unroll
        for (int ai = 0; ai < 2; ++ai)
#pragma unroll
            for (int m = 0; m < 4; ++m) { float* rowp = xs + ((size_t)u.grp * 768 + row0 + ai * 128 + m * 16) * 256 + col0;
#pragma unroll
                for (int bj = 0; bj < 2; ++bj)
#pragma unroll
                    for (int n = 0; n < 2; ++n) *(f32x4*)(rowp + bj * 128 + n * 16) = acc[ai][bj][m][n]; }
    } };
struct EpiYc { static constexpr bool PERM = true; static constexpr int BMAP = 0; bf16_t* ycpre;
    __device__ __forceinline__ void operator()(AccRef acc, const Unit& u, int wr, int wc, int fr, int fq) const {
        const int row0 = u.pm * 256 + wr * 64 + fr, col0 = u.pn * 256 + wc * 32 + 8 * fq;
#pragma unroll
        for (int ai = 0; ai < 2; ++ai)
#pragma unroll
            for (int m = 0; m < 4; ++m) { const int n = row0 + ai * 128 + m * 16;
#pragma unroll
                for (int bj = 0; bj < 2; ++bj) { const int col = col0 + bj * 128, i = col >> 4, c0 = col & 15;
                    *(u32x4*)(ycpre + ((size_t)(n * 32 + i) * 768 + u.grp * 16 + c0)) = pack8(gelu4(acc[ai][bj][m][0]), gelu4(acc[ai][bj][m][1])); } }
    } };
struct EpiGlu { static constexpr bool PERM = true; static constexpr int BMAP = 0; const bf16_t* ycpre; const float* bias; bf16_t* y;
    __device__ __forceinline__ void operator()(AccRef acc, const Unit& u, int wr, int wc, int fr, int fq) const {
        const int row0 = u.pm * 256 + wr * 64 + fr, col0 = u.pn * 256 + wc * 32 + 8 * fq;
        f32x4 bv[2][2];
#pragma unroll
        for (int bj = 0; bj < 2; ++bj)
#pragma unroll
            for (int n = 0; n < 2; ++n) bv[bj][n] = *(const f32x4*)(bias + col0 + bj * 128 + 4 * n);
#pragma unroll
        for (int ai = 0; ai < 2; ++ai) {
            u32x4 yc[4][2];
#pragma unroll
            for (int m = 0; m < 4; ++m)
#pragma unroll
                for (int bj = 0; bj < 2; ++bj) yc[m][bj] = *(const u32x4*)(ycpre + (size_t)(row0 + ai * 128 + m * 16) * 768 + col0 + bj * 128);
#pragma unroll
            for (int m = 0; m < 4; ++m) { const size_t t = (size_t)(row0 + ai * 128 + m * 16);
#pragma unroll
                for (int bj = 0; bj < 2; ++bj) { const int col = col0 + bj * 128; const u32x4 w = yc[m][bj];
                    const f32x4 v0 = acc[ai][bj][m][0] + bv[bj][0], v1 = acc[ai][bj][m][1] + bv[bj][1];
                    const f32x4 o0 = (f32x4){bf_lo(w.x) * sigmoid_f(v0[0]), bf_hi(w.x) * sigmoid_f(v0[1]), bf_lo(w.y) * sigmoid_f(v0[2]), bf_hi(w.y) * sigmoid_f(v0[3])};
                    const f32x4 o1 = (f32x4){bf_lo(w.z) * sigmoid_f(v1[0]), bf_hi(w.z) * sigmoid_f(v1[1]), bf_lo(w.w) * sigmoid_f(v1[2]), bf_hi(w.w) * sigmoid_f(v1[3])};
                    *(u32x4*)(y + t * 2048 + 1280 + col) = pack8(o0, o1); } }
            asm volatile("" ::: "memory"); }
    } };
struct EpiRes { static constexpr bool PERM = false; static constexpr int BMAP = 0; float* x; const float* r0; const float* r1adj;
    __device__ __forceinline__ void operator()(AccRef acc, const Unit& u, int wr, int wc, int fr, int fq) const {
        const int row0 = u.pm * 256 + wr * 64 + fr, col0 = u.pn * 256 + wc * 32 + 4 * fq;
        const float* sb = u.pm < 64 ? r0 : r1adj;
#pragma unroll
        for (int ai = 0; ai < 2; ++ai) {
            const size_t off = (size_t)(row0 + ai * 128) * 2048 + col0;
            f32x4 ld[4][2][2];
#pragma unroll
            for (int m = 0; m < 4; ++m)
#pragma unroll
                for (int bj = 0; bj < 2; ++bj)
#pragma unroll
                    for (int n = 0; n < 2; ++n) ld[m][bj][n] = *(const f32x4*)(sb + off + (size_t)m * 16 * 2048 + bj * 128 + n * 16);
#pragma unroll
            for (int m = 0; m < 4; ++m)
#pragma unroll
                for (int bj = 0; bj < 2; ++bj)
#pragma unroll
                    for (int n = 0; n < 2; ++n) *(f32x4*)(x + off + (size_t)m * 16 * 2048 + bj * 128 + n * 16) = ld[m][bj][n] + acc[ai][bj][m][n];
            asm volatile("" ::: "memory"); }
    } };
struct EpiSwi { static constexpr bool PERM = true; static constexpr int BMAP = 0; bf16_t* hid;
    __device__ __forceinline__ void operator()(AccRef acc, const Unit& u, int wr, int wc, int fr, int fq) const {
        const int row0 = u.pm * 256 + wr * 64 + fr, col0 = u.pn * 128 + wc * 32 + 8 * fq;
#pragma unroll
        for (int ai = 0; ai < 2; ++ai)
#pragma unroll
            for (int m = 0; m < 4; ++m) {
                f32x4 o[2];
#pragma unroll
                for (int n = 0; n < 2; ++n) { const f32x4 g = acc[ai][0][m][n], up = acc[ai][1][m][n];
                    o[n] = (f32x4){g[0] * sigmoid_f(g[0]) * up[0], g[1] * sigmoid_f(g[1]) * up[1], g[2] * sigmoid_f(g[2]) * up[2], g[3] * sigmoid_f(g[3]) * up[3]}; }
                *(u32x4*)(hid + (size_t)(row0 + ai * 128 + m * 16) * 5632 + col0) = pack8(o[0], o[1]); }
    } };

struct TrDesc { const float* src; int ldsrc, K, c0, nc; bf16_t* dst; int mode, doff; };
template <class SEL, class CTX>
__device__ __forceinline__ void transpose_run(LAS unsigned char* lds, const CTX& ctx, int t0, int t1, int stride) {
    const int tid = tid_l();
    LAS unsigned* tl = (LAS unsigned*)lds;
    const int k = tid >> 3, n8 = (tid & 7) * 8;
    f32x4 v[4][2];
    TrDesc d; int lt;
    if (t0 < t1) { SEL::get(ctx, t0, d, lt); const int nkt = d.K >> 6, kt = lt % nkt, ct = lt / nkt;
        const float* s = d.src + (size_t)(kt * 64 + k) * d.ldsrc + d.c0 + ct * 256 + n8;
#pragma unroll
        for (int q = 0; q < 4; ++q) { v[q][0] = *(const f32x4*)(s + q * 64); v[q][1] = *(const f32x4*)(s + q * 64 + 4); } }
    for (int t = t0; t < t1; t += stride) {
        SEL::get(ctx, t, d, lt);
        const int nkt = d.K >> 6, kt = lt % nkt, ct = lt / nkt;
        unsigned w[4][4];
#pragma unroll
        for (int q = 0; q < 4; ++q)
#pragma unroll
            for (int j = 0; j < 4; ++j) { const float lo = v[q][0][j], hi = v[q][1][j];
                const float recv = __shfl_xor((k & 1) ? lo : hi, 8);
                w[q][j] = (k & 1) ? cvt_pk_bf16(recv, hi) : cvt_pk_bf16(lo, recv); }
        if (t + stride < t1) { TrDesc dn; int ltn; SEL::get(ctx, t + stride, dn, ltn); const int nktn = dn.K >> 6, ktn = ltn % nktn, ctn = ltn / nktn;
            const float* s = dn.src + (size_t)(ktn * 64 + k) * dn.ldsrc + dn.c0 + ctn * 256 + n8;
#pragma unroll
            for (int q = 0; q < 4; ++q) { v[q][0] = *(const f32x4*)(s + q * 64); v[q][1] = *(const f32x4*)(s + q * 64 + 4); } }
#pragma unroll
        for (int q = 0; q < 4; ++q)
#pragma unroll
            for (int j = 0; j < 4; ++j) tl[(q * 64 + n8 + j + ((k & 1) ? 4 : 0)) * 33 + (k >> 1)] = w[q][j];
        __syncthreads();
        { const int n = tid >> 3, k8 = (tid & 7) * 8;
#pragma unroll
          for (int q = 0; q < 4; ++q) {
              const LAS unsigned* p = tl + (q * 64 + n) * 33 + (k8 >> 1);
              u32x4 ww; ww.x = p[0]; ww.y = p[1]; ww.z = p[2]; ww.w = p[3];
              const int cc = ct * 256 + q * 64 + n;
              const int drow = d.mode == 0 ? d.doff + cc : ((cc >> 7) * 256 + (cc & 127) + (d.mode == 2 ? 128 : 0));
              *(u32x4*)(d.dst + (size_t)drow * d.K + kt * 64 + k8) = ww; } }
        __syncthreads();
    }
}
struct SelOne { static __device__ __forceinline__ void get(const TrDesc& c, int t, TrDesc& d, int& lt) { d = c; lt = t; } };
struct FfnCtx { const float* wg; const float* wu; const float* wd; bf16_t* wgu; bf16_t* wdown; };
struct SelFfn { static __device__ __forceinline__ void get(const FfnCtx& c, int t, TrDesc& d, int& lt) {
    if (t < 704)       { d = TrDesc{c.wg, DFF, 2048, 0, DFF, c.wgu, 1, 0}; lt = t; }
    else if (t < 1408) { d = TrDesc{c.wu, DFF, 2048, 0, DFF, c.wgu, 2, 0}; lt = t - 704; }
    else               { d = TrDesc{c.wd, 2048, DFF, 0, 2048, c.wdown, 0, 0}; lt = t - 1408; } } };

__device__ __forceinline__ double kd(double c) { asm volatile("" : "+v"(c)); return c; }
__device__ __forceinline__ double exp_d(double x) {
    const double y = x * 0.125; double term = 1.0, sum = 1.0;
#pragma unroll 1
    for (int n = 1; n <= 22; ++n) { term *= y / (double)n; sum += term; }
    sum *= sum; sum *= sum; sum *= sum; return sum;
}
__device__ __forceinline__ void sincos_d(double x, double& s, double& c) {
    const double k = rint(x * kd(0.15915494309189535));
    double r = fma(-k, kd(6.283185307179586232), x); r = fma(-k, kd(2.4492935982947064e-16), r);
    const double y = r * 0.125, my2 = -(y * y);
    double sn = y, cs = 1.0, ts = y, tc = 1.0;
#pragma unroll 1
    for (int n = 1; n <= 10; ++n) { tc *= my2 / (double)((2 * n - 1) * (2 * n)); cs += tc; ts *= my2 / (double)((2 * n) * (2 * n + 1)); sn += ts; }
#pragma unroll 1
    for (int i = 0; i < 3; ++i) { const double c2 = cs * cs - sn * sn, s2 = 2.0 * sn * cs; cs = c2; sn = s2; }
    s = sn; c = cs;
}

__device__ __forceinline__ void s5_disc(const Args& a, int l, int g, int dir, int p, double& ar, double& ai, double& qr, double& qi) {
    const double lr = (double)a.in[7][((l * 2 + dir) * 48 + g) * 64 + p], li = (double)a.in[8][((l * 2 + dir) * 48 + g) * 64 + p];
    const double st = exp_d((double)a.in[9][(l * 2 + dir) * 48 + g]);
    const double mag = exp_d(lr * st); double sn, cs; sincos_d(li * st, sn, cs);
    ar = mag * cs; ai = mag * sn; const double den = lr * lr + li * li, nr = ar - 1.0;
    qr = (nr * lr + ai * li) / den; qi = (ai * lr - nr * li) / den;
}
__device__ __forceinline__ void s5_group_a(LAS unsigned char* lds, const Args& a, int l, int g) {
    const int tid = tid_l();
    LAS float* apw = (LAS float*)lds;
    LAS float* bbr = apw + 2 * 33 * 64 * 2;
    bf16_t* GMp = (bf16_t*)(a.ws + WS_GM); float* ALp = (float*)(a.ws + WS_AL); float* APWp = (float*)(a.ws + WS_APW);
    if (tid < 128) {
        const int dir = tid >> 6, p = tid & 63;
        double ar, ai, qr, qi; s5_disc(a, l, g, dir, p, ar, ai, qr, qi);
        double pr = 1.0, pi = 0.0;
#pragma unroll 1
        for (int tau = 0; tau <= 32; ++tau) { const float fr_ = (float)pr, fi_ = (float)pi;
            apw[((dir * 33 + tau) * 64 + p) * 2] = fr_; apw[((dir * 33 + tau) * 64 + p) * 2 + 1] = fi_;
            *(f32x2*)(APWp + ((size_t)((g * 2 + dir) * 33 + tau) * 64 + p) * 2) = (f32x2){fr_, fi_};
            const double nr2 = pr * ar - pi * ai, ni2 = pr * ai + pi * ar; pr = nr2; pi = ni2; }
        ALp[((g * 2 + dir) * 64 + p) * 2] = apw[((dir * 33 + 32) * 64 + p) * 2]; ALp[((g * 2 + dir) * 64 + p) * 2 + 1] = apw[((dir * 33 + 32) * 64 + p) * 2 + 1];
#pragma unroll 1
        for (int c = 0; c < 16; ++c) { const double br = (double)a.in[10][((l * 48 + g) * 64 + p) * 16 + c], bi = (double)a.in[11][((l * 48 + g) * 64 + p) * 16 + c];
            bbr[((dir * 64 + p) * 16 + c) * 2] = (float)(qr * br - qi * bi); bbr[((dir * 64 + p) * 16 + c) * 2 + 1] = (float)(qr * bi + qi * br); }
    }
    __syncthreads();
    {
        const int row = tid >> 1, half = tid & 1, dir = row >> 7, p = (row >> 1) & 63, ri = row & 1;
        bf16_t* rowp = GMp + ((size_t)g * 256 + row) * 512;
        for (int jj = 0; jj < 16; ++jj) { const int j = half * 16 + jj, e = dir == 0 ? 31 - j : j;
            const float wr_ = apw[((dir * 33 + e) * 64 + p) * 2], wi_ = apw[((dir * 33 + e) * 64 + p) * 2 + 1];
            float v[16];
#pragma unroll
            for (int c2 = 0; c2 < 16; ++c2) { const float Br = bbr[((dir * 64 + p) * 16 + c2) * 2], Bi = bbr[((dir * 64 + p) * 16 + c2) * 2 + 1];
                v[c2] = ri == 0 ? wr_ * Br - wi_ * Bi : wr_ * Bi + wi_ * Br; }
            u32x4 w0, w1; w0.x = cvt_pk_bf16(v[0], v[1]); w0.y = cvt_pk_bf16(v[2], v[3]); w0.z = cvt_pk_bf16(v[4], v[5]); w0.w = cvt_pk_bf16(v[6], v[7]);
            w1.x = cvt_pk_bf16(v[8], v[9]); w1.y = cvt_pk_bf16(v[10], v[11]); w1.z = cvt_pk_bf16(v[12], v[13]); w1.w = cvt_pk_bf16(v[14], v[15]);
            *(u32x4*)(rowp + j * 16) = w0; *(u32x4*)(rowp + j * 16 + 8) = w1; }
    }
    __syncthreads();
}
__device__ __forceinline__ void s5_ktab(LAS unsigned char* lds, const Args& a, int l, int task) {
    const int tid = tid_l(), g = task >> 3, dir = (task >> 2) & 1, tb = task & 3;
    LAS float* ap8 = (LAS float*)lds;
    LAS float* bbr = ap8 + 8 * 64 * 2;
    LAS float* ccx = bbr + 64 * 16 * 2;
    LAS float* cw  = ccx + 16 * 64 * 2;
    float* KTp = (float*)(a.ws + WS_KT);
    if (tid < 64) {
        const int p = tid; double ar, ai, qr, qi; s5_disc(a, l, g, dir, p, ar, ai, qr, qi);
        double pr = 1.0, pi = 0.0;
#pragma unroll 1
        for (int t = 0; t < tb * 8; ++t) { const double nr2 = pr * ar - pi * ai, ni2 = pr * ai + pi * ar; pr = nr2; pi = ni2; }
#pragma unroll 1
        for (int t = 0; t < 8; ++t) { ap8[(t * 64 + p) * 2] = (float)pr; ap8[(t * 64 + p) * 2 + 1] = (float)pi;
            const double nr2 = pr * ar - pi * ai, ni2 = pr * ai + pi * ar; pr = nr2; pi = ni2; }
#pragma unroll 1
        for (int c = 0; c < 16; ++c) { const double br = (double)a.in[10][((l * 48 + g) * 64 + p) * 16 + c], bi = (double)a.in[11][((l * 48 + g) * 64 + p) * 16 + c];
            bbr[(p * 16 + c) * 2] = (float)(qr * br - qi * bi); bbr[(p * 16 + c) * 2 + 1] = (float)(qr * bi + qi * br); }
    }
    for (int idx = tid; idx < 1024; idx += NTHREADS) { const int c = idx >> 6, p = idx & 63;
        ccx[idx * 2] = a.in[12][((l * 48 + g) * 16 + c) * 64 + p]; ccx[idx * 2 + 1] = a.in[13][((l * 48 + g) * 16 + c) * 64 + p]; }
    __syncthreads();
    for (int idx = tid; idx < 8192; idx += NTHREADS) { const int t = idx >> 10, cp = idx & 1023, p = idx & 63;
        const float Cr = ccx[cp * 2], Ci = ccx[cp * 2 + 1], wr_ = ap8[(t * 64 + p) * 2], wi_ = ap8[(t * 64 + p) * 2 + 1];
        cw[idx * 2] = Cr * wr_ - Ci * wi_; cw[idx * 2 + 1] = Cr * wi_ + Ci * wr_; }
    __syncthreads();
#pragma unroll
    for (int k = 0; k < 4; ++k) { const int o = tid + k * NTHREADS, t = o >> 8, c = (o >> 4) & 15, c2 = o & 15;
        float s = 0.f;
        for (int p = 0; p < 64; ++p) s += cw[((t * 16 + c) * 64 + p) * 2] * bbr[(p * 16 + c2) * 2] - cw[((t * 16 + c) * 64 + p) * 2 + 1] * bbr[(p * 16 + c2) * 2 + 1];
        KTp[((size_t)((g * 2 + dir) * 32 + tb * 8 + t)) * 256 + c * 16 + c2] = s; }
    __syncthreads();
}
__device__ __forceinline__ void s5_te(const Args& a, int l, int task) {
    const int tid = tid_l(), g = task >> 2, qd = task & 3, r = tid >> 2, sub = tid & 3, i = qd * 8 + (r >> 4), c = r & 15;
    const float* KTp = (const float*)(a.ws + WS_KT); const float* APWp = (const float*)(a.ws + WS_APW);
    bf16_t* rowp = (bf16_t*)(a.ws + WS_TE) + ((size_t)g * 512 + i * 16 + c) * 768;
    const float dsk = a.in[14][l * 768 + g * 16 + c];
    const float* kf = KTp + (size_t)((g * 2 + 0) * 32) * 256 + c * 16; const float* kb = KTp + (size_t)((g * 2 + 1) * 32) * 256 + c * 16;
#pragma unroll
    for (int jb = 0; jb < 8; jb += 4) {
        f32x4 v[4][4];
#pragma unroll
        for (int jq = 0; jq < 4; ++jq) { const int j = sub * 8 + jb + jq;
            const float* kp = j < i ? kf + (i - j) * 256 : (j > i ? kb + (j - i) * 256 : kf);
#pragma unroll
            for (int q = 0; q < 4; ++q) v[jq][q] = *(const f32x4*)(kp + q * 4);
            if (j == i) {
#pragma unroll
                for (int q = 0; q < 4; ++q) { v[jq][q] += *(const f32x4*)(kb + q * 4);
#pragma unroll
                    for (int e = 0; e < 4; ++e) v[jq][q][e] += (q * 4 + e == c) ? dsk : 0.f; } } }
#pragma unroll
        for (int jq = 0; jq < 4; ++jq) { const int j = sub * 8 + jb + jq;
            *(u32x4*)(rowp + j * 16) = pack8(v[jq][0], v[jq][1]); *(u32x4*)(rowp + j * 16 + 8) = pack8(v[jq][2], v[jq][3]); } }
    { const int dir = sub >> 1, p0 = (sub & 1) * 32, e = dir == 0 ? i + 1 : 32 - i;
      const float* cr = a.in[12] + ((l * 48 + g) * 16 + c) * 64 + p0; const float* ci = a.in[13] + ((l * 48 + g) * 16 + c) * 64 + p0;
      const float* aw = APWp + ((size_t)((g * 2 + dir) * 33 + e) * 64 + p0) * 2;
#pragma unroll 2
      for (int p4 = 0; p4 < 32; p4 += 4) { const f32x4 Cr = *(const f32x4*)(cr + p4), Ci = *(const f32x4*)(ci + p4), w0 = *(const f32x4*)(aw + p4 * 2), w1 = *(const f32x4*)(aw + p4 * 2 + 4);
          u32x4 ww; ww.x = cvt_pk_bf16(Cr[0] * w0[0] - Ci[0] * w0[1], -(Cr[0] * w0[1] + Ci[0] * w0[0])); ww.y = cvt_pk_bf16(Cr[1] * w0[2] - Ci[1] * w0[3], -(Cr[1] * w0[3] + Ci[1] * w0[2]));
          ww.z = cvt_pk_bf16(Cr[2] * w1[0] - Ci[2] * w1[1], -(Cr[2] * w1[1] + Ci[2] * w1[0])); ww.w = cvt_pk_bf16(Cr[3] * w1[2] - Ci[3] * w1[3], -(Cr[3] * w1[3] + Ci[3] * w1[2]));
          *(u32x4*)(rowp + 512 + dir * 128 + (p0 + p4) * 2) = ww; } }
}

__device__ __forceinline__ void winbf_task(LAS unsigned char* lds, const float* w_in_l, bf16_t* dst, int task) {
    const int tid = tid_l(), g = task & 3, k0 = (task >> 2) * 64;
    LAS float* Wt = (LAS float*)lds;
    LAS float* tc = Wt + 64 * 128; LAS float* ts = tc + 128;
    { const int k = tid >> 3, c16 = (tid & 7) * 16; const float* s = w_in_l + (size_t)(k0 + k) * INW + 1536 + g * 128 + c16;
#pragma unroll
      for (int q = 0; q < 4; ++q) *(LAS f32x4*)(Wt + k * 128 + c16 + q * 4) = *(const f32x4*)(s + q * 4); }
    if (tid < 128) { float sn, cs; sincospif((float)tid * (1.0f / 64.0f), &sn, &cs); tc[tid] = cs; ts[tid] = sn; }
    __syncthreads();
    const int cp = tid & 127, kq = tid >> 7;
    float aC[16], aS[16];
#pragma unroll
    for (int kk = 0; kk < 16; ++kk) { aC[kk] = 0.f; aS[kk] = 0.f; }
    for (int c = 0; c < 128; ++c) { const int idx = (c * cp) & 127; const float vc = tc[idx], vs = ts[idx];
#pragma unroll
        for (int kk = 0; kk < 16; ++kk) { const float w = Wt[(kq * 16 + kk) * 128 + c]; aC[kk] += w * vc; aS[kk] += w * vs; } }
    bf16_t* dc = dst + (size_t)(g * 128 + cp) * 2048 + k0 + kq * 16; bf16_t* ds = dst + (size_t)(512 + g * 128 + cp) * 2048 + k0 + kq * 16;
    u32x4 w; w.x = cvt_pk_bf16(aC[0], aC[1]); w.y = cvt_pk_bf16(aC[2], aC[3]); w.z = cvt_pk_bf16(aC[4], aC[5]); w.w = cvt_pk_bf16(aC[6], aC[7]); *(u32x4*)dc = w;
    w.x = cvt_pk_bf16(aC[8], aC[9]); w.y = cvt_pk_bf16(aC[10], aC[11]); w.z = cvt_pk_bf16(aC[12], aC[13]); w.w = cvt_pk_bf16(aC[14], aC[15]); *(u32x4*)(dc + 8) = w;
    w.x = cvt_pk_bf16(aS[0], aS[1]); w.y = cvt_pk_bf16(aS[2], aS[3]); w.z = cvt_pk_bf16(aS[4], aS[5]); w.w = cvt_pk_bf16(aS[6], aS[7]); *(u32x4*)ds = w;
    w.x = cvt_pk_bf16(aS[8], aS[9]); w.y = cvt_pk_bf16(aS[10], aS[11]); w.z = cvt_pk_bf16(aS[12], aS[13]); w.w = cvt_pk_bf16(aS[14], aS[15]); *(u32x4*)(ds + 8) = w;
    __syncthreads();
}

__device__ __forceinline__ void d256_gen(bf16_t* d256, int bx, int G) {
    for (int idx = bx * NTHREADS + tid_l(); idx < 256 * 512; idx += G * NTHREADS) { const int k1 = idx >> 9, ri = (idx >> 8) & 1, n1 = idx & 255, e = (n1 * k1) & 255;
        float sn, cs; sincospif((float)e * (1.0f / 128.0f), &sn, &cs);
        d256[idx] = f2bf((ri == 0 ? cs : -sn) * 0.0013810679320049757f); }
}
__device__ __forceinline__ void fft16_pass(LAS unsigned char* lds, const bf16_t* zf2, bf16_t* vt, int bx, int G) {
    const int tid = tid_l();
    LAS float* tw = (LAS float*)lds;
    for (int i = tid; i < 4096; i += NTHREADS) { float sn, cs; sincospif((float)i * (1.0f / 2048.0f), &sn, &cs); tw[2 * i] = cs; tw[2 * i + 1] = sn; }
    __syncthreads();
    const int n1 = tid & 255, sub = tid >> 8;
    u32x4 pw0, pw1, pw2, pw3;
    { const int task0 = bx * 2 + sub; if (task0 < 3072) { const bf16_t* src = zf2 + ((size_t)task0 * 256 + n1) * 32; pw0 = *(const u32x4*)src; pw1 = *(const u32x4*)(src + 8); pw2 = *(const u32x4*)(src + 16); pw3 = *(const u32x4*)(src + 24); } }
    for (int task = bx * 2 + sub; task < 3072; task += G * 2) {
        const u32x4 w0 = pw0, w1 = pw1, w2 = pw2, w3 = pw3;
        if (task + G * 2 < 3072) { const bf16_t* src = zf2 + ((size_t)(task + G * 2) * 256 + n1) * 32; pw0 = *(const u32x4*)src; pw1 = *(const u32x4*)(src + 8); pw2 = *(const u32x4*)(src + 16); pw3 = *(const u32x4*)(src + 24); }
        float zr[16], zi[16];
#pragma unroll
        for (int e = 0; e < 4; ++e) { zr[2 * e] = bf_lo(w0[e]); zr[2 * e + 1] = bf_hi(w0[e]); zr[8 + 2 * e] = bf_lo(w1[e]); zr[8 + 2 * e + 1] = bf_hi(w1[e]);
                                      zi[2 * e] = bf_lo(w2[e]); zi[2 * e + 1] = bf_hi(w2[e]); zi[8 + 2 * e] = bf_lo(w3[e]); zi[8 + 2 * e + 1] = bf_hi(w3[e]); }
        float Ar[4][4], Ai[4][4];
#pragma unroll
        for (int q = 0; q < 4; ++q) {
            const float s0r = zr[q] + zr[8 + q], s0i = zi[q] + zi[8 + q], s1r = zr[q] - zr[8 + q], s1i = zi[q] - zi[8 + q];
            const float s2r = zr[4 + q] + zr[12 + q], s2i = zi[4 + q] + zi[12 + q], s3r = zr[4 + q] - zr[12 + q], s3i = zi[4 + q] - zi[12 + q];
            Ar[q][0] = s0r + s2r; Ai[q][0] = s0i + s2i; Ar[q][2] = s0r - s2r; Ai[q][2] = s0i - s2i;
            Ar[q][1] = s1r - s3i; Ai[q][1] = s1i + s3r; Ar[q][3] = s1r + s3i; Ai[q][3] = s1i - s3r; }
        const float c1 = 0.9238795325f, s1 = 0.3826834324f, c2 = 0.7071067812f;
#define CMUL(xr, xi, cr, ci) { const float t_ = xr * (cr) - xi * (ci); xi = xr * (ci) + xi * (cr); xr = t_; }
        CMUL(Ar[1][1], Ai[1][1], c1, s1) CMUL(Ar[1][2], Ai[1][2], c2, c2) CMUL(Ar[1][3], Ai[1][3], s1, c1)
        CMUL(Ar[2][1], Ai[2][1], c2, c2) CMUL(Ar[2][2], Ai[2][2], 0.f, 1.f) CMUL(Ar[2][3], Ai[2][3], -c2, c2)
        CMUL(Ar[3][1], Ai[3][1], s1, c1) CMUL(Ar[3][2], Ai[3][2], -c2, c2) CMUL(Ar[3][3], Ai[3][3], -c1, -s1)
#undef CMUL
        float xr[16], xi[16];
#pragma unroll
        for (int r = 0; r < 4; ++r) {
            const float s0r = Ar[0][r] + Ar[2][r], s0i = Ai[0][r] + Ai[2][r], s1r = Ar[0][r] - Ar[2][r], s1i = Ai[0][r] - Ai[2][r];
            const float s2r = Ar[1][r] + Ar[3][r], s2i = Ai[1][r] + Ai[3][r], s3r = Ar[1][r] - Ar[3][r], s3i = Ai[1][r] - Ai[3][r];
            xr[r] = s0r + s2r; xi[r] = s0i + s2i; xr[r + 8] = s0r - s2r; xi[r + 8] = s0i - s2i;
            xr[r + 4] = s1r - s3i; xi[r + 4] = s1i + s3r; xr[r + 12] = s1r + s3i; xi[r + 12] = s1i - s3r; }
        const int b = task >> 9, gc = task & 511;
        bf16_t* dst = vt + ((size_t)(b * 16) * 512 + gc) * 512 + n1;
#pragma unroll
        for (int k2 = 0; k2 < 16; ++k2) { const int idx = (n1 * k2) & 4095; const float c = tw[2 * idx], sn = tw[2 * idx + 1];
            dst[(size_t)k2 * 512 * 512] = f2bf(xr[k2] * c - xi[k2] * sn); dst[(size_t)k2 * 512 * 512 + 256] = f2bf(xr[k2] * sn + xi[k2] * c); }
    }
    __syncthreads();
}

template <int MODE>
__device__ __forceinline__ void rms_rows(const float* xp, const float* xs, float* xres, const float* gain, bf16_t* outb, int bx, int G) {
    const int tid = tid_l(), lane = tid & 63, wave = tid >> 6;
    f32x4 gv[8];
#pragma unroll
    for (int it = 0; it < 8; ++it) gv[it] = *(const f32x4*)(gain + it * 256 + lane * 4);
    for (int row = (bx * 8 + wave) * 2; row < T; row += G * 16) {
        f32x4 v[2][8]; float ss[2] = {0.f, 0.f};
#pragma unroll
        for (int rr = 0; rr < 2; ++rr) { const int r_ = row + rr;
            const float* src = MODE == 0 ? (r_ < 16384 ? xp + (size_t)r_ * 2048 : xs + (size_t)(r_ - 16384) * 2048) : xres + (size_t)r_ * 2048;
#pragma unroll
            for (int it = 0; it < 8; ++it) v[rr][it] = *(const f32x4*)(src + it * 256 + lane * 4); }
#pragma unroll
        for (int rr = 0; rr < 2; ++rr) {
#pragma unroll
            for (int it = 0; it < 8; ++it) ss[rr] += v[rr][it][0] * v[rr][it][0] + v[rr][it][1] * v[rr][it][1] + v[rr][it][2] * v[rr][it][2] + v[rr][it][3] * v[rr][it][3];
            ss[rr] = wave_sum(ss[rr]); }
#pragma unroll
        for (int rr = 0; rr < 2; ++rr) { const float r = 1.0f / sqrtf(ss[rr] * (1.0f / 2048.0f) + EPS);
#pragma unroll
            for (int it = 0; it < 8; ++it) {
                const f32x4 o = v[rr][it] * r * gv[it];
                if (MODE == 2) *(f32x4*)(xres + (size_t)(row + rr) * 2048 + it * 256 + lane * 4) = o;
                else { u32x2 w; w.x = cvt_pk_bf16(o[0], o[1]); w.y = cvt_pk_bf16(o[2], o[3]); *(u32x2*)(outb + (size_t)(row + rr) * 2048 + it * 256 + lane * 4) = w; }
            } }
    }
}

__device__ __forceinline__ void outnorm_rows(bf16_t* y, const float* og, int bx, int G) {
    const int tid = tid_l(), lane = tid & 63, wave = tid >> 6;
    for (int row = (bx * 8 + wave) * 2; row < T; row += G * 16) {
        u32x4 w[2][4]; float ss[2][3];
#pragma unroll
        for (int rr = 0; rr < 2; ++rr)
#pragma unroll
            for (int it = 0; it < 4; ++it) w[rr][it] = *(const u32x4*)(y + (size_t)(row + rr) * 2048 + (it * 64 + lane) * 8);
#pragma unroll
        for (int rr = 0; rr < 2; ++rr) { ss[rr][0] = 0.f; ss[rr][1] = 0.f; ss[rr][2] = 0.f;
#pragma unroll
            for (int it = 0; it < 4; ++it) { const int ch = it * 64 + lane; float s = 0.f;
#pragma unroll
                for (int q = 0; q < 4; ++q) { const float a0 = bf_lo(w[rr][it][q]), a1 = bf_hi(w[rr][it][q]); s += a0 * a0 + a1 * a1; }
                const int seg = ch < 96 ? 0 : (ch < 160 ? 1 : 2);
                ss[rr][0] += seg == 0 ? s : 0.f; ss[rr][1] += seg == 1 ? s : 0.f; ss[rr][2] += seg == 2 ? s : 0.f; }
            ss[rr][0] = wave_sum(ss[rr][0]); ss[rr][1] = wave_sum(ss[rr][1]); ss[rr][2] = wave_sum(ss[rr][2]); }
#pragma unroll
        for (int rr = 0; rr < 2; ++rr) {
            const float r0 = 1.0f / sqrtf(ss[rr][0] * (1.0f / 768.0f) + EPS), r1 = 1.0f / sqrtf(ss[rr][1] * (1.0f / 512.0f) + EPS), r2 = 1.0f / sqrtf(ss[rr][2] * (1.0f / 768.0f) + EPS);
#pragma unroll
            for (int it = 0; it < 4; ++it) { const int ch = it * 64 + lane; const float r = ch < 96 ? r0 : (ch < 160 ? r1 : r2);
                const f32x4 g0 = *(const f32x4*)(og + ch * 8), g1 = *(const f32x4*)(og + ch * 8 + 4);
                const u32x4 ww = w[rr][it];
                u32x4 o; o.x = cvt_pk_bf16(bf_lo(ww.x) * r * g0[0], bf_hi(ww.x) * r * g0[1]); o.y = cvt_pk_bf16(bf_lo(ww.y) * r * g0[2], bf_hi(ww.y) * r * g0[3]);
                o.z = cvt_pk_bf16(bf_lo(ww.z) * r * g1[0], bf_hi(ww.z) * r * g1[1]); o.w = cvt_pk_bf16(bf_lo(ww.w) * r * g1[2], bf_hi(ww.w) * r * g1[3]);
                *(u32x4*)(y + (size_t)(row + rr) * 2048 + ch * 8) = o; } }
    }
}

__device__ __forceinline__ void gmlp_task(LAS unsigned char* lds, const bf16_t* zina, const bf16_t* wsb, const float* vg, const float* bs, bf16_t* y, int task) {
    const int tid = tid_l(), lane = tid & 63, wid = tid >> 6, fr = lane & 15, fq = lane >> 4;
    const int cidx = task / 6, h = task - cidx * 6, t0 = cidx * 128;
    LAS bf16_t* vT = (LAS bf16_t*)lds;
    { const int k = tid >> 2, dq = (tid & 3) * 32;
      const bf16_t* src = zina + (size_t)(t0 + k) * 1536 + 768 + h * 128 + dq;
      u32x4 w[4]; float ss = 0.f;
#pragma unroll
      for (int q = 0; q < 4; ++q) { w[q] = *(const u32x4*)(src + q * 8);
#pragma unroll
          for (int e = 0; e < 4; ++e) { const float a0 = bf_lo(w[q][e]), a1 = bf_hi(w[q][e]); ss += a0 * a0 + a1 * a1; } }
      ss += __shfl_xor(ss, 1); ss += __shfl_xor(ss, 2);
      const float r = 1.0f / sqrtf(ss * (1.0f / 128.0f) + EPS);
#pragma unroll
      for (int q = 0; q < 4; ++q)
#pragma unroll
          for (int e = 0; e < 4; ++e) { const int d = dq + q * 8 + e * 2;
              vT[d * 136 + k] = f2bf(bf_lo(w[q][e]) * r * vg[h * 128 + d]); vT[(d + 1) * 136 + k] = f2bf(bf_hi(w[q][e]) * r * vg[h * 128 + d + 1]); } }
    __syncthreads();
    const int q0 = (wid >> 1) * 32, d0 = (wid & 1) * 64;
    f32x4 acc[2][4];
#pragma unroll
    for (int mq = 0; mq < 2; ++mq)
#pragma unroll
        for (int nd = 0; nd < 4; ++nd) acc[mq][nd] = (f32x4){0.f, 0.f, 0.f, 0.f};
#pragma unroll
    for (int ks = 0; ks < 4; ++ks) {
        bf16x8 af[2], bfr[4];
#pragma unroll
        for (int mq = 0; mq < 2; ++mq) af[mq] = *(const bf16x8*)(wsb + (size_t)(h * 128 + q0 + mq * 16 + fr) * 128 + ks * 32 + fq * 8);
#pragma unroll
        for (int nd = 0; nd < 4; ++nd) bfr[nd] = *(const LAS bf16x8*)(vT + (d0 + nd * 16 + fr) * 136 + ks * 32 + fq * 8);
#pragma unroll
        for (int mq = 0; mq < 2; ++mq)
#pragma unroll
            for (int nd = 0; nd < 4; ++nd) acc[mq][nd] = __builtin_amdgcn_mfma_f32_16x16x32_bf16(bfr[nd], af[mq], acc[mq][nd], 0, 0, 0);
    }
    u32x2 uq[2][4];
#pragma unroll
    for (int mq = 0; mq < 2; ++mq)
#pragma unroll
        for (int nd = 0; nd < 4; ++nd) uq[mq][nd] = *(const u32x2*)(zina + (size_t)(t0 + q0 + mq * 16 + fr) * 1536 + h * 128 + d0 + nd * 16 + 4 * fq);
#pragma unroll
    for (int mq = 0; mq < 2; ++mq) { const int q = q0 + mq * 16 + fr; const float b = bs[h * 128 + q];
#pragma unroll
        for (int nd = 0; nd < 4; ++nd) { const int d = d0 + nd * 16 + 4 * fq;
            const u32x2 uu = uq[mq][nd];
            const f32x4 m = acc[mq][nd] + b;
            u32x2 o; o.x = cvt_pk_bf16(bf_lo(uu.x) * m[0], bf_hi(uu.x) * m[1]); o.y = cvt_pk_bf16(bf_lo(uu.y) * m[2], bf_hi(uu.y) * m[3]);
            *(u32x2*)(y + (size_t)(t0 + q) * 2048 + h * 128 + d) = o; } }
    __syncthreads();
}

__device__ __forceinline__ void carry_scan(const float* xs, const float* ALp, bf16_t* ucat, int bx) {
    const int idx = bx * NTHREADS + tid_l();
    if (idx >= 48 * 6 * 128) return;
    const int p = idx & 63, dir = (idx >> 6) & 1, b = (idx >> 7) % 6, g = idx / 768;
    const f32x2 aL = *(const f32x2*)(ALp + ((g * 2 + dir) * 64 + p) * 2);
    float hr = 0.f, hi = 0.f;
#pragma unroll 32
    for (int s = 0; s < 128; ++s) { const int c = dir == 0 ? s : 127 - s; const size_t chunk = (size_t)g * 768 + b * 128 + c;
        const f32x2 x = *(const f32x2*)(xs + chunk * 256 + dir * 128 + p * 2);
        *(unsigned*)(ucat + chunk * 768 + 512 + dir * 128 + p * 2) = cvt_pk_bf16(hr, hi);
        const float nr = aL.x * hr - aL.y * hi + x.x, ni = aL.x * hi + aL.y * hr + x.y; hr = nr; hi = ni; }
}

#define XB_TMO      128
#define XB_XCNT(j)  (256  + 64 * (j))
#define XB_XSUB(j)  (1280 + 64 * (j))
#define XB_XGEN(j)  (2304 + 64 * (j))
#define XB_TOP      3328
#define XB_TOPGEN   3392
#define XCD_BAR_WORDS 3456
#define XB_SPIN_CAP (1u << 22)
__device__ __forceinline__ unsigned xb_ld(unsigned* p)              { return __hip_atomic_load(p, __ATOMIC_RELAXED, __HIP_MEMORY_SCOPE_AGENT); }
__device__ __forceinline__ unsigned xb_add(unsigned* p, unsigned v) { return __hip_atomic_fetch_add(p, v, __ATOMIC_RELAXED, __HIP_MEMORY_SCOPE_AGENT); }
__device__ __forceinline__ unsigned xb_xcc_id() { return (unsigned)__builtin_amdgcn_s_getreg((3 << 11) | 20) & 0xFu; }
#define XB_SPIN(cond, bar) do { unsigned _sp = 0; while (cond) { __builtin_amdgcn_s_sleep(1); \
    if ((++_sp & 255u) == 0u) { if (xb_ld(&(bar)[XB_TMO])) break; if (_sp > XB_SPIN_CAP) { atomicAdd(&(bar)[XB_TMO], 1u); break; } } } } while (0)
struct XcdBarrier { unsigned* bar; unsigned x; volatile LAS unsigned* st; };
__device__ __forceinline__ XcdBarrier xcd_barrier_post(unsigned* bar, volatile LAS unsigned* st) {
    XcdBarrier b; b.bar = bar; b.x = xb_xcc_id(); b.st = st;
    if (threadIdx.x == 0) (void)xb_add(&bar[XB_XCNT(b.x)], 1u);
    return b;
}
__device__ __forceinline__ void xcd_barrier_complete(unsigned* bar, unsigned x, unsigned& nloc, unsigned& nx) {
    const unsigned Gt = gridDim.x * gridDim.y * gridDim.z;
    unsigned sum, cnt, mine, sp = 0u;
    for (;;) {
        sum = 0u; cnt = 0u; mine = 0u;
#pragma unroll
        for (unsigned j = 0; j < 16; ++j) { const unsigned c = xb_ld(&bar[XB_XCNT(j)]); sum += c; cnt += (c > 0u) ? 1u : 0u; mine = (j == x) ? c : mine; }
        if (sum == Gt) break;
        __builtin_amdgcn_s_sleep(1);
        if ((++sp & 255u) == 0u) { if (xb_ld(&bar[XB_TMO])) break; if (sp > XB_SPIN_CAP) { atomicAdd(&bar[XB_TMO], 1u); break; } }
    }
    nloc = mine > 0u ? mine : 1u; nx = cnt > 0u ? cnt : 1u;
}
__device__ __forceinline__ void xcd_barrier(const XcdBarrier& b) {
    asm volatile("s_waitcnt vmcnt(0)" ::: "memory");
    __syncthreads();
    if (threadIdx.x == 0) {
        unsigned* bar = b.bar;
        __builtin_amdgcn_s_waitcnt(0);
        unsigned nloc = b.st[0], nx = b.st[1];
        if (nloc == 0u) { xcd_barrier_complete(bar, b.x, nloc, nx); b.st[0] = nloc; b.st[1] = nx; }
        const unsigned old = xb_add(&bar[XB_XSUB(b.x)], 1u);
        const unsigned gen = old / nloc;
        if (old + 1u == (gen + 1u) * nloc) {
            __builtin_amdgcn_fence(__ATOMIC_RELEASE, "agent");
            asm volatile("s_waitcnt vmcnt(0)" ::: "memory");
            const unsigned og = xb_add(&bar[XB_TOP], 1u);
            const unsigned tg = og / nx;
            if (og + 1u == (tg + 1u) * nx) xb_add(&bar[XB_TOPGEN], 1u);
            else XB_SPIN(xb_ld(&bar[XB_TOPGEN]) == tg, bar);
            __builtin_amdgcn_fence(__ATOMIC_ACQUIRE, "agent");
            xb_add(&bar[XB_XGEN(b.x)], 1u);
            asm volatile("s_waitcnt vmcnt(0)" ::: "memory");
        } else {
            XB_SPIN(xb_ld(&bar[XB_XGEN(b.x)]) == gen, bar);
            __builtin_amdgcn_fence(__ATOMIC_ACQUIRE, "agent");
            asm volatile("s_waitcnt vmcnt(0)" ::: "memory");
        }
    }
    __syncthreads();
}

__device__ __forceinline__ void grid_bar(unsigned* cnt, unsigned target) {
    asm volatile("s_waitcnt vmcnt(0)" ::: "memory");
    __syncthreads();
    if (threadIdx.x == 0) {
        __builtin_amdgcn_fence(__ATOMIC_RELEASE, "agent");
        asm volatile("s_waitcnt vmcnt(0)" ::: "memory");
        (void)__hip_atomic_fetch_add(cnt, 1u, __ATOMIC_RELAXED, __HIP_MEMORY_SCOPE_AGENT);
        unsigned sp = 0;
        while (__hip_atomic_load(cnt, __ATOMIC_RELAXED, __HIP_MEMORY_SCOPE_AGENT) < target) { __builtin_amdgcn_s_sleep(1); if (++sp > (1u << 22)) break; }
        __builtin_amdgcn_fence(__ATOMIC_ACQUIRE, "agent");
        asm volatile("s_waitcnt vmcnt(0)" ::: "memory");
    }
    __syncthreads();
}

constexpr int N_PHASES = 23;
__global__ void __launch_bounds__(NTHREADS, 2) mega_fwd(Args a) {
    extern __shared__ __attribute__((aligned(16))) unsigned char lds_raw[];
    LAS unsigned char* lds = (LAS unsigned char*)lds_raw;
    cg::grid_group grid = cg::this_grid();
#define WINAC ((bf16_t*)(ws + WS_WINAC))
#define WINBF ((bf16_t*)(ws + WS_WINBF))
#define WOUT  ((bf16_t*)(ws + WS_WOUT))
#define WGLU  ((bf16_t*)(ws + WS_WGLU))
#define WSB   ((bf16_t*)(ws + WS_WS))
#define WGU   ((bf16_t*)(ws + WS_WGU))
#define WDOWN ((bf16_t*)(ws + WS_WDOWN))
#define VT    ((bf16_t*)(ws + WS_VT))
#define D256  ((bf16_t*)(ws + WS_D256))
#define AL    ((float*)(ws + WS_AL))
#define SLOT1 ((bf16_t*)(ws + WS_SLOT1))
#define ZINA  ((bf16_t*)(ws + WS_ZINA))
#define ZFT   ((bf16_t*)(ws + WS_ZFT))
#define YCPRE ((bf16_t*)(ws + WS_YCPRE))
#define UCAT  ((bf16_t*)(ws + WS_UCAT))
#define XS    ((float*)(ws + WS_XS))
#define TE    ((bf16_t*)(ws + WS_TE))
#define GM    ((bf16_t*)(ws + WS_GM))
#define HID   ((bf16_t*)(ws + WS_HID))
    int ph = 0; unsigned nbar = 0;
    volatile LAS unsigned* xst = (volatile LAS unsigned*)(lds + 131072);
    if (threadIdx.x == 0) { xst[0] = 0u; xst[1] = 0u; }
    __syncthreads();
    const XcdBarrier xbar = xcd_barrier_post((unsigned*)(a.ws + WS_CTL), xst);
#define GRID_SYNC() do { if (a.ph_lo > 4096) { grid.sync(); } else { xcd_barrier(xbar); } ++nbar; } while (0)
#ifndef ONLY_PH
#define ONLY_PH -1
#endif
#ifndef PROBE_DUP
#define PROBE_DUP -1
#endif
#define PH_BEGIN(k) if ((ONLY_PH < 0 || ONLY_PH == (k)) && ph >= a.ph_lo && ph < a.ph_hi) { const int nrep_ = ((k) == PROBE_DUP) ? 2 : 1; for (int rep_ = 0; rep_ < nrep_; ++rep_) { unsigned char* ws = a.ws; float* X = a.out; int bx = blockIdx.x, G = gridDim.x; asm volatile("; PHASEMARK %4" : "+s"(ws), "+s"(X), "+s"(bx), "+s"(G) : "i"(k));
#define PH_END   if (rep_ + 1 < nrep_) GRID_SYNC(); } if (ph + 1 < a.ph_hi) GRID_SYNC(); } ++ph;

#define FFN_CONVERT(t0, t1) do { if (bx >= 32) { \
        const FfnCtx fc{a.in[20] + (size_t)l * 2048 * DFF, a.in[21] + (size_t)l * 2048 * DFF, a.in[22] + (size_t)l * DFF * 2048, WGU, WDOWN}; \
        transpose_run<SelFfn>(lds, fc, (t0) + bx - 32, (t1), G - 32); } } while (0)
#pragma unroll 1
    for (int l = 0; l < 2; ++l) {
        PH_BEGIN(0)
            for (int g = bx; g < NGRP; g += G) s5_group_a(lds, a, l, g);
            for (int t = G - 1 - bx; t < NGRP * 8; t += G) s5_ktab(lds, a, l, t);
            for (int t = (bx + G - 48) % G; t < 128; t += G) winbf_task(lds, a.in[3] + (size_t)l * 2048 * INW, WINBF, t);
            if (l == 0) d256_gen(D256, bx, G);
            {
                const float* s = a.in[5] + (size_t)l * 6 * 128 * 128;
                for (int i = bx * NTHREADS + tid_l(); i < 6 * 128 * 128 / 2; i += G * NTHREADS) ((unsigned*)WSB)[i] = cvt_pk_bf16(s[2 * i], s[2 * i + 1]);
            }
            {
                const TrDesc td[4] = {
                    {a.in[3] + (size_t)l * 2048 * INW, INW, 2048, 0, 1536, WINAC, 0, 0},
                    {a.in[3] + (size_t)l * 2048 * INW, INW, 2048, 2048, 768, WINAC, 0, 1536},
                    {a.in[18] + (size_t)l * 2048 * 2048, 2048, 2048, 0, 2048, WOUT, 0, 0},
                    {a.in[15] + (size_t)l * 768 * 768, 768, 768, 0, 768, WGLU, 0, 0}};
                const int ntile[4] = {32 * 6, 32 * 3, 32 * 8, 12 * 3};
#pragma unroll
                for (int m = 0; m < 4; ++m) transpose_run<SelOne>(lds, td[m], bx, ntile[m], G);
            }
            if (l == 0) rms_rows<0>(a.in[0], a.in[1], X, a.in[2], SLOT1, bx, G);
            else        rms_rows<1>(nullptr, nullptr, X, a.in[2] + l * 2048, SLOT1, bx, G);
        PH_END
        PH_BEGIN(1)
            { pg8::Sched S{(const char*)SLOT1, (const char*)WINAC, 0, 0, 2048, 2048, T / 256, 9, 1, G, bx, 0, 8}; EpiWin E{ZINA, UCAT}; pg8::gemm_phase(lds, S, 2048, E); }
            { pg8::Sched S{(const char*)WINBF, (const char*)SLOT1, 0, 0, 2048, 2048, 4, T / 256, 1, G, G - 1 - bx, 1, 8}; EpiZft2 E{ZFT}; pg8::gemm_phase(lds, S, 2048, E); }
        PH_END
        PH_BEGIN(2)
            fft16_pass(lds, ZFT, VT, bx, G);
            { pg8::Sched S{(const char*)UCAT, (const char*)GM, (long)768 * 768 * 2, (long)256 * 512 * 2, 768, 512, 3, 1, NGRP, G, bx, 0, 8}; EpiXs E{XS}; pg8::gemm_phase(lds, S, 512, E); }
            for (int t = G - 1 - bx; t < 192 * 6; t += G) gmlp_task(lds, ZINA, WSB, a.in[4] + l * 768, a.in[6] + l * 768, SLOT1, t);
            for (int t = bx; t < NGRP * 4; t += G) s5_te(a, l, t);
        PH_END
        PH_BEGIN(3)
            if (bx < 72) carry_scan(XS, AL, UCAT, bx);
            if (bx >= 64) { pg8::Sched S{(const char*)D256, (const char*)VT, 0, 0, 512, 512, 1, 192, 1, G - 64, bx - 64, 0, 8}; EpiFour2 E{SLOT1}; pg8::gemm_phase(lds, S, 512, E); }
        PH_END
        PH_BEGIN(4)
            { pg8::Sched S{(const char*)UCAT, (const char*)TE, (long)768 * 768 * 2, (long)512 * 768 * 2, 768, 768, 3, 2, NGRP, G, bx, 0, 8}; EpiYc E{YCPRE}; pg8::gemm_phase(lds, S, 768, E); }
            FFN_CONVERT(0, 1056);
        PH_END
        PH_BEGIN(5)
            { pg8::Sched S{(const char*)YCPRE, (const char*)WGLU, 0, 0, 768, 768, T / 256, 3, 1, G, bx, 0, 8}; EpiGlu E{YCPRE, a.in[16] + l * 768, SLOT1}; pg8::gemm_phase(lds, S, 768, E); }
            FFN_CONVERT(1056, 2112);
        PH_END
        PH_BEGIN(6)
            outnorm_rows(SLOT1, a.in[17] + l * 2048, bx, G);
        PH_END
        PH_BEGIN(7)
            { pg8::Sched S{(const char*)SLOT1, (const char*)WOUT, 0, 0, 2048, 2048, T / 256, 8, 1, G, bx, 0, 4}; EpiRes E{X, l == 0 ? a.in[0] : X, (l == 0 ? a.in[1] : X + (size_t)16384 * 2048) - (size_t)16384 * 2048}; pg8::gemm_phase(lds, S, 2048, E); }
        PH_END
        PH_BEGIN(8)
            rms_rows<1>(nullptr, nullptr, X, a.in[19] + l * 2048, SLOT1, bx, G);
        PH_END
        PH_BEGIN(9)
            { pg8::Sched S{(const char*)SLOT1, (const char*)WGU, 0, 0, 2048, 2048, T / 256, 44, 1, G, bx, 0, 4}; EpiSwi E{HID}; pg8::gemm_phase(lds, S, 2048, E); }
        PH_END
        PH_BEGIN(10)
            { pg8::Sched S{(const char*)HID, (const char*)WDOWN, 0, 0, DFF, DFF, T / 256, 8, 1, G, bx, 0, 4}; EpiRes E{X, X, X}; pg8::gemm_phase(lds, S, DFF, E); }
        PH_END
    }
    PH_BEGIN(11)
        rms_rows<2>(nullptr, nullptr, X, a.in[23], nullptr, bx, G);
    PH_END
#undef PH_BEGIN
#undef PH_END
}

extern "C" void kernel_launch(void* const* d_in, const int* in_sizes, int n_in, void* d_out, int out_size, void* d_ws, size_t ws_size, hipStream_t stream) {
    static int grid = 0;
    if (grid == 0) {
        if (n_in != 24 || out_size != T * DM || ws_size < WS_END) { fprintf(stderr, "kernel_launch: unexpected shapes / workspace (n_in %d out %d ws %zu need %zu)\n", n_in, out_size, ws_size, (size_t)WS_END); grid = -1; return; }
        int dev = 0, cus = 0, per_cu = 0;
        if (hipGetDevice(&dev) != hipSuccess || hipDeviceGetAttribute(&cus, hipDeviceAttributeMultiprocessorCount, dev) != hipSuccess) { grid = -1; return; }
        if (hipFuncSetAttribute((const void*)mega_fwd, hipFuncAttributeMaxDynamicSharedMemorySize, LDS_BYTES) != hipSuccess) { fprintf(stderr, "kernel_launch: hipFuncSetAttribute failed\n"); grid = -1; return; }
        if (hipOccupancyMaxActiveBlocksPerMultiprocessor(&per_cu, (const void*)mega_fwd, NTHREADS, LDS_BYTES) != hipSuccess || per_cu < 1) { fprintf(stderr, "kernel_launch: occupancy query says %d\n", per_cu); per_cu = 1; }
        (void)hipGetLastError();
        grid = cus * 1;
    }
    if (grid < 0) return;
    if (hipMemsetAsync((char*)d_ws + WS_CTL, 0, 16384, stream) != hipSuccess) { fprintf(stderr, "kernel_launch: memset of the barrier word failed\n"); return; }
    Args a{};
    for (int i = 0; i < 24; ++i) a.in[i] = (const float*)d_in[i];
    a.out = (float*)d_out; a.ws = (unsigned char*)d_ws;
#if MK_ONE_LAUNCH
    a.ph_lo = 0; a.ph_hi = N_PHASES;
    void* args[] = {&a};
    hipError_t e = hipLaunchCooperativeKernel((const void*)mega_fwd, dim3(grid), dim3(NTHREADS), args, LDS_BYTES, stream);
    if (e != hipSuccess) fprintf(stderr, "cooperative launch failed: %s (grid %d)\n", hipGetErrorString(e), grid);
#else
    for (int p = 0; p < N_PHASES; ++p) {
        a.ph_lo = p; a.ph_hi = p + 1;
        hipLaunchKernelGGL(mega_fwd, dim3(grid), dim3(NTHREADS), LDS_BYTES, stream, a);
    }
#endif
}
```

```cpp
#include <hip/hip_runtime.h>
#include <hip/hip_cooperative_groups.h>
#include <cstdio>
#include <cstdint>
namespace cg = cooperative_groups;

#ifndef MK_ONE_LAUNCH
#define MK_ONE_LAUNCH 1
#endif

#define LAS __attribute__((address_space(3)))
typedef unsigned short bf16_t;
typedef short bf16x8 __attribute__((ext_vector_type(8)));
typedef float f32x4 __attribute__((ext_vector_type(4)));
typedef float f32x2 __attribute__((ext_vector_type(2)));
typedef unsigned u32x4 __attribute__((ext_vector_type(4)));
typedef unsigned u32x2 __attribute__((ext_vector_type(2)));

constexpr int T = 24576, DM = 2048, NBATCH = 6, SEQ = 4096, DFF = 5632, INW = 2816;
constexpr int NGRP = 48, NCHUNK = T / 32;
constexpr float EPS = 1e-6f;
constexpr int NTHREADS = 512;
constexpr int LDS_BYTES = 131072 + 1024;

constexpr size_t WS_WINAC = 0;
constexpr size_t WS_WINBF = WS_WINAC + (size_t)2304 * 2048 * 2;
constexpr size_t WS_WOUT  = WS_WINBF + (size_t)1024 * 2048 * 2;
constexpr size_t WS_WGLU  = WS_WOUT + (size_t)2048 * 2048 * 2;
constexpr size_t WS_WS    = WS_WGLU + (size_t)768 * 768 * 2;
constexpr size_t WS_WGU   = WS_WS + (size_t)6 * 128 * 128 * 2;
constexpr size_t WS_WDOWN = WS_WGU + (size_t)11264 * 2048 * 2;
constexpr size_t WS_DFT   = WS_WDOWN + (size_t)2048 * 5632 * 2;
constexpr size_t WS_VT    = WS_DFT;
constexpr size_t WS_D256  = WS_DFT + (size_t)49152 * 512 * 2;
constexpr size_t WS_AL    = WS_DFT + (size_t)4096 * 8192 * 2;
constexpr size_t WS_APW   = WS_AL + (size_t)48 * 2 * 64 * 2 * 4;
constexpr size_t WS_KT    = WS_APW + (size_t)48 * 2 * 33 * 64 * 2 * 4;
constexpr size_t WS_SLOT1 = WS_KT + (size_t)48 * 2 * 32 * 256 * 4;
constexpr size_t WS_ACT   = WS_SLOT1 + (size_t)T * 2048 * 2;
constexpr size_t WS_ZINA  = WS_ACT;
constexpr size_t WS_ZFT   = WS_ZINA + (size_t)T * 1536 * 2;
constexpr size_t WS_YCPRE = WS_ZFT;
constexpr size_t WS_UCAT  = WS_ZFT + (size_t)512 * 49152 * 2;
constexpr size_t WS_XS    = WS_UCAT + (size_t)48 * 768 * 768 * 2;
constexpr size_t WS_TE    = WS_XS + (size_t)48 * 768 * 256 * 4;
constexpr size_t WS_GM    = WS_TE + (size_t)48 * 512 * 768 * 2;
constexpr size_t WS_MIXEND = WS_GM + (size_t)48 * 256 * 512 * 2;
constexpr size_t WS_HID   = WS_ACT;
constexpr size_t WS_CTL   = WS_ACT + (size_t)T * 5632 * 2;
constexpr size_t WS_END   = WS_CTL + 16384;
static_assert(WS_MIXEND <= WS_CTL, "mixer buffers must fit under the FFN hidden buffer");

struct Args { const float* in[24]; float* out; unsigned char* ws; int ph_lo, ph_hi; };

__device__ __forceinline__ int tid_l() { int t = threadIdx.x; asm volatile("" : "+v"(t)); return t; }
__device__ __forceinline__ unsigned cvt_pk_bf16(float lo, float hi) { unsigned r; asm("v_cvt_pk_bf16_f32 %0, %1, %2" : "=v"(r) : "v"(lo), "v"(hi)); return r; }
__device__ __forceinline__ float bf_lo(unsigned w) { return __uint_as_float(w << 16); }
__device__ __forceinline__ float bf_hi(unsigned w) { return __uint_as_float(w & 0xffff0000u); }
__device__ __forceinline__ bf16_t f2bf(float f) { return (bf16_t)(cvt_pk_bf16(f, 0.f) & 0xffffu); }
__device__ __forceinline__ float sigmoid_f(float v) { return __builtin_amdgcn_rcpf(1.0f + __builtin_amdgcn_exp2f(-1.4426950409f * v)); }
__device__ __forceinline__ float gelu_tanh(float x) { const float z = x * (1.5957691216f + 0.0713548163f * x * x); return x * sigmoid_f(z); }
__device__ __forceinline__ float wave_sum(float v) {
#pragma unroll
    for (int o = 32; o >= 1; o >>= 1) v += __shfl_xor(v, o);
    return v;
}

namespace pg8 {
constexpr int BM = 256, BK = 64, HALF = 128, HTB = HALF * BK * 2, STAGE_BYTES = 8 * HTB, NXCD = 8, WGM = 8;
__device__ __forceinline__ int lds_byte(int r, int c) { const int st = (r >> 4) * 2 + (c >> 5), rr = r & 15, cc = c & 31, ob = rr * 64 + cc * 2; return st * 1024 + (ob ^ (((ob >> 9) & 1) << 5)); }
__device__ __forceinline__ void stage_rc(int b, int& R, int& C) { const int st = b / 1024, sb = b % 1024, swz = sb ^ (((sb >> 9) & 1) << 5); R = (st >> 1) * 16 + swz / 64; C = (st & 1) * 32 + (swz % 64) / 2; }
__device__ __forceinline__ int perm32(int rho) { const int n = rho >> 4, i = rho & 15; return 8 * (i >> 2) + 4 * n + (i & 3); }

struct Unit { const char* A; const char* B; int pm, pn, grp; };
struct Sched {
    const char* A; const char* B; long gsA, gsB; int lda, ldb, nM, nN, nG, G, c, bmap, wgm;
    __device__ __forceinline__ bool next(int i, Unit& u) const {
        const int nwg = nM * nN;
        const long L = (long)i * G + c; if (c < 0 || L >= (long)nwg * nG) return false;
        const int grp = (int)(L / nwg); int wgid = (int)(L - (long)grp * nwg);
        { const int q = nwg / NXCD, r = nwg % NXCD, xcd = wgid % NXCD, off = wgid / NXCD; wgid = (xcd < r ? xcd * (q + 1) : r * (q + 1) + (xcd - r) * q) + off; }
        const int nig = wgm * nN, gid = wgid / nig, fm = gid * wgm, gsz = (nM - fm) < wgm ? (nM - fm) : wgm;
        u.pm = fm + ((wgid % nig) % gsz); u.pn = (wgid % nig) / gsz; u.grp = grp;
        u.A = A + (size_t)grp * gsA + (size_t)u.pm * 512 * lda; u.B = B + (size_t)grp * gsB + (bmap ? (size_t)((u.pn >> 4) * 4096 + (u.pn & 15) * 16) * 2 * ldb : (size_t)u.pn * 512 * ldb);
        return true;
    }
};

template <class Epi>
__device__ __forceinline__ void gemm_phase(LAS unsigned char* lds, const Sched& S, const int K, const Epi& E) {
    int tid = threadIdx.x; asm volatile("" : "+v"(tid));
    const int wid = __builtin_amdgcn_readfirstlane(tid >> 6), lane = tid & 63, wr = wid >> 2, wc = wid & 3, fr = lane & 15, fq = lane >> 4;
    const int nt = K / BK;
    unsigned voffA[2], voffB[2];
#pragma unroll
    for (int i = 0; i < 2; ++i) { int R, C; stage_rc(tid * 16 + i * 8192, R, C); const int Rb = Epi::PERM ? ((R & ~31) + perm32(R & 31)) : R;
        const int RbT = Epi::BMAP ? ((Rb >> 4) + 256 * (Rb & 15)) : Rb;
        voffA[i] = (unsigned)(R * S.lda + C) * 2u; voffB[i] = (unsigned)(RbT * S.ldb + C) * 2u; }
    const size_t kstep = (size_t)(BK * 2);
    const size_t hstepA = (size_t)HALF * S.lda * 2, hstepB = (size_t)(Epi::BMAP ? 8 : HALF) * S.ldb * 2;
    const unsigned ldsw = (unsigned)wid * 1024u;
    const int aoff = lds_byte(wr * 64 + fr, fq * 8), boff = lds_byte(wc * 32 + fr, fq * 8);
#define PG8_SA(b, h) (((b) * 2 + (h)) * HTB)
#define PG8_SB(b, h) ((4 + (b) * 2 + (h)) * HTB)
#define PG8_STAGE(bufoff, gbase, voff) do { _Pragma("unroll") for (int _i = 0; _i < 2; ++_i) \
        __builtin_amdgcn_global_load_lds((const unsigned*)((const char*)(gbase) + (voff)[_i]), (LAS unsigned*)(lds + (bufoff) + ldsw + _i * 8192), 16, 0, 0); } while (0)
#define PG8_LDA(dst, b, h) do { _Pragma("unroll") for (int m = 0; m < 4; ++m) _Pragma("unroll") for (int k = 0; k < 2; ++k) dst[m][k] = *(const LAS bf16x8*)(lds + PG8_SA(b, h) + aoff + m * 2048 + k * 1024); } while (0)
#define PG8_LDB(dst, b, h) do { _Pragma("unroll") for (int n = 0; n < 2; ++n) _Pragma("unroll") for (int k = 0; k < 2; ++k) dst[n][k] = *(const LAS bf16x8*)(lds + PG8_SB(b, h) + boff + n * 2048 + k * 1024); } while (0)
#define PG8_MMA(ai, bj, At, Bt) do { __builtin_amdgcn_s_setprio(1); _Pragma("unroll") for (int m = 0; m < 4; ++m) _Pragma("unroll") for (int n = 0; n < 2; ++n) _Pragma("unroll") for (int k = 0; k < 2; ++k) \
        acc[ai][bj][m][n] = __builtin_amdgcn_mfma_f32_16x16x32_bf16(Bt[n][k], At[m][k], acc[ai][bj][m][n], 0, 0, 0); __builtin_amdgcn_s_setprio(0); } while (0)
#define PG8_WAIT_V(n) asm volatile("s_waitcnt vmcnt(" #n ")" ::: "memory")
#define PG8_WAIT_L(n) asm volatile("s_waitcnt lgkmcnt(" #n ")" ::: "memory")
#define PG8_BAR __builtin_amdgcn_s_barrier()
#define PG8_SCHED __builtin_amdgcn_sched_barrier(0)
    Unit cur, nxt; int ui = 0;
    if (!S.next(0, cur)) return;
    f32x4 acc[2][2][4][2];
#pragma unroll
    for (int a = 0; a < 2; ++a)
#pragma unroll
        for (int b = 0; b < 2; ++b)
#pragma unroll
            for (int m = 0; m < 4; ++m)
#pragma unroll
                for (int n = 0; n < 2; ++n) acc[a][b][m][n] = (f32x4){0.f, 0.f, 0.f, 0.f};
    bf16x8 At[4][2], B0[2][2], B1[2][2];
    const char* cA = cur.A; const char* cB = cur.B;
    PG8_STAGE(PG8_SB(0, 0), cB, voffB); PG8_STAGE(PG8_SB(0, 1), cB + hstepB, voffB); PG8_STAGE(PG8_SA(0, 0), cA, voffA); PG8_STAGE(PG8_SA(0, 1), cA + hstepA, voffA);
    if (wr == 1) PG8_BAR;
    PG8_WAIT_V(2); PG8_BAR;
    PG8_STAGE(PG8_SB(1, 0), cB + kstep, voffB); PG8_STAGE(PG8_SA(1, 0), cA + kstep, voffA); PG8_STAGE(PG8_SB(1, 1), cB + hstepB + kstep, voffB);
    PG8_WAIT_V(6); PG8_BAR;
    for (;;) {
        const bool has_next = S.next(ui + 1, nxt);
        const char* nA = has_next ? nxt.A : cA; const char* nB = has_next ? nxt.B : cB;
        for (int t = 0; t < nt; t += 2) {
            const bool last = (t == nt - 2);
            const char* a1 = cA + (size_t)(t + 1) * kstep;
            const char* a2 = last ? nA : cA + (size_t)(t + 2) * kstep; const char* b2 = last ? nB : cB + (size_t)(t + 2) * kstep;
            const char* a3 = a2 + kstep; const char* b3 = b2 + kstep;
            PG8_LDB(B0, 0, 0); PG8_LDB(B1, 0, 1); PG8_SCHED; PG8_LDA(At, 0, 0); PG8_STAGE(PG8_SA(1, 1), a1 + hstepA, voffA);
            PG8_WAIT_V(8); PG8_WAIT_L(0); PG8_BAR; PG8_MMA(0, 0, At, B0); PG8_MMA(0, 1, At, B1); PG8_BAR; PG8_SCHED;
            PG8_LDA(At, 0, 1); PG8_STAGE(PG8_SB(0, 0), b2, voffB); PG8_STAGE(PG8_SB(0, 1), b2 + hstepB, voffB); PG8_STAGE(PG8_SA(0, 0), a2, voffA);
            PG8_WAIT_V(8); PG8_WAIT_L(0); PG8_BAR; PG8_MMA(1, 0, At, B0); PG8_MMA(1, 1, At, B1); PG8_BAR; PG8_SCHED;
            PG8_LDB(B0, 1, 0); PG8_LDB(B1, 1, 1); PG8_SCHED; PG8_LDA(At, 1, 0); PG8_STAGE(PG8_SA(0, 1), a2 + hstepA, voffA);
            PG8_WAIT_V(8); PG8_WAIT_L(0); PG8_BAR; PG8_MMA(0, 0, At, B0); PG8_MMA(0, 1, At, B1); PG8_BAR; PG8_SCHED;
            PG8_LDA(At, 1, 1); PG8_STAGE(PG8_SB(1, 0), b3, voffB); PG8_STAGE(PG8_SB(1, 1), b3 + hstepB, voffB); PG8_STAGE(PG8_SA(1, 0), a3, voffA);
            PG8_WAIT_V(8); PG8_WAIT_L(0); PG8_BAR; PG8_MMA(1, 0, At, B0); PG8_MMA(1, 1, At, B1); PG8_BAR; PG8_SCHED;
        }
        if (wr == 0) PG8_BAR;
        E(acc, cur, wr, wc, fr, fq);
        if (!has_next) break;
#pragma unroll
        for (int a = 0; a < 2; ++a)
#pragma unroll
            for (int b = 0; b < 2; ++b)
#pragma unroll
                for (int m = 0; m < 4; ++m)
#pragma unroll
                    for (int n = 0; n < 2; ++n) acc[a][b][m][n] = (f32x4){0.f, 0.f, 0.f, 0.f};
        cur = nxt; cA = nA; cB = nB; ++ui;
        if (wr == 1) PG8_BAR;
    }
    PG8_WAIT_V(0);
    PG8_BAR;
#undef PG8_SA
#undef PG8_SB
#undef PG8_STAGE
#undef PG8_LDA
#undef PG8_LDB
#undef PG8_MMA
#undef PG8_WAIT_V
#undef PG8_WAIT_L
#undef PG8_BAR
#undef PG8_SCHED
}
}
using pg8::Unit;
typedef const f32x4 (&AccRef)[2][2][4][2];

__device__ __forceinline__ u32x4 pack8(f32x4 v0, f32x4 v1) { u32x4 w; w.x = cvt_pk_bf16(v0[0], v0[1]); w.y = cvt_pk_bf16(v0[2], v0[3]); w.z = cvt_pk_bf16(v1[0], v1[1]); w.w = cvt_pk_bf16(v1[2], v1[3]); return w; }
__device__ __forceinline__ f32x4 gelu4(f32x4 v) { return (f32x4){gelu_tanh(v[0]), gelu_tanh(v[1]), gelu_tanh(v[2]), gelu_tanh(v[3])}; }

struct EpiWin { static constexpr bool PERM = true; static constexpr int BMAP = 0; bf16_t* zina; bf16_t* ucat;
    __device__ __forceinline__ void operator()(AccRef acc, const Unit& u, int wr, int wc, int fr, int fq) const {
        const int row0 = u.pm * 256 + wr * 64 + fr;
        if (u.pn < 6) {
            const int col0 = u.pn * 256 + wc * 32 + 8 * fq;
#pragma unroll
            for (int ai = 0; ai < 2; ++ai)
#pragma unroll
                for (int m = 0; m < 4; ++m) { bf16_t* rowp = zina + (size_t)(row0 + ai * 128 + m * 16) * 1536 + col0;
#pragma unroll
                    for (int bj = 0; bj < 2; ++bj) *(u32x4*)(rowp + bj * 128) = pack8(gelu4(acc[ai][bj][m][0]), gelu4(acc[ai][bj][m][1])); }
        } else {
            const int cc0 = (u.pn - 6) * 256 + wc * 32 + 8 * fq;
#pragma unroll
            for (int ai = 0; ai < 2; ++ai)
#pragma unroll
                for (int m = 0; m < 4; ++m) { const int t = row0 + ai * 128 + m * 16, n = t >> 5, j = t & 31;
#pragma unroll
                    for (int bj = 0; bj < 2; ++bj) { const int cc = cc0 + bj * 128, g = cc >> 4, c0 = cc & 15;
                        *(u32x4*)(ucat + ((size_t)(g * 768 + n) * 768 + j * 16 + c0)) = pack8(acc[ai][bj][m][0], acc[ai][bj][m][1]); } }
        }
    } };
struct EpiZft2 { static constexpr bool PERM = true; static constexpr int BMAP = 1; bf16_t* zf2;
    __device__ __forceinline__ void operator()(AccRef acc, const Unit& u, int wr, int wc, int fr, int fq) const {
        const int row0 = u.pm * 256 + wr * 64 + fr, b = u.pn >> 4, n1b = (u.pn & 15) * 16 + 2 * wc + (fq >> 1), n20 = (fq & 1) * 8;
#pragma unroll
        for (int ai = 0; ai < 2; ++ai)
#pragma unroll
            for (int m = 0; m < 4; ++m) { const int r = row0 + ai * 128 + m * 16, ri = r >> 9, gc = r & 511;
#pragma unroll
                for (int bj = 0; bj < 2; ++bj) { const int n1 = n1b + 8 * bj;
                    *(u32x4*)(zf2 + ((((size_t)b * 512 + gc) * 256 + n1) * 32 + ri * 16 + n20)) = pack8(acc[ai][bj][m][0], acc[ai][bj][m][1]); } }
    } };
struct EpiFour2 { static constexpr bool PERM = true; static constexpr int BMAP = 0; bf16_t* y;
    __device__ __forceinline__ void operator()(AccRef acc, const Unit& u, int wr, int wc, int fr, int fq) const {
        const int bk = u.pn >> 1, b = bk >> 4, k2 = bk & 15, col0 = 768 + (u.pn & 1) * 256 + wc * 32 + 8 * fq, k10 = wr * 64 + fr;
#pragma unroll
        for (int ai = 0; ai < 2; ++ai)
#pragma unroll
            for (int m = 0; m < 4; ++m) { const int k1 = k10 + ai * 128 + m * 16; bf16_t* rowp = y + (size_t)(b * 4096 + 16 * k1 + k2) * 2048 + col0;
#pragma unroll
                for (int bj = 0; bj < 2; ++bj) *(u32x4*)(rowp + bj * 128) = pack8(acc[ai][bj][m][0], acc[ai][bj][m][1]); }
    } };
struct EpiXs { static constexpr bool PERM = false; static constexpr int BMAP = 0; float* xs;
    __device__ __forceinline__ void operator()(AccRef acc, const Unit& u, int wr, int wc, int fr, int fq) const {
        const int row0 = u.pm * 256 + wr * 64 + fr, col0 = wc * 32 + 4 * fq;
#pragma unroll
        for (int ai = 0; ai < 2; ++ai)
#pragma unroll
            for (int m = 0; m < 4; ++m) { float* rowp = xs + ((size_t)u.grp * 768 + row0 + ai * 128 + m * 16) * 256 + col0;
#pragma unroll
                for (int bj = 0; bj < 2; ++bj)
#pragma unroll
                    for (int n = 0; n < 2; ++n) *(f32x4*)(rowp + bj * 128 + n * 16) = acc[ai][bj][m][n]; }
    } };
struct EpiYc { static constexpr bool PERM = true; static constexpr int BMAP = 0; bf16_t* ycpre;
    __device__ __forceinline__ void operator()(AccRef acc, const Unit& u, int wr, int wc, int fr, int fq) const {
        const int row0 = u.pm * 256 + wr * 64 + fr, col0 = u.pn * 256 + wc * 32 + 8 * fq;
#pragma unroll
        for (int ai = 0; ai < 2; ++ai)
#pragma unroll
            for (int m = 0; m < 4; ++m) { const int n = row0 + ai * 128 + m * 16;
#pragma unroll
                for (int bj = 0; bj < 2; ++bj) { const int col = col0 + bj * 128, i = col >> 4, c0 = col & 15;
                    *(u32x4*)(ycpre + ((size_t)(n * 32 + i) * 768 + u.grp * 16 + c0)) = pack8(gelu4(acc[ai][bj][m][0]), gelu4(acc[ai][bj][m][1])); } }
    } };
struct EpiGlu { static constexpr bool PERM = true; static constexpr int BMAP = 0; const bf16_t* ycpre; const float* bias; bf16_t* y;
    __device__ __forceinline__ void operator()(AccRef acc, const Unit& u, int wr, int wc, int fr, int fq) const {
        const int row0 = u.pm * 256 + wr * 64 + fr, col0 = u.pn * 256 + wc * 32 + 8 * fq;
        f32x4 bv[2][2];
#pragma unroll
        for (int bj = 0; bj < 2; ++bj)
#pragma unroll
            for (int n = 0; n < 2; ++n) bv[bj][n] = *(const f32x4*)(bias + col0 + bj * 128 + 4 * n);
#pragma unroll
        for (int ai = 0; ai < 2; ++ai) {
            u32x4 yc[4][2];
#pragma unroll
            for (int m = 0; m < 4; ++m)
#pragma unroll
                for (int bj = 0; bj < 2; ++bj) yc[m][bj] = *(const u32x4*)(ycpre + (size_t)(row0 + ai * 128 + m * 16) * 768 + col0 + bj * 128);
#pragma unroll
            for (int m = 0; m < 4; ++m) { const size_t t = (size_t)(row0 + ai * 128 + m * 16);
#pragma unroll
                for (int bj = 0; bj < 2; ++bj) { const int col = col0 + bj * 128; const u32x4 w = yc[m][bj];
                    const f32x4 v0 = acc[ai][bj][m][0] + bv[bj][0], v1 = acc[ai][bj][m][1] + bv[bj][1];
                    const f32x4 o0 = (f32x4){bf_lo(w.x) * sigmoid_f(v0[0]), bf_hi(w.x) * sigmoid_f(v0[1]), bf_lo(w.y) * sigmoid_f(v0[2]), bf_hi(w.y) * sigmoid_f(v0[3])};
                    const f32x4 o1 = (f32x4){bf_lo(w.z) * sigmoid_f(v1[0]), bf_hi(w.z) * sigmoid_f(v1[1]), bf_lo(w.w) * sigmoid_f(v1[2]), bf_hi(w.w) * sigmoid_f(v1[3])};
                    *(u32x4*)(y + t * 2048 + 1280 + col) = pack8(o0, o1); } }
            asm volatile("" ::: "memory"); }
    } };
struct EpiRes { static constexpr bool PERM = false; static constexpr int BMAP = 0; float* x; const float* r0; const float* r1adj;
    __device__ __forceinline__ void operator()(AccRef acc, const Unit& u, int wr, int wc, int fr, int fq) const {
        const int row0 = u.pm * 256 + wr * 64 + fr, col0 = u.pn * 256 + wc * 32 + 4 * fq;
        const float* sb = u.pm < 64 ? r0 : r1adj;
#pragma unroll
        for (int ai = 0; ai < 2; ++ai) {
            const size_t off = (size_t)(row0 + ai * 128) * 2048 + col0;
            f32x4 ld[4][2][2];
#pragma unroll
            for (int m = 0; m < 4; ++m)
#pragma unroll
                for (int bj = 0; bj < 2; ++bj)
#pragma unroll
                    for (int n = 0; n < 2; ++n) ld[m][bj][n] = *(const f32x4*)(sb + off + (size_t)m * 16 * 2048 + bj * 128 + n * 16);
#pragma unroll
            for (int m = 0; m < 4; ++m)
#pragma unroll
                for (int bj = 0; bj < 2; ++bj)
#pragma unroll
                    for (int n = 0; n < 2; ++n) *(f32x4*)(x + off + (size_t)m * 16 * 2048 + bj * 128 + n * 16) = ld[m][bj][n] + acc[ai][bj][m][n];
            asm volatile("" ::: "memory"); }
    } };
struct EpiSwi { static constexpr bool PERM = true; static constexpr int BMAP = 0; bf16_t* hid;
    __device__ __forceinline__ void operator()(AccRef acc, const Unit& u, int wr, int wc, int fr, int fq) const {
        const int row0 = u.pm * 256 + wr * 64 + fr, col0 = u.pn * 128 + wc * 32 + 8 * fq;
#pragma unroll
        for (int ai = 0; ai < 2; ++ai)
#pragma unroll
            for (int m = 0; m < 4; ++m) {
                f32x4 o[2];
#pragma unroll
                for (int n = 0; n < 2; ++n) { const f32x4 g = acc[ai][0][m][n], up = acc[ai][1][m][n];
                    o[n] = (f32x4){g[0] * sigmoid_f(g[0]) * up[0], g[1] * sigmoid_f(g[1]) * up[1], g[2] * sigmoid_f(g[2]) * up[2], g[3] * sigmoid_f(g[3]) * up[3]}; }
                *(u32x4*)(hid + (size_t)(row0 + ai * 128 + m * 16) * 5632 + col0) = pack8(o[0], o[1]); }
    } };

struct TrDesc { const float* src; int ldsrc, K, c0, nc; bf16_t* dst; int mode, doff; };
template <class SEL, class CTX>
__device__ __forceinline__ void transpose_run(LAS unsigned char* lds, const CTX& ctx, int t0, int t1, int stride) {
    const int tid = tid_l();
    LAS unsigned* tl = (LAS unsigned*)lds;
    const int k = tid >> 3, n8 = (tid & 7) * 8;
    f32x4 v[4][2];
    TrDesc d; int lt;
    if (t0 < t1) { SEL::get(ctx, t0, d, lt); const int nkt = d.K >> 6, kt = lt % nkt, ct = lt / nkt;
        const float* s = d.src + (size_t)(kt * 64 + k) * d.ldsrc + d.c0 + ct * 256 + n8;
#pragma unroll
        for (int q = 0; q < 4; ++q) { v[q][0] = *(const f32x4*)(s + q * 64); v[q][1] = *(const f32x4*)(s + q * 64 + 4); } }
    for (int t = t0; t < t1; t += stride) {
        SEL::get(ctx, t, d, lt);
        const int nkt = d.K >> 6, kt = lt % nkt, ct = lt / nkt;
        unsigned w[4][4];
#pragma unroll
        for (int q = 0; q < 4; ++q)
#pragma unroll
            for (int j = 0; j < 4; ++j) { const float lo = v[q][0][j], hi = v[q][1][j];
                const float recv = __shfl_xor((k & 1) ? lo : hi, 8);
                w[q][j] = (k & 1) ? cvt_pk_bf16(recv, hi) : cvt_pk_bf16(lo, recv); }
        if (t + stride < t1) { TrDesc dn; int ltn; SEL::get(ctx, t + stride, dn, ltn); const int nktn = dn.K >> 6, ktn = ltn % nktn, ctn = ltn / nktn;
            const float* s = dn.src + (size_t)(ktn * 64 + k) * dn.ldsrc + dn.c0 + ctn * 256 + n8;
#pragma unroll
            for (int q = 0; q < 4; ++q) { v[q][0] = *(const f32x4*)(s + q * 64); v[q][1] = *(const f32x4*)(s + q * 64 + 4); } }
#pragma unroll
        for (int q = 0; q < 4; ++q)
#pragma unroll
            for (int j = 0; j < 4; ++j) tl[(q * 64 + n8 + j + ((k & 1) ? 4 : 0)) * 33 + (k >> 1)] = w[q][j];
        __syncthreads();
        { const int n = tid >> 3, k8 = (tid & 7) * 8;
#pragma unroll
          for (int q = 0; q < 4; ++q) {
              const LAS unsigned* p = tl + (q * 64 + n) * 33 + (k8 >> 1);
              u32x4 ww; ww.x = p[0]; ww.y = p[1]; ww.z = p[2]; ww.w = p[3];
              const int cc = ct * 256 + q * 64 + n;
              const int drow = d.mode == 0 ? d.doff + cc : ((cc >> 7) * 256 + (cc & 127) + (d.mode == 2 ? 128 : 0));
              *(u32x4*)(d.dst + (size_t)drow * d.K + kt * 64 + k8) = ww; } }
        __syncthreads();
    }
}
struct SelOne { static __device__ __forceinline__ void get(const TrDesc& c, int t, TrDesc& d, int& lt) { d = c; lt = t; } };
struct FfnCtx { const float* wg; const float* wu; const float* wd; bf16_t* wgu; bf16_t* wdown; };
struct SelFfn { static __device__ __forceinline__ void get(const FfnCtx& c, int t, TrDesc& d, int& lt) {
    if (t < 704)       { d = TrDesc{c.wg, DFF, 2048, 0, DFF, c.wgu, 1, 0}; lt = t; }
    else if (t < 1408) { d = TrDesc{c.wu, DFF, 2048, 0, DFF, c.wgu, 2, 0}; lt = t - 704; }
    else               { d = TrDesc{c.wd, 2048, DFF, 0, 2048, c.wdown, 0, 0}; lt = t - 1408; } } };

__device__ __forceinline__ double kd(double c) { asm volatile("" : "+v"(c)); return c; }
__device__ __forceinline__ double exp_d(double x) {
    const double y = x * 0.125; double term = 1.0, sum = 1.0;
#pragma unroll 1
    for (int n = 1; n <= 22; ++n) { term *= y / (double)n; sum += term; }
    sum *= sum; sum *= sum; sum *= sum; return sum;
}
__device__ __forceinline__ void sincos_d(double x, double& s, double& c) {
    const double k = rint(x * kd(0.15915494309189535));
    double r = fma(-k, kd(6.283185307179586232), x); r = fma(-k, kd(2.4492935982947064e-16), r);
    const double y = r * 0.125, my2 = -(y * y);
    double sn = y, cs = 1.0, ts = y, tc = 1.0;
#pragma unroll 1
    for (int n = 1; n <= 10; ++n) { tc *= my2 / (double)((2 * n - 1) * (2 * n)); cs += tc; ts *= my2 / (double)((2 * n) * (2 * n + 1)); sn += ts; }
#pragma unroll 1
    for (int i = 0; i < 3; ++i) { const double c2 = cs * cs - sn * sn, s2 = 2.0 * sn * cs; cs = c2; sn = s2; }
    s = sn; c = cs;
}

__device__ __forceinline__ void s5_disc(const Args& a, int l, int g, int dir, int p, double& ar, double& ai, double& qr, double& qi) {
    const double lr = (double)a.in[7][((l * 2 + dir) * 48 + g) * 64 + p], li = (double)a.in[8][((l * 2 + dir) * 48 + g) * 64 + p];
    const double st = exp_d((double)a.in[9][(l * 2 + dir) * 48 + g]);
    const double mag = exp_d(lr * st); double sn, cs; sincos_d(li * st, sn, cs);
    ar = mag * cs; ai = mag * sn; const double den = lr * lr + li * li, nr = ar - 1.0;
    qr = (nr * lr + ai * li) / den; qi = (ai * lr - nr * li) / den;
}
__device__ __forceinline__ void s5_group_a(LAS unsigned char* lds, const Args& a, int l, int g) {
    const int tid = tid_l();
    LAS float* apw = (LAS float*)lds;
    LAS float* bbr = apw + 2 * 33 * 64 * 2;
    bf16_t* GMp = (bf16_t*)(a.ws + WS_GM); float* ALp = (float*)(a.ws + WS_AL); float* APWp = (float*)(a.ws + WS_APW);
    if (tid < 128) {
        const int dir = tid >> 6, p = tid & 63;
        double ar, ai, qr, qi; s5_disc(a, l, g, dir, p, ar, ai, qr, qi);
        double pr = 1.0, pi = 0.0;
#pragma unroll 1
        for (int tau = 0; tau <= 32; ++tau) { const float fr_ = (float)pr, fi_ = (float)pi;
            apw[((dir * 33 + tau) * 64 + p) * 2] = fr_; apw[((dir * 33 + tau) * 64 + p) * 2 + 1] = fi_;
            *(f32x2*)(APWp + ((size_t)((g * 2 + dir) * 33 + tau) * 64 + p) * 2) = (f32x2){fr_, fi_};
            const double nr2 = pr * ar - pi * ai, ni2 = pr * ai + pi * ar; pr = nr2; pi = ni2; }
        ALp[((g * 2 + dir) * 64 + p) * 2] = apw[((dir * 33 + 32) * 64 + p) * 2]; ALp[((g * 2 + dir) * 64 + p) * 2 + 1] = apw[((dir * 33 + 32) * 64 + p) * 2 + 1];
#pragma unroll 1
        for (int c = 0; c < 16; ++c) { const double br = (double)a.in[10][((l * 48 + g) * 64 + p) * 16 + c], bi = (double)a.in[11][((l * 48 + g) * 64 + p) * 16 + c];
            bbr[((dir * 64 + p) * 16 + c) * 2] = (float)(qr * br - qi * bi); bbr[((dir * 64 + p) * 16 + c) * 2 + 1] = (float)(qr * bi + qi * br); }
    }
    __syncthreads();
    {
        const int row = tid >> 1, half = tid & 1, dir = row >> 7, p = (row >> 1) & 63, ri = row & 1;
        bf16_t* rowp = GMp + ((size_t)g * 256 + row) * 512;
        for (int jj = 0; jj < 16; ++jj) { const int j = half * 16 + jj, e = dir == 0 ? 31 - j : j;
            const float wr_ = apw[((dir * 33 + e) * 64 + p) * 2], wi_ = apw[((dir * 33 + e) * 64 + p) * 2 + 1];
            float v[16];
#pragma unroll
            for (int c2 = 0; c2 < 16; ++c2) { const float Br = bbr[((dir * 64 + p) * 16 + c2) * 2], Bi = bbr[((dir * 64 + p) * 16 + c2) * 2 + 1];
                v[c2] = ri == 0 ? wr_ * Br - wi_ * Bi : wr_ * Bi + wi_ * Br; }
            u32x4 w0, w1; w0.x = cvt_pk_bf16(v[0], v[1]); w0.y = cvt_pk_bf16(v[2], v[3]); w0.z = cvt_pk_bf16(v[4], v[5]); w0.w = cvt_pk_bf16(v[6], v[7]);
            w1.x = cvt_pk_bf16(v[8], v[9]); w1.y = cvt_pk_bf16(v[10], v[11]); w1.z = cvt_pk_bf16(v[12], v[13]); w1.w = cvt_pk_bf16(v[14], v[15]);
            *(u32x4*)(rowp + j * 16) = w0; *(u32x4*)(rowp + j * 16 + 8) = w1; }
    }
    __syncthreads();
}
__device__ __forceinline__ void s5_ktab(LAS unsigned char* lds, const Args& a, int l, int task) {
    const int tid = tid_l(), g = task >> 3, dir = (task >> 2) & 1, tb = task & 3;
    LAS float* ap8 = (LAS float*)lds;
    LAS float* bbr = ap8 + 8 * 64 * 2;
    LAS float* ccx = bbr + 64 * 16 * 2;
    LAS float* cw  = ccx + 16 * 64 * 2;
    float* KTp = (float*)(a.ws + WS_KT);
    if (tid < 64) {
        const int p = tid; double ar, ai, qr, qi; s5_disc(a, l, g, dir, p, ar, ai, qr, qi);
        double pr = 1.0, pi = 0.0;
#pragma unroll 1
        for (int t = 0; t < tb * 8; ++t) { const double nr2 = pr * ar - pi * ai, ni2 = pr * ai + pi * ar; pr = nr2; pi = ni2; }
#pragma unroll 1
        for (int t = 0; t < 8; ++t) { ap8[(t * 64 + p) * 2] = (float)pr; ap8[(t * 64 + p) * 2 + 1] = (float)pi;
            const double nr2 = pr * ar - pi * ai, ni2 = pr * ai + pi * ar; pr = nr2; pi = ni2; }
#pragma unroll 1
        for (int c = 0; c < 16; ++c) { const double br = (double)a.in[10][((l * 48 + g) * 64 + p) * 16 + c], bi = (double)a.in[11][((l * 48 + g) * 64 + p) * 16 + c];
            bbr[(p * 16 + c) * 2] = (float)(qr * br - qi * bi); bbr[(p * 16 + c) * 2 + 1] = (float)(qr * bi + qi * br); }
    }
    for (int idx = tid; idx < 1024; idx += NTHREADS) { const int c = idx >> 6, p = idx & 63;
        ccx[idx * 2] = a.in[12][((l * 48 + g) * 16 + c) * 64 + p]; ccx[idx * 2 + 1] = a.in[13][((l * 48 + g) * 16 + c) * 64 + p]; }
    __syncthreads();
    for (int idx = tid; idx < 8192; idx += NTHREADS) { const int t = idx >> 10, cp = idx & 1023, p = idx & 63;
        const float Cr = ccx[cp * 2], Ci = ccx[cp * 2 + 1], wr_ = ap8[(t * 64 + p) * 2], wi_ = ap8[(t * 64 + p) * 2 + 1];
        cw[idx * 2] = Cr * wr_ - Ci * wi_; cw[idx * 2 + 1] = Cr * wi_ + Ci * wr_; }
    __syncthreads();
#pragma unroll
    for (int k = 0; k < 4; ++k) { const int o = tid + k * NTHREADS, t = o >> 8, c = (o >> 4) & 15, c2 = o & 15;
        float s = 0.f;
        for (int p = 0; p < 64; ++p) s += cw[((t * 16 + c) * 64 + p) * 2] * bbr[(p * 16 + c2) * 2] - cw[((t * 16 + c) * 64 + p) * 2 + 1] * bbr[(p * 16 + c2) * 2 + 1];
        KTp[((size_t)((g * 2 + dir) * 32 + tb * 8 + t)) * 256 + c * 16 + c2] = s; }
    __syncthreads();
}
__device__ __forceinline__ void s5_te(const Args& a, int l, int task) {
    const int tid = tid_l(), g = task >> 2, qd = task & 3, r = tid >> 2, sub = tid & 3, i = qd * 8 + (r >> 4), c = r & 15;
    const float* KTp = (const float*)(a.ws + WS_KT); const float* APWp = (const float*)(a.ws + WS_APW);
    bf16_t* rowp = (bf16_t*)(a.ws + WS_TE) + ((size_t)g * 512 + i * 16 + c) * 768;
    const float dsk = a.in[14][l * 768 + g * 16 + c];
    const float* kf = KTp + (size_t)((g * 2 + 0) * 32) * 256 + c * 16; const float* kb = KTp + (size_t)((g * 2 + 1) * 32) * 256 + c * 16;
#pragma unroll
    for (int jb = 0; jb < 8; jb += 4) {
        f32x4 v[4][4];
#pragma unroll
        for (int jq = 0; jq < 4; ++jq) { const int j = sub * 8 + jb + jq;
            const float* kp = j < i ? kf + (i - j) * 256 : (j > i ? kb + (j - i) * 256 : kf);
#pragma unroll
            for (int q = 0; q < 4; ++q) v[jq][q] = *(const f32x4*)(kp + q * 4);
            if (j == i) {
#pragma unroll
                for (int q = 0; q < 4; ++q) { v[jq][q] += *(const f32x4*)(kb + q * 4);
#pragma unroll
                    for (int e = 0; e < 4; ++e) v[jq][q][e] += (q * 4 + e == c) ? dsk : 0.f; } } }
#pragma unroll
        for (int jq = 0; jq < 4; ++jq) { const int j = sub * 8 + jb + jq;
            *(u32x4*)(rowp + j * 16) = pack8(v[jq][0], v[jq][1]); *(u32x4*)(rowp + j * 16 + 8) = pack8(v[jq][2], v[jq][3]); } }
    { const int dir = sub >> 1, p0 = (sub & 1) * 32, e = dir == 0 ? i + 1 : 32 - i;
      const float* cr = a.in[12] + ((l * 48 + g) * 16 + c) * 64 + p0; const float* ci = a.in[13] + ((l * 48 + g) * 16 + c) * 64 + p0;
      const float* aw = APWp + ((size_t)((g * 2 + dir) * 33 + e) * 64 + p0) * 2;
#pragma unroll 2
      for (int p4 = 0; p4 < 32; p4 += 4) { const f32x4 Cr = *(const f32x4*)(cr + p4), Ci = *(const f32x4*)(ci + p4), w0 = *(const f32x4*)(aw + p4 * 2), w1 = *(const f32x4*)(aw + p4 * 2 + 4);
          u32x4 ww; ww.x = cvt_pk_bf16(Cr[0] * w0[0] - Ci[0] * w0[1], -(Cr[0] * w0[1] + Ci[0] * w0[0])); ww.y = cvt_pk_bf16(Cr[1] * w0[2] - Ci[1] * w0[3], -(Cr[1] * w0[3] + Ci[1] * w0[2]));
          ww.z = cvt_pk_bf16(Cr[2] * w1[0] - Ci[2] * w1[1], -(Cr[2] * w1[1] + Ci[2] * w1[0])); ww.w = cvt_pk_bf16(Cr[3] * w1[2] - Ci[3] * w1[3], -(Cr[3] * w1[3] + Ci[3] * w1[2]));
          *(u32x4*)(rowp + 512 + dir * 128 + (p0 + p4) * 2) = ww; } }
}

__device__ __forceinline__ void winbf_task(LAS unsigned char* lds, const float* w_in_l, bf16_t* dst, int task) {
    const int tid = tid_l(), g = task & 3, k0 = (task >> 2) * 64;
    LAS float* Wt = (LAS float*)lds;
    LAS float* tc = Wt + 64 * 128; LAS float* ts = tc + 128;
    { const int k = tid >> 3, c16 = (tid & 7) * 16; const float* s = w_in_l + (size_t)(k0 + k) * INW + 1536 + g * 128 + c16;
#pragma unroll
      for (int q = 0; q < 4; ++q) *(LAS f32x4*)(Wt + k * 128 + c16 + q * 4) = *(const f32x4*)(s + q * 4); }
    if (tid < 128) { float sn, cs; sincospif((float)tid * (1.0f / 64.0f), &sn, &cs); tc[tid] = cs; ts[tid] = sn; }
    __syncthreads();
    const int cp = tid & 127, kq = tid >> 7;
    float aC[16], aS[16];
#pragma unroll
    for (int kk = 0; kk < 16; ++kk) { aC[kk] = 0.f; aS[kk] = 0.f; }
    for (int c = 0; c < 128; ++c) { const int idx = (c * cp) & 127; const float vc = tc[idx], vs = ts[idx];
#pragma unroll
        for (int kk = 0; kk < 16; ++kk) { const float w = Wt[(kq * 16 + kk) * 128 + c]; aC[kk] += w * vc; aS[kk] += w * vs; } }
    bf16_t* dc = dst + (size_t)(g * 128 + cp) * 2048 + k0 + kq * 16; bf16_t* ds = dst + (size_t)(512 + g * 128 + cp) * 2048 + k0 + kq * 16;
    u32x4 w; w.x = cvt_pk_bf16(aC[0], aC[1]); w.y = cvt_pk_bf16(aC[2], aC[3]); w.z = cvt_pk_bf16(aC[4], aC[5]); w.w = cvt_pk_bf16(aC[6], aC[7]); *(u32x4*)dc = w;
    w.x = cvt_pk_bf16(aC[8], aC[9]); w.y = cvt_pk_bf16(aC[10], aC[11]); w.z = cvt_pk_bf16(aC[12], aC[13]); w.w = cvt_pk_bf16(aC[14], aC[15]); *(u32x4*)(dc + 8) = w;
    w.x = cvt_pk_bf16(aS[0], aS[1]); w.y = cvt_pk_bf16(aS[2], aS[3]); w.z = cvt_pk_bf16(aS[4], aS[5]); w.w = cvt_pk_bf16(aS[6], aS[7]); *(u32x4*)ds = w;
    w.x = cvt_pk_bf16(aS[8], aS[9]); w.y = cvt_pk_bf16(aS[10], aS[11]); w.z = cvt_pk_bf16(aS[12], aS[13]); w.w = cvt_pk_bf16(aS[14], aS[15]); *(u32x4*)(ds + 8) = w;
    __syncthreads();
}

__device__ __forceinline__ void d256_gen(bf16_t* d256, int bx, int G) {
    for (int idx = bx * NTHREADS + tid_l(); idx < 256 * 512; idx += G * NTHREADS) { const int k1 = idx >> 9, ri = (idx >> 8) & 1, n1 = idx & 255, e = (n1 * k1) & 255;
        float sn, cs; sincospif((float)e * (1.0f / 128.0f), &sn, &cs);
        d256[idx] = f2bf((ri == 0 ? cs : -sn) * 0.0013810679320049757f); }
}
__device__ __forceinline__ void fft16_pass(LAS unsigned char* lds, const bf16_t* zf2, bf16_t* vt, int bx, int G) {
    const int tid = tid_l();
    LAS float* tw = (LAS float*)lds;
    for (int i = tid; i < 4096; i += NTHREADS) { float sn, cs; sincospif((float)i * (1.0f / 2048.0f), &sn, &cs); tw[2 * i] = cs; tw[2 * i + 1] = sn; }
    __syncthreads();
    const int n1 = tid & 255, sub = tid >> 8;
    u32x4 pw0, pw1, pw2, pw3;
    { const int task0 = bx * 2 + sub; if (task0 < 3072) { const bf16_t* src = zf2 + ((size_t)task0 * 256 + n1) * 32; pw0 = *(const u32x4*)src; pw1 = *(const u32x4*)(src + 8); pw2 = *(const u32x4*)(src + 16); pw3 = *(const u32x4*)(src + 24); } }
    for (int task = bx * 2 + sub; task < 3072; task += G * 2) {
        const u32x4 w0 = pw0, w1 = pw1, w2 = pw2, w3 = pw3;
        if (task + G * 2 < 3072) { const bf16_t* src = zf2 + ((size_t)(task + G * 2) * 256 + n1) * 32; pw0 = *(const u32x4*)src; pw1 = *(const u32x4*)(src + 8); pw2 = *(const u32x4*)(src + 16); pw3 = *(const u32x4*)(src + 24); }
        float zr[16], zi[16];
#pragma unroll
        for (int e = 0; e < 4; ++e) { zr[2 * e] = bf_lo(w0[e]); zr[2 * e + 1] = bf_hi(w0[e]); zr[8 + 2 * e] = bf_lo(w1[e]); zr[8 + 2 * e + 1] = bf_hi(w1[e]);
                                      zi[2 * e] = bf_lo(w2[e]); zi[2 * e + 1] = bf_hi(w2[e]); zi[8 + 2 * e] = bf_lo(w3[e]); zi[8 + 2 * e + 1] = bf_hi(w3[e]); }
        float Ar[4][4], Ai[4][4];
#pragma unroll
        for (int q = 0; q < 4; ++q) {
            const float s0r = zr[q] + zr[8 + q], s0i = zi[q] + zi[8 + q], s1r = zr[q] - zr[8 + q], s1i = zi[q] - zi[8 + q];
            const float s2r = zr[4 + q] + zr[12 + q], s2i = zi[4 + q] + zi[12 + q], s3r = zr[4 + q] - zr[12 + q], s3i = zi[4 + q] - zi[12 + q];
            Ar[q][0] = s0r + s2r; Ai[q][0] = s0i + s2i; Ar[q][2] = s0r - s2r; Ai[q][2] = s0i - s2i;
            Ar[q][1] = s1r - s3i; Ai[q][1] = s1i + s3r; Ar[q][3] = s1r + s3i; Ai[q][3] = s1i - s3r; }
        const float c1 = 0.9238795325f, s1 = 0.3826834324f, c2 = 0.7071067812f;
#define CMUL(xr, xi, cr, ci) { const float t_ = xr * (cr) - xi * (ci); xi = xr * (ci) + xi * (cr); xr = t_; }
        CMUL(Ar[1][1], Ai[1][1], c1, s1) CMUL(Ar[1][2], Ai[1][2], c2, c2) CMUL(Ar[1][3], Ai[1][3], s1, c1)
        CMUL(Ar[2][1], Ai[2][1], c2, c2) CMUL(Ar[2][2], Ai[2][2], 0.f, 1.f) CMUL(Ar[2][3], Ai[2][3], -c2, c2)
        CMUL(Ar[3][1], Ai[3][1], s1, c1) CMUL(Ar[3][2], Ai[3][2], -c2, c2) CMUL(Ar[3][3], Ai[3][3], -c1, -s1)
#undef CMUL
        float xr[16], xi[16];
#pragma unroll
        for (int r = 0; r < 4; ++r) {
            const float s0r = Ar[0][r] + Ar[2][r], s0i = Ai[0][r] + Ai[2][r], s1r = Ar[0][r] - Ar[2][r], s1i = Ai[0][r] - Ai[2][r];
            const float s2r = Ar[1][r] + Ar[3][r], s2i = Ai[1][r] + Ai[3][r], s3r = Ar[1][r] - Ar[3][r], s3i = Ai[1][r] - Ai[3][r];
            xr[r] = s0r + s2r; xi[r] = s0i + s2i; xr[r + 8] = s0r - s2r; xi[r + 8] = s0i - s2i;
            xr[r + 4] = s1r - s3i; xi[r + 4] = s1i + s3r; xr[r + 12] = s1r + s3i; xi[r + 12] = s1i - s3r; }
        const int b = task >> 9, gc = task & 511;
        bf16_t* dst = vt + ((size_t)(b * 16) * 512 + gc) * 512 + n1;
#pragma unroll
        for (int k2 = 0; k2 < 16; ++k2) { const int idx = (n1 * k2) & 4095; const float c = tw[2 * idx], sn = tw[2 * idx + 1];
            dst[(size_t)k2 * 512 * 512] = f2bf(xr[k2] * c - xi[k2] * sn); dst[(size_t)k2 * 512 * 512 + 256] = f2bf(xr[k2] * sn + xi[k2] * c); }
    }
    __syncthreads();
}

template <int MODE>
__device__ __forceinline__ void rms_rows(const float* xp, const float* xs, float* xres, const float* gain, bf16_t* outb, int bx, int G) {
    const int tid = tid_l(), lane = tid & 63, wave = tid >> 6;
    f32x4 gv[8];
#pragma unroll
    for (int it = 0; it < 8; ++it) gv[it] = *(const f32x4*)(gain + it * 256 + lane * 4);
    for (int row = (bx * 8 + wave) * 2; row < T; row += G * 16) {
        f32x4 v[2][8]; float ss[2] = {0.f, 0.f};
#pragma unroll
        for (int rr = 0; rr < 2; ++rr) { const int r_ = row + rr;
            const float* src = MODE == 0 ? (r_ < 16384 ? xp + (size_t)r_ * 2048 : xs + (size_t)(r_ - 16384) * 2048) : xres + (size_t)r_ * 2048;
#pragma unroll
            for (int it = 0; it < 8; ++it) v[rr][it] = *(const f32x4*)(src + it * 256 + lane * 4); }
#pragma unroll
        for (int rr = 0; rr < 2; ++rr) {
#pragma unroll
            for (int it = 0; it < 8; ++it) ss[rr] += v[rr][it][0] * v[rr][it][0] + v[rr][it][1] * v[rr][it][1] + v[rr][it][2] * v[rr][it][2] + v[rr][it][3] * v[rr][it][3];
            ss[rr] = wave_sum(ss[rr]); }
#pragma unroll
        for (int rr = 0; rr < 2; ++rr) { const float r = 1.0f / sqrtf(ss[rr] * (1.0f / 2048.0f) + EPS);
#pragma unroll
            for (int it = 0; it < 8; ++it) {
                const f32x4 o = v[rr][it] * r * gv[it];
                if (MODE == 2) *(f32x4*)(xres + (size_t)(row + rr) * 2048 + it * 256 + lane * 4) = o;
                else { u32x2 w; w.x = cvt_pk_bf16(o[0], o[1]); w.y = cvt_pk_bf16(o[2], o[3]); *(u32x2*)(outb + (size_t)(row + rr) * 2048 + it * 256 + lane * 4) = w; }
            } }
    }
}

__device__ __forceinline__ void outnorm_rows(bf16_t* y, const float* og, int bx, int G) {
    const int tid = tid_l(), lane = tid & 63, wave = tid >> 6;
    for (int row = (bx * 8 + wave) * 2; row < T; row += G * 16) {
        u32x4 w[2][4]; float ss[2][3];
#pragma unroll
        for (int rr = 0; rr < 2; ++rr)
#pragma unroll
            for (int it = 0; it < 4; ++it) w[rr][it] = *(const u32x4*)(y + (size_t)(row + rr) * 2048 + (it * 64 + lane) * 8);
#pragma unroll
        for (int rr = 0; rr < 2; ++rr) { ss[rr][0] = 0.f; ss[rr][1] = 0.f; ss[rr][2] = 0.f;
#pragma unroll
            for (int it = 0; it < 4; ++it) { const int ch = it * 64 + lane; float s = 0.f;
#pragma unroll
                for (int q = 0; q < 4; ++q) { const float a0 = bf_lo(w[rr][it][q]), a1 = bf_hi(w[rr][it][q]); s += a0 * a0 + a1 * a1; }
                const int seg = ch < 96 ? 0 : (ch < 160 ? 1 : 2);
                ss[rr][0] += seg == 0 ? s : 0.f; ss[rr][1] += seg == 1 ? s : 0.f; ss[rr][2] += seg == 2 ? s : 0.f; }
            ss[rr][0] = wave_sum(ss[rr][0]); ss[rr][1] = wave_sum(ss[rr][1]); ss[rr][2] = wave_sum(ss[rr][2]); }
#pragma unroll
        for (int rr = 0; rr < 2; ++rr) {
            const float r0 = 1.0f / sqrtf(ss[rr][0] * (1.0f / 768.0f) + EPS), r1 = 1.0f / sqrtf(ss[rr][1] * (1.0f / 512.0f) + EPS), r2 = 1.0f / sqrtf(ss[rr][2] * (1.0f / 768.0f) + EPS);
#pragma unroll
            for (int it = 0; it < 4; ++it) { const int ch = it * 64 + lane; const float r = ch < 96 ? r0 : (ch < 160 ? r1 : r2);
                const f32x4 g0 = *(const f32x4*)(og + ch * 8), g1 = *(const f32x4*)(og + ch * 8 + 4);
                const u32x4 ww = w[rr][it];
                u32x4 o; o.x = cvt_pk_bf16(bf_lo(ww.x) * r * g0[0], bf_hi(ww.x) * r * g0[1]); o.y = cvt_pk_bf16(bf_lo(ww.y) * r * g0[2], bf_hi(ww.y) * r * g0[3]);
                o.z = cvt_pk_bf16(bf_lo(ww.z) * r * g1[0], bf_hi(ww.z) * r * g1[1]); o.w = cvt_pk_bf16(bf_lo(ww.w) * r * g1[2], bf_hi(ww.w) * r * g1[3]);
                *(u32x4*)(y + (size_t)(row + rr) * 2048 + ch * 8) = o; } }
    }
}

__device__ __forceinline__ void gmlp_task(LAS unsigned char* lds, const bf16_t* zina, const bf16_t* wsb, const float* vg, const float* bs, bf16_t* y, int task) {
    const int tid = tid_l(), lane = tid & 63, wid = tid >> 6, fr = lane & 15, fq = lane >> 4;
    const int cidx = task / 6, h = task - cidx * 6, t0 = cidx * 128;
    LAS bf16_t* vT = (LAS bf16_t*)lds;
    { const int k = tid >> 2, dq = (tid & 3) * 32;
      const bf16_t* src = zina + (size_t)(t0 + k) * 1536 + 768 + h * 128 + dq;
      u32x4 w[4]; float ss = 0.f;
#pragma unroll
      for (int q = 0; q < 4; ++q) { w[q] = *(const u32x4*)(src + q * 8);
#pragma unroll
          for (int e = 0; e < 4; ++e) { const float a0 = bf_lo(w[q][e]), a1 = bf_hi(w[q][e]); ss += a0 * a0 + a1 * a1; } }
      ss += __shfl_xor(ss, 1); ss += __shfl_xor(ss, 2);
      const float r = 1.0f / sqrtf(ss * (1.0f / 128.0f) + EPS);
#pragma unroll
      for (int q = 0; q < 4; ++q)
#pragma unroll
          for (int e = 0; e < 4; ++e) { const int d = dq + q * 8 + e * 2;
              vT[d * 136 + k] = f2bf(bf_lo(w[q][e]) * r * vg[h * 128 + d]); vT[(d + 1) * 136 + k] = f2bf(bf_hi(w[q][e]) * r * vg[h * 128 + d + 1]); } }
    __syncthreads();
    const int q0 = (wid >> 1) * 32, d0 = (wid & 1) * 64;
    f32x4 acc[2][4];
#pragma unroll
    for (int mq = 0; mq < 2; ++mq)
#pragma unroll
        for (int nd = 0; nd < 4; ++nd) acc[mq][nd] = (f32x4){0.f, 0.f, 0.f, 0.f};
#pragma unroll
    for (int ks = 0; ks < 4; ++ks) {
        bf16x8 af[2], bfr[4];
#pragma unroll
        for (int mq = 0; mq < 2; ++mq) af[mq] = *(const bf16x8*)(wsb + (size_t)(h * 128 + q0 + mq * 16 + fr) * 128 + ks * 32 + fq * 8);
#pragma unroll
        for (int nd = 0; nd < 4; ++nd) bfr[nd] = *(const LAS bf16x8*)(vT + (d0 + nd * 16 + fr) * 136 + ks * 32 + fq * 8);
#pragma unroll
        for (int mq = 0; mq < 2; ++mq)
#pragma unroll
            for (int nd = 0; nd < 4; ++nd) acc[mq][nd] = __builtin_amdgcn_mfma_f32_16x16x32_bf16(bfr[nd], af[mq], acc[mq][nd], 0, 0, 0);
    }
    u32x2 uq[2][4];
#pragma unroll
    for (int mq = 0; mq < 2; ++mq)
#pragma unroll
        for (int nd = 0; nd < 4; ++nd) uq[mq][nd] = *(const u32x2*)(zina + (size_t)(t0 + q0 + mq * 16 + fr) * 1536 + h * 128 + d0 + nd * 16 + 4 * fq);
#pragma unroll
    for (int mq = 0; mq < 2; ++mq) { const int q = q0 + mq * 16 + fr; const float b = bs[h * 128 + q];
#pragma unroll
        for (int nd = 0; nd < 4; ++nd) { const int d = d0 + nd * 16 + 4 * fq;
            const u32x2 uu = uq[mq][nd];
            const f32x4 m = acc[mq][nd] + b;
            u32x2 o; o.x = cvt_pk_bf16(bf_lo(uu.x) * m[0], bf_hi(uu.x) * m[1]); o.y = cvt_pk_bf16(bf_lo(uu.y) * m[2], bf_hi(uu.y) * m[3]);
            *(u32x2*)(y + (size_t)(t0 + q) * 2048 + h * 128 + d) = o; } }
    __syncthreads();
}

__device__ __forceinline__ void carry_scan(const float* xs, const float* ALp, bf16_t* ucat, int bx) {
    const int idx = bx * NTHREADS + tid_l();
    if (idx >= 48 * 6 * 128) return;
    const int p = idx & 63, dir = (idx >> 6) & 1, b = (idx >> 7) % 6, g = idx / 768;
    const f32x2 aL = *(const f32x2*)(ALp + ((g * 2 + dir) * 64 + p) * 2);
    float hr = 0.f, hi = 0.f;
#pragma unroll 32
    for (int s = 0; s < 128; ++s) { const int c = dir == 0 ? s : 127 - s; const size_t chunk = (size_t)g * 768 + b * 128 + c;
        const f32x2 x = *(const f32x2*)(xs + chunk * 256 + dir * 128 + p * 2);
        *(unsigned*)(ucat + chunk * 768 + 512 + dir * 128 + p * 2) = cvt_pk_bf16(hr, hi);
        const float nr = aL.x * hr - aL.y * hi + x.x, ni = aL.x * hi + aL.y * hr + x.y; hr = nr; hi = ni; }
}

#define XB_TMO      128
#define XB_XCNT(j)  (256  + 64 * (j))
#define XB_XSUB(j)  (1280 + 64 * (j))
#define XB_XGEN(j)  (2304 + 64 * (j))
#define XB_TOP      3328
#define XB_TOPGEN   3392
#define XCD_BAR_WORDS 3456
#define XB_SPIN_CAP (1u << 22)
__device__ __forceinline__ unsigned xb_ld(unsigned* p)              { return __hip_atomic_load(p, __ATOMIC_RELAXED, __HIP_MEMORY_SCOPE_AGENT); }
__device__ __forceinline__ unsigned xb_add(unsigned* p, unsigned v) { return __hip_atomic_fetch_add(p, v, __ATOMIC_RELAXED, __HIP_MEMORY_SCOPE_AGENT); }
__device__ __forceinline__ unsigned xb_xcc_id() { return (unsigned)__builtin_amdgcn_s_getreg((3 << 11) | 20) & 0xFu; }
#define XB_SPIN(cond, bar) do { unsigned _sp = 0; while (cond) { __builtin_amdgcn_s_sleep(1); \
    if ((++_sp & 255u) == 0u) { if (xb_ld(&(bar)[XB_TMO])) break; if (_sp > XB_SPIN_CAP) { atomicAdd(&(bar)[XB_TMO], 1u); break; } } } } while (0)
struct XcdBarrier { unsigned* bar; unsigned x; volatile LAS unsigned* st; };
__device__ __forceinline__ XcdBarrier xcd_barrier_post(unsigned* bar, volatile LAS unsigned* st) {
    XcdBarrier b; b.bar = bar; b.x = xb_xcc_id(); b.st = st;
    if (threadIdx.x == 0) (void)xb_add(&bar[XB_XCNT(b.x)], 1u);
    return b;
}
__device__ __forceinline__ void xcd_barrier_complete(unsigned* bar, unsigned x, unsigned& nloc, unsigned& nx) {
    const unsigned Gt = gridDim.x * gridDim.y * gridDim.z;
    unsigned sum, cnt, mine, sp = 0u;
    for (;;) {
        sum = 0u; cnt = 0u; mine = 0u;
#pragma unroll
        for (unsigned j = 0; j < 16; ++j) { const unsigned c = xb_ld(&bar[XB_XCNT(j)]); sum += c; cnt += (c > 0u) ? 1u : 0u; mine = (j == x) ? c : mine; }
        if (sum == Gt) break;
        __builtin_amdgcn_s_sleep(1);
        if ((++sp & 255u) == 0u) { if (xb_ld(&bar[XB_TMO])) break; if (sp > XB_SPIN_CAP) { atomicAdd(&bar[XB_TMO], 1u); break; } }
    }
    nloc = mine > 0u ? mine : 1u; nx = cnt > 0u ? cnt : 1u;
}
__device__ __forceinline__ void xcd_barrier(const XcdBarrier& b) {
    asm volatile("s_waitcnt vmcnt(0)" ::: "memory");
    __syncthreads();
    if (threadIdx.x == 0) {
        unsigned* bar = b.bar;
        __builtin_amdgcn_s_waitcnt(0);
        unsigned nloc = b.st[0], nx = b.st[1];
        if (nloc == 0u) { xcd_barrier_complete(bar, b.x, nloc, nx); b.st[0] = nloc; b.st[1] = nx; }
        const unsigned old = xb_add(&bar[XB_XSUB(b.x)], 1u);
        const unsigned gen = old / nloc;
        if (old + 1u == (gen + 1u) * nloc) {
            __builtin_amdgcn_fence(__ATOMIC_RELEASE, "agent");
            asm volatile("s_waitcnt vmcnt(0)" ::: "memory");
            const unsigned og = xb_add(&bar[XB_TOP], 1u);
            const unsigned tg = og / nx;
            if (og + 1u == (tg + 1u) * nx) xb_add(&bar[XB_TOPGEN], 1u);
            else XB_SPIN(xb_ld(&bar[XB_TOPGEN]) == tg, bar);
            __builtin_amdgcn_fence(__ATOMIC_ACQUIRE, "agent");
            xb_add(&bar[XB_XGEN(b.x)], 1u);
            asm volatile("s_waitcnt vmcnt(0)" ::: "memory");
        } else {
            XB_SPIN(xb_ld(&bar[XB_XGEN(b.x)]) == gen, bar);
            __builtin_amdgcn_fence(__ATOMIC_ACQUIRE, "agent");
            asm volatile("s_waitcnt vmcnt(0)" ::: "memory");
        }
    }
    __syncthreads();
}

__device__ __forceinline__ void grid_bar(unsigned* cnt, unsigned target) {
    asm volatile("s_waitcnt vmcnt(0)" ::: "memory");
    __syncthreads();
    if (threadIdx.x == 0) {
        __builtin_amdgcn_fence(__ATOMIC_RELEASE, "agent");
        asm volatile("s_waitcnt vmcnt(0)" ::: "memory");
        (void)__hip_atomic_fetch_add(cnt, 1u, __ATOMIC_RELAXED, __HIP_MEMORY_SCOPE_AGENT);
        unsigned sp = 0;
        while (__hip_atomic_load(cnt, __ATOMIC_RELAXED, __HIP_MEMORY_SCOPE_AGENT) < target) { __builtin_amdgcn_s_sleep(1); if (++sp > (1u << 22)) break; }
        __builtin_amdgcn_fence(__ATOMIC_ACQUIRE, "agent");
        asm volatile("s_waitcnt vmcnt(0)" ::: "memory");
    }
    __syncthreads();
}

constexpr int N_PHASES = 23;
__global__ void __launch_bounds__(NTHREADS, 2) mega_fwd(Args a) {
    extern __shared__ __attribute__((aligned(16))) unsigned char lds_raw[];
    LAS unsigned char* lds = (LAS unsigned char*)lds_raw;
    cg::grid_group grid = cg::this_grid();
#define WINAC ((bf16_t*)(ws + WS_WINAC))
#define WINBF ((bf16_t*)(ws + WS_WINBF))
#define WOUT  ((bf16_t*)(ws + WS_WOUT))
#define WGLU  ((bf16_t*)(ws + WS_WGLU))
#define WSB   ((bf16_t*)(ws + WS_WS))
#define WGU   ((bf16_t*)(ws + WS_WGU))
#define WDOWN ((bf16_t*)(ws + WS_WDOWN))
#define VT    ((bf16_t*)(ws + WS_VT))
#define D256  ((bf16_t*)(ws + WS_D256))
#define AL    ((float*)(ws + WS_AL))
#define SLOT1 ((bf16_t*)(ws + WS_SLOT1))
#define ZINA  ((bf16_t*)(ws + WS_ZINA))
#define ZFT   ((bf16_t*)(ws + WS_ZFT))
#define YCPRE ((bf16_t*)(ws + WS_YCPRE))
#define UCAT  ((bf16_t*)(ws + WS_UCAT))
#define XS    ((float*)(ws + WS_XS))
#define TE    ((bf16_t*)(ws + WS_TE))
#define GM    ((bf16_t*)(ws + WS_GM))
#define HID   ((bf16_t*)(ws + WS_HID))
    int ph = 0; unsigned nbar = 0;
    volatile LAS unsigned* xst = (volatile LAS unsigned*)(lds + 131072);
    if (threadIdx.x == 0) { xst[0] = 0u; xst[1] = 0u; }
    __syncthreads();
    const XcdBarrier xbar = xcd_barrier_post((unsigned*)(a.ws + WS_CTL), xst);
#define GRID_SYNC() do { if (a.ph_lo > 4096) { grid.sync(); } else { xcd_barrier(xbar); } ++nbar; } while (0)
#ifndef ONLY_PH
#define ONLY_PH -1
#endif
#ifndef PROBE_DUP
#define PROBE_DUP -1
#endif
#define PH_BEGIN(k) if ((ONLY_PH < 0 || ONLY_PH == (k)) && ph >= a.ph_lo && ph < a.ph_hi) { const int nrep_ = ((k) == PROBE_DUP) ? 2 : 1; for (int rep_ = 0; rep_ < nrep_; ++rep_) { unsigned char* ws = a.ws; float* X = a.out; int bx = blockIdx.x, G = gridDim.x; asm volatile("; PHASEMARK %4" : "+s"(ws), "+s"(X), "+s"(bx), "+s"(G) : "i"(k));
#define PH_END   if (rep_ + 1 < nrep_) GRID_SYNC(); } if (ph + 1 < a.ph_hi) GRID_SYNC(); } ++ph;

#define FFN_CONVERT(t0, t1) do { if (bx >= 32) { \
        const FfnCtx fc{a.in[20] + (size_t)l * 2048 * DFF, a.in[21] + (size_t)l * 2048 * DFF, a.in[22] + (size_t)l * DFF * 2048, WGU, WDOWN}; \
        transpose_run<SelFfn>(lds, fc, (t0) + bx - 32, (t1), G - 32); } } while (0)
#pragma unroll 1
    for (int l = 0; l < 2; ++l) {
        PH_BEGIN(0)
            for (int g = bx; g < NGRP; g += G) s5_group_a(lds, a, l, g);
            for (int t = G - 1 - bx; t < NGRP * 8; t += G) s5_ktab(lds, a, l, t);
            for (int t = (bx + G - 48) % G; t < 128; t += G) winbf_task(lds, a.in[3] + (size_t)l * 2048 * INW, WINBF, t);
            if (l == 0) d256_gen(D256, bx, G);
            {
                const float* s = a.in[5] + (size_t)l * 6 * 128 * 128;
                for (int i = bx * NTHREADS + tid_l(); i < 6 * 128 * 128 / 2; i += G * NTHREADS) ((unsigned*)WSB)[i] = cvt_pk_bf16(s[2 * i], s[2 * i + 1]);
            }
            {
                const TrDesc td[4] = {
                    {a.in[3] + (size_t)l * 2048 * INW, INW, 2048, 0, 1536, WINAC, 0, 0},
                    {a.in[3] + (size_t)l * 2048 * INW, INW, 2048, 2048, 768, WINAC, 0, 1536},
                    {a.in[18] + (size_t)l * 2048 * 2048, 2048, 2048, 0, 2048, WOUT, 0, 0},
                    {a.in[15] + (size_t)l * 768 * 768, 768, 768, 0, 768, WGLU, 0, 0}};
                const int ntile[4] = {32 * 6, 32 * 3, 32 * 8, 12 * 3};
#pragma unroll
                for (int m = 0; m < 4; ++m) transpose_run<SelOne>(lds, td[m], bx, ntile[m], G);
            }
            if (l == 0) rms_rows<0>(a.in[0], a.in[1], X, a.in[2], SLOT1, bx, G);
            else        rms_rows<1>(nullptr, nullptr, X, a.in[2] + l * 2048, SLOT1, bx, G);
        PH_END
        PH_BEGIN(1)
            { pg8::Sched S{(const char*)SLOT1, (const char*)WINAC, 0, 0, 2048, 2048, T / 256, 9, 1, G, bx, 0, 4}; EpiWin E{ZINA, UCAT}; pg8::gemm_phase(lds, S, 2048, E); }
            { pg8::Sched S{(const char*)WINBF, (const char*)SLOT1, 0, 0, 2048, 2048, 4, T / 256, 1, G, G - 1 - bx, 1, 8}; EpiZft2 E{ZFT}; pg8::gemm_phase(lds, S, 2048, E); }
        PH_END
        PH_BEGIN(2)
            fft16_pass(lds, ZFT, VT, bx, G);
            { pg8::Sched S{(const char*)UCAT, (const char*)GM, (long)768 * 768 * 2, (long)256 * 512 * 2, 768, 512, 3, 1, NGRP, G, bx, 0, 8}; EpiXs E{XS}; pg8::gemm_phase(lds, S, 512, E); }
            for (int t = G - 1 - bx; t < 192 * 6; t += G) gmlp_task(lds, ZINA, WSB, a.in[4] + l * 768, a.in[6] + l * 768, SLOT1, t);
            for (int t = bx; t < NGRP * 4; t += G) s5_te(a, l, t);
        PH_END
        PH_BEGIN(3)
            if (bx < 72) carry_scan(XS, AL, UCAT, bx);
            if (bx >= 64) { pg8::Sched S{(const char*)D256, (const char*)VT, 0, 0, 512, 512, 1, 192, 1, G - 64, bx - 64, 0, 8}; EpiFour2 E{SLOT1}; pg8::gemm_phase(lds, S, 512, E); }
        PH_END
        PH_BEGIN(4)
            { pg8::Sched S{(const char*)UCAT, (const char*)TE, (long)768 * 768 * 2, (long)512 * 768 * 2, 768, 768, 3, 2, NGRP, G, bx, 0, 8}; EpiYc E{YCPRE}; pg8::gemm_phase(lds, S, 768, E); }
            FFN_CONVERT(0, 1056);
        PH_END
        PH_BEGIN(5)
            { pg8::Sched S{(const char*)YCPRE, (const char*)WGLU, 0, 0, 768, 768, T / 256, 3, 1, G, bx, 0, 8}; EpiGlu E{YCPRE, a.in[16] + l * 768, SLOT1}; pg8::gemm_phase(lds, S, 768, E); }
            FFN_CONVERT(1056, 2112);
        PH_END
        PH_BEGIN(6)
            outnorm_rows(SLOT1, a.in[17] + l * 2048, bx, G);
        PH_END
        PH_BEGIN(7)
            { pg8::Sched S{(const char*)SLOT1, (const char*)WOUT, 0, 0, 2048, 2048, T / 256, 8, 1, G, bx, 0, 4}; EpiRes E{X, l == 0 ? a.in[0] : X, (l == 0 ? a.in[1] : X + (size_t)16384 * 2048) - (size_t)16384 * 2048}; pg8::gemm_phase(lds, S, 2048, E); }
        PH_END
        PH_BEGIN(8)
            rms_rows<1>(nullptr, nullptr, X, a.in[19] + l * 2048, SLOT1, bx, G);
        PH_END
        PH_BEGIN(9)
            { pg8::Sched S{(const char*)SLOT1, (const char*)WGU, 0, 0, 2048, 2048, T / 256, 44, 1, G, bx, 0, 4}; EpiSwi E{HID}; pg8::gemm_phase(lds, S, 2048, E); }
        PH_END
        PH_BEGIN(10)
            { pg8::Sched S{(const char*)HID, (const char*)WDOWN, 0, 0, DFF, DFF, T / 256, 8, 1, G, bx, 0, 4}; EpiRes E{X, X, X}; pg8::gemm_phase(lds, S, DFF, E); }
        PH_END
    }
    PH_BEGIN(11)
        rms_rows<2>(nullptr, nullptr, X, a.in[23], nullptr, bx, G);
    PH_END
#undef PH_BEGIN
#undef PH_END
}

extern "C" void kernel_launch(void* const* d_in, const int* in_sizes, int n_in, void* d_out, int out_size, void* d_ws, size_t ws_size, hipStream_t stream) {
    static int grid = 0;
    if (grid == 0) {
        if (n_in != 24 || out_size != T * DM || ws_size < WS_END) { fprintf(stderr, "kernel_launch: unexpected shapes / workspace (n_in %d out %d ws %zu need %zu)\n", n_in, out_size, ws_size, (size_t)WS_END); grid = -1; return; }
        int dev = 0, cus = 0, per_cu = 0;
        if (hipGetDevice(&dev) != hipSuccess || hipDeviceGetAttribute(&cus, hipDeviceAttributeMultiprocessorCount, dev) != hipSuccess) { grid = -1; return; }
        if (hipFuncSetAttribute((const void*)mega_fwd, hipFuncAttributeMaxDynamicSharedMemorySize, LDS_BYTES) != hipSuccess) { fprintf(stderr, "kernel_launch: hipFuncSetAttribute failed\n"); grid = -1; return; }
        if (hipOccupancyMaxActiveBlocksPerMultiprocessor(&per_cu, (const void*)mega_fwd, NTHREADS, LDS_BYTES) != hipSuccess || per_cu < 1) { fprintf(stderr, "kernel_launch: occupancy query says %d\n", per_cu); per_cu = 1; }
        (void)hipGetLastError();
        grid = cus * 1;
    }
    if (grid < 0) return;
    if (hipMemsetAsync((char*)d_ws + WS_CTL, 0, 16384, stream) != hipSuccess) { fprintf(stderr, "kernel_launch: memset of the barrier word failed\n"); return; }
    Args a{};
    for (int i = 0; i < 24; ++i) a.in[i] = (const float*)d_in[i];
    a.out = (float*)d_out; a.ws = (unsigned char*)d_ws;
#if MK_ONE_LAUNCH
    a.ph_lo = 0; a.ph_hi = N_PHASES;
    void* args[] = {&a};
    hipError_t e = hipLaunchCooperativeKernel((const void*)mega_fwd, dim3(grid), dim3(NTHREADS), args, LDS_BYTES, stream);
    if (e != hipSuccess) fprintf(stderr, "cooperative launch failed: %s (grid %d)\n", hipGetErrorString(e), grid);
#else
    for (int p = 0; p < N_PHASES; ++p) {
        a.ph_lo = p; a.ph_hi = p + 1;
        hipLaunchKernelGGL(mega_fwd, dim3(grid), dim3(NTHREADS), LDS_BYTES, stream, a);
    }
#endif
}
```

```cpp
#include <hip/hip_runtime.h>
#include <hip/hip_cooperative_groups.h>
#include <cstdio>
#include <cstdint>
namespace cg = cooperative_groups;

#ifndef MK_ONE_LAUNCH
#define MK_ONE_LAUNCH 1
#endif

#define LAS __attribute__((address_space(3)))
typedef unsigned short bf16_t;
typedef short bf16x8 __attribute__((ext_vector_type(8)));
typedef float f32x4 __attribute__((ext_vector_type(4)));
typedef float f32x2 __attribute__((ext_vector_type(2)));
typedef unsigned u32x4 __attribute__((ext_vector_type(4)));
typedef unsigned u32x2 __attribute__((ext_vector_type(2)));

constexpr int T = 24576, DM = 2048, NBATCH = 6, SEQ = 4096, DFF = 5632, INW = 2816;
constexpr int NGRP = 48, NCHUNK = T / 32;
constexpr float EPS = 1e-6f;
constexpr int NTHREADS = 512;
constexpr int LDS_BYTES = 131072 + 1024;

constexpr size_t WS_WINAC = 0;
constexpr size_t WS_WINBF = WS_WINAC + (size_t)2304 * 2048 * 2;
constexpr size_t WS_WOUT  = WS_WINBF + (size_t)1024 * 2048 * 2;
constexpr size_t WS_WGLU  = WS_WOUT + (size_t)2048 * 2048 * 2;
constexpr size_t WS_WS    = WS_WGLU + (size_t)768 * 768 * 2;
constexpr size_t WS_WGU   = WS_WS + (size_t)6 * 128 * 128 * 2;
constexpr size_t WS_WDOWN = WS_WGU + (size_t)11264 * 2048 * 2;
constexpr size_t WS_DFT   = WS_WDOWN + (size_t)2048 * 5632 * 2;
constexpr size_t WS_VT    = WS_DFT;
constexpr size_t WS_D256  = WS_DFT + (size_t)49152 * 512 * 2;
constexpr size_t WS_AL    = WS_DFT + (size_t)4096 * 8192 * 2;
constexpr size_t WS_APW   = WS_AL + (size_t)48 * 2 * 64 * 2 * 4;
constexpr size_t WS_KT    = WS_APW + (size_t)48 * 2 * 33 * 64 * 2 * 4;
constexpr size_t WS_SLOT1 = WS_KT + (size_t)48 * 2 * 32 * 256 * 4;
constexpr size_t WS_ACT   = WS_SLOT1 + (size_t)T * 2048 * 2;
constexpr size_t WS_ZINA  = WS_ACT;
constexpr size_t WS_ZFT   = WS_ZINA + (size_t)T * 1536 * 2;
constexpr size_t WS_YCPRE = WS_ZFT;
constexpr size_t WS_UCAT  = WS_ZFT + (size_t)512 * 49152 * 2;
constexpr size_t WS_XS    = WS_UCAT + (size_t)48 * 768 * 768 * 2;
constexpr size_t WS_TE    = WS_XS + (size_t)48 * 768 * 256 * 4;
constexpr size_t WS_GM    = WS_TE + (size_t)48 * 512 * 768 * 2;
constexpr size_t WS_MIXEND = WS_GM + (size_t)48 * 256 * 512 * 2;
constexpr size_t WS_HID   = WS_ACT;
constexpr size_t WS_CTL   = WS_ACT + (size_t)T * 5632 * 2;
constexpr size_t WS_END   = WS_CTL + 16384;
static_assert(WS_MIXEND <= WS_CTL, "mixer buffers must fit under the FFN hidden buffer");

struct Args { const float* in[24]; float* out; unsigned char* ws; int ph_lo, ph_hi; };

__device__ __forceinline__ int tid_l() { int t = threadIdx.x; asm volatile("" : "+v"(t)); return t; }
__device__ __forceinline__ unsigned cvt_pk_bf16(float lo, float hi) { unsigned r; asm("v_cvt_pk_bf16_f32 %0, %1, %2" : "=v"(r) : "v"(lo), "v"(hi)); return r; }
__device__ __forceinline__ float bf_lo(unsigned w) { return __uint_as_float(w << 16); }
__device__ __forceinline__ float bf_hi(unsigned w) { return __uint_as_float(w & 0xffff0000u); }
__device__ __forceinline__ bf16_t f2bf(float f) { return (bf16_t)(cvt_pk_bf16(f, 0.f) & 0xffffu); }
__device__ __forceinline__ float sigmoid_f(float v) { return __builtin_amdgcn_rcpf(1.0f + __builtin_amdgcn_exp2f(-1.4426950409f * v)); }
__device__ __forceinline__ float gelu_tanh(float x) { const float z = x * (1.5957691216f + 0.0713548163f * x * x); return x * sigmoid_f(z); }
__device__ __forceinline__ float wave_sum(float v) {
#pragma unroll
    for (int o = 32; o >= 1; o >>= 1) v += __shfl_xor(v, o);
    return v;
}

namespace pg8 {
constexpr int BM = 256, BK = 64, HALF = 128, HTB = HALF * BK * 2, STAGE_BYTES = 8 * HTB, NXCD = 8, WGM = 8;
__device__ __forceinline__ int lds_byte(int r, int c) { const int st = (r >> 4) * 2 + (c >> 5), rr = r & 15, cc = c & 31, ob = rr * 64 + cc * 2; return st * 1024 + (ob ^ (((ob >> 9) & 1) << 5)); }
__device__ __forceinline__ void stage_rc(int b, int& R, int& C) { const int st = b / 1024, sb = b % 1024, swz = sb ^ (((sb >> 9) & 1) << 5); R = (st >> 1) * 16 + swz / 64; C = (st & 1) * 32 + (swz % 64) / 2; }
__device__ __forceinline__ int perm32(int rho) { const int n = rho >> 4, i = rho & 15; return 8 * (i >> 2) + 4 * n + (i & 3); }

struct Unit { const char* A; const char* B; int pm, pn, grp; };
struct Sched {
    const char* A; const char* B; long gsA, gsB; int lda, ldb, nM, nN, nG, G, c, bmap, wgm;
    __device__ __forceinline__ bool next(int i, Unit& u) const {
        const int nwg = nM * nN;
        const long L = (long)i * G + c; if (c < 0 || L >= (long)nwg * nG) return false;
        const int grp = (int)(L / nwg); int wgid = (int)(L - (long)grp * nwg);
        { const int q = nwg / NXCD, r = nwg % NXCD, xcd = wgid % NXCD, off = wgid / NXCD; wgid = (xcd < r ? xcd * (q + 1) : r * (q + 1) + (xcd - r) * q) + off; }
        const int nig = wgm * nN, gid = wgid / nig, fm = gid * wgm, gsz = (nM - fm) < wgm ? (nM - fm) : wgm;
        u.pm = fm + ((wgid % nig) % gsz); u.pn = (wgid % nig) / gsz; u.grp = grp;
        u.A = A + (size_t)grp * gsA + (size_t)u.pm * 512 * lda; u.B = B + (size_t)grp * gsB + (bmap ? (size_t)((u.pn >> 4) * 4096 + (u.pn & 15) * 16) * 2 * ldb : (size_t)u.pn * 512 * ldb);
        return true;
    }
};

template <class Epi>
__device__ __forceinline__ void gemm_phase(LAS unsigned char* lds, const Sched& S, const int K, const Epi& E) {
    int tid = threadIdx.x; asm volatile("" : "+v"(tid));
    const int wid = __builtin_amdgcn_readfirstlane(tid >> 6), lane = tid & 63, wr = wid >> 2, wc = wid & 3, fr = lane & 15, fq = lane >> 4;
    const int nt = K / BK;
    unsigned voffA[2], voffB[2];
#pragma unroll
    for (int i = 0; i < 2; ++i) { int R, C; stage_rc(tid * 16 + i * 8192, R, C); const int Rb = Epi::PERM ? ((R & ~31) + perm32(R & 31)) : R;
        const int RbT = Epi::BMAP ? ((Rb >> 4) + 256 * (Rb & 15)) : Rb;
        voffA[i] = (unsigned)(R * S.lda + C) * 2u; voffB[i] = (unsigned)(RbT * S.ldb + C) * 2u; }
    const size_t kstep = (size_t)(BK * 2);
    const size_t hstepA = (size_t)HALF * S.lda * 2, hstepB = (size_t)(Epi::BMAP ? 8 : HALF) * S.ldb * 2;
    const unsigned ldsw = (unsigned)wid * 1024u;
    const int aoff = lds_byte(wr * 64 + fr, fq * 8), boff = lds_byte(wc * 32 + fr, fq * 8);
#define PG8_SA(b, h) (((b) * 2 + (h)) * HTB)
#define PG8_SB(b, h) ((4 + (b) * 2 + (h)) * HTB)
#define PG8_STAGE(bufoff, gbase, voff) do { _Pragma("unroll") for (int _i = 0; _i < 2; ++_i) \
        __builtin_amdgcn_global_load_lds((const unsigned*)((const char*)(gbase) + (voff)[_i]), (LAS unsigned*)(lds + (bufoff) + ldsw + _i * 8192), 16, 0, 0); } while (0)
#define PG8_LDA(dst, b, h) do { _Pragma("unroll") for (int m = 0; m < 4; ++m) _Pragma("unroll") for (int k = 0; k < 2; ++k) dst[m][k] = *(const LAS bf16x8*)(lds + PG8_SA(b, h) + aoff + m * 2048 + k * 1024); } while (0)
#define PG8_LDB(dst, b, h) do { _Pragma("unroll") for (int n = 0; n < 2; ++n) _Pragma("unroll") for (int k = 0; k < 2; ++k) dst[n][k] = *(const LAS bf16x8*)(lds + PG8_SB(b, h) + boff + n * 2048 + k * 1024); } while (0)
#define PG8_MMA(ai, bj, At, Bt) do { __builtin_amdgcn_s_setprio(1); _Pragma("unroll") for (int m = 0; m < 4; ++m) _Pragma("unroll") for (int n = 0; n < 2; ++n) _Pragma("unroll") for (int k = 0; k < 2; ++k) \
        acc[ai][bj][m][n] = __builtin_amdgcn_mfma_f32_16x16x32_bf16(Bt[n][k], At[m][k], acc[ai][bj][m][n], 0, 0, 0); __builtin_amdgcn_s_setprio(0); } while (0)
#define PG8_WAIT_V(n) asm volatile("s_waitcnt vmcnt(" #n ")" ::: "memory")
#define PG8_WAIT_L(n) asm volatile("s_waitcnt lgkmcnt(" #n ")" ::: "memory")
#define PG8_BAR __builtin_amdgcn_s_barrier()
#define PG8_SCHED __builtin_amdgcn_sched_barrier(0)
    Unit cur, nxt; int ui = 0;
    if (!S.next(0, cur)) return;
    f32x4 acc[2][2][4][2];
#pragma unroll
    for (int a = 0; a < 2; ++a)
#pragma unroll
        for (int b = 0; b < 2; ++b)
#pragma unroll
            for (int m = 0; m < 4; ++m)
#pragma unroll
                for (int n = 0; n < 2; ++n) acc[a][b][m][n] = (f32x4){0.f, 0.f, 0.f, 0.f};
    bf16x8 At[4][2], B0[2][2], B1[2][2];
    const char* cA = cur.A; const char* cB = cur.B;
    PG8_STAGE(PG8_SB(0, 0), cB, voffB); PG8_STAGE(PG8_SB(0, 1), cB + hstepB, voffB); PG8_STAGE(PG8_SA(0, 0), cA, voffA); PG8_STAGE(PG8_SA(0, 1), cA + hstepA, voffA);
    if (wr == 1) PG8_BAR;
    PG8_WAIT_V(2); PG8_BAR;
    PG8_STAGE(PG8_SB(1, 0), cB + kstep, voffB); PG8_STAGE(PG8_SA(1, 0), cA + kstep, voffA); PG8_STAGE(PG8_SB(1, 1), cB + hstepB + kstep, voffB);
    PG8_WAIT_V(6); PG8_BAR;
    for (;;) {
        const bool has_next = S.next(ui + 1, nxt);
        const char* nA = has_next ? nxt.A : cA; const char* nB = has_next ? nxt.B : cB;
        for (int t = 0; t < nt; t += 2) {
            const bool last = (t == nt - 2);
            const char* a1 = cA + (size_t)(t + 1) * kstep;
            const char* a2 = last ? nA : cA + (size_t)(t + 2) * kstep; const char* b2 = last ? nB : cB + (size_t)(t + 2) * kstep;
            const char* a3 = a2 + kstep; const char* b3 = b2 + kstep;
            PG8_LDB(B0, 0, 0); PG8_LDB(B1, 0, 1); PG8_SCHED; PG8_LDA(At, 0, 0); PG8_STAGE(PG8_SA(1, 1), a1 + hstepA, voffA);
            PG8_WAIT_V(8); PG8_WAIT_L(0); PG8_BAR; PG8_MMA(0, 0, At, B0); PG8_MMA(0, 1, At, B1); PG8_BAR; PG8_SCHED;
            PG8_LDA(At, 0, 1); PG8_STAGE(PG8_SB(0, 0), b2, voffB); PG8_STAGE(PG8_SB(0, 1), b2 + hstepB, voffB); PG8_STAGE(PG8_SA(0, 0), a2, voffA);
            PG8_WAIT_V(8); PG8_WAIT_L(0); PG8_BAR; PG8_MMA(1, 0, At, B0); PG8_MMA(1, 1, At, B1); PG8_BAR; PG8_SCHED;
            PG8_LDB(B0, 1, 0); PG8_LDB(B1, 1, 1); PG8_SCHED; PG8_LDA(At, 1, 0); PG8_STAGE(PG8_SA(0, 1), a2 + hstepA, voffA);
            PG8_WAIT_V(8); PG8_WAIT_L(0); PG8_BAR; PG8_MMA(0, 0, At, B0); PG8_MMA(0, 1, At, B1); PG8_BAR; PG8_SCHED;
            PG8_LDA(At, 1, 1); PG8_STAGE(PG8_SB(1, 0), b3, voffB); PG8_STAGE(PG8_SB(1, 1), b3 + hstepB, voffB); PG8_STAGE(PG8_SA(1, 0), a3, voffA);
            PG8_WAIT_V(8); PG8_WAIT_L(0); PG8_BAR; PG8_MMA(1, 0, At, B0); PG8_MMA(1, 1, At, B1); PG8_BAR; PG8_SCHED;
        }
        if (wr == 0) PG8_BAR;
        E(acc, cur, wr, wc, fr, fq);
        if (!has_next) break;
#pragma unroll
        for (int a = 0; a < 2; ++a)
#pragma unroll
            for (int b = 0; b < 2; ++b)
#pragma unroll
                for (int m = 0; m < 4; ++m)
#pragma unroll
                    for (int n = 0; n < 2; ++n) acc[a][b][m][n] = (f32x4){0.f, 0.f, 0.f, 0.f};
        cur = nxt; cA = nA; cB = nB; ++ui;
        if (wr == 1) PG8_BAR;
    }
    PG8_WAIT_V(0);
    PG8_BAR;
#undef PG8_SA
#undef PG8_SB
#undef PG8_STAGE
#undef PG8_LDA
#undef PG8_LDB
#undef PG8_MMA
#undef PG8_WAIT_V
#undef PG8_WAIT_L
#undef PG8_BAR
#undef PG8_SCHED
}
}
using pg8::Unit;
typedef const f32x4 (&AccRef)[2][2][4][2];

__device__ __forceinline__ u32x4 pack8(f32x4 v0, f32x4 v1) { u32x4 w; w.x = cvt_pk_bf16(v0[0], v0[1]); w.y = cvt_pk_bf16(v0[2], v0[3]); w.z = cvt_pk_bf16(v1[0], v1[1]); w.w = cvt_pk_bf16(v1[2], v1[3]); return w; }
__device__ __forceinline__ f32x4 gelu4(f32x4 v) { return (f32x4){gelu_tanh(v[0]), gelu_tanh(v[1]), gelu_tanh(v[2]), gelu_tanh(v[3])}; }

struct EpiWin { static constexpr bool PERM = true; static constexpr int BMAP = 0; bf16_t* zina; bf16_t* ucat;
    __device__ __forceinline__ void operator()(AccRef acc, const Unit& u, int wr, int wc, int fr, int fq) const {
        const int row0 = u.pm * 256 + wr * 64 + fr;
        if (u.pn < 6) {
            const int col0 = u.pn * 256 + wc * 32 + 8 * fq;
#pragma unroll
            for (int ai = 0; ai < 2; ++ai)
#pragma unroll
                for (int m = 0; m < 4; ++m) { bf16_t* rowp = zina + (size_t)(row0 + ai * 128 + m * 16) * 1536 + col0;
#pragma unroll
                    for (int bj = 0; bj < 2; ++bj) *(u32x4*)(rowp + bj * 128) = pack8(gelu4(acc[ai][bj][m][0]), gelu4(acc[ai][bj][m][1])); }
        } else {
            const int cc0 = (u.pn - 6) * 256 + wc * 32 + 8 * fq;
#pragma unroll
            for (int ai = 0; ai < 2; ++ai)
#pragma unroll
                for (int m = 0; m < 4; ++m) { const int t = row0 + ai * 128 + m * 16, n = t >> 5, j = t & 31;
#pragma unroll
                    for (int bj = 0; bj < 2; ++bj) { const int cc = cc0 + bj * 128, g = cc >> 4, c0 = cc & 15;
                        *(u32x4*)(ucat + ((size_t)(g * 768 + n) * 768 + j * 16 + c0)) = pack8(acc[ai][bj][m][0], acc[ai][bj][m][1]); } }
        }
    } };
struct EpiZft2 { static constexpr bool PERM = true; static constexpr int BMAP = 1; bf16_t* zf2;
    __device__ __forceinline__ void operator()(AccRef acc, const Unit& u, int wr, int wc, int fr, int fq) const {
        const int row0 = u.pm * 256 + wr * 64 + fr, b = u.pn >> 4, n1b = (u.pn & 15) * 16 + 2 * wc + (fq >> 1), n20 = (fq & 1) * 8;
#pragma unroll
        for (int ai = 0; ai < 2; ++ai)
#pragma unroll
            for (int m = 0; m < 4; ++m) { const int r = row0 + ai * 128 + m * 16, ri = r >> 9, gc = r & 511;
#pragma unroll
                for (int bj = 0; bj < 2; ++bj) { const int n1 = n1b + 8 * bj;
                    *(u32x4*)(zf2 + ((((size_t)b * 512 + gc) * 256 + n1) * 32 + ri * 16 + n20)) = pack8(acc[ai][bj][m][0], acc[ai][bj][m][1]); } }
    } };
struct EpiFour2 { static constexpr bool PERM = true; static constexpr int BMAP = 0; bf16_t* y;
    __device__ __forceinline__ void operator()(AccRef acc, const Unit& u, int wr, int wc, int fr, int fq) const {
        const int bk = u.pn >> 1, b = bk >> 4, k2 = bk & 15, col0 = 768 + (u.pn & 1) * 256 + wc * 32 + 8 * fq, k10 = wr * 64 + fr;
#pragma unroll
        for (int ai = 0; ai < 2; ++ai)
#pragma unroll
            for (int m = 0; m < 4; ++m) { const int k1 = k10 + ai * 128 + m * 16; bf16_t* rowp = y + (size_t)(b * 4096 + 16 * k1 + k2) * 2048 + col0;
#pragma unroll
                for (int bj = 0; bj < 2; ++bj) *(u32x4*)(rowp + bj * 128) = pack8(acc[ai][bj][m][0], acc[ai][bj][m][1]); }
    } };
struct EpiXs { static constexpr bool PERM = false; static constexpr int BMAP = 0; float* xs;
    __device__ __forceinline__ void operator()(AccRef acc, const Unit& u, int wr, int wc, int fr, int fq) const {
        const int row0 = u.pm * 256 + wr * 64 + fr, col0 = wc * 32 + 4 * fq;
#pragma unroll
        for (int ai = 0; ai < 2; ++ai)
#pragma unroll
            for (int m = 0; m < 4; ++m) { float* rowp = xs + ((size_t)u.grp * 768 + row0 + ai * 128 + m * 16) * 256 + col0;
#pragma unroll
                for (int bj = 0; bj < 2; ++bj)
#pragma unroll
                    for (int n = 0; n < 2; ++n) *(f32x4*)(rowp + bj * 128 + n * 16) = acc[ai][bj][m][n]; }
    } };
struct EpiYc { static constexpr bool PERM = true; static constexpr int BMAP = 0; bf16_t* ycpre;
    __device__ __forceinline__ void operator()(AccRef acc, const Unit& u, int wr, int wc, int fr, int fq) const {
        const int row0 = u.pm * 256 + wr * 64 + fr, col0 = u.pn * 256 + wc * 32 + 8 * fq;
#pragma unroll
        for (int ai = 0; ai < 2; ++ai)
#pragma unroll
            for (int m = 0; m < 4; ++m) { const int n = row0 + ai * 128 + m * 16;
#pragma unroll
                for (int bj = 0; bj < 2; ++bj) { const int col = col0 + bj * 128, i = col >> 4, c0 = col & 15;
                    *(u32x4*)(ycpre + ((size_t)(n * 32 + i) * 768 + u.grp * 16 + c0)) = pack8(gelu4(acc[ai][bj][m][0]), gelu4(acc[ai][bj][m][1])); } }
    } };
struct EpiGlu { static constexpr bool PERM = true; static constexpr int BMAP = 0; const bf16_t* ycpre; const float* bias; bf16_t* y;
    __device__ __forceinline__ void operator()(AccRef acc, const Unit& u, int wr, int wc, int fr, int fq) const {
        const int row0 = u.pm * 256 + wr * 64 + fr, col0 = u.pn * 256 + wc * 32 + 8 * fq;
        f32x4 bv[2][2];
#pragma unroll
        for (int bj = 0; bj < 2; ++bj)
#pragma unroll
            for (int n = 0; n < 2; ++n) bv[bj][n] = *(const f32x4*)(bias + col0 + bj * 128 + 4 * n);
#pragma unroll
        for (int ai = 0; ai < 2; ++ai) {
            u32x4 yc[4][2];
#pragma unroll
            for (int m = 0; m < 4; ++m)
#pragma unroll
                for (int bj = 0; bj < 2; ++bj) yc[m][bj] = *(const u32x4*)(ycpre + (size_t)(row0 + ai * 128 + m * 16) * 768 + col0 + bj * 128);
#pragma unroll
            for (int m = 0; m < 4; ++m) { const size_t t = (size_t)(row0 + ai * 128 + m * 16);
#pragma unroll
                for (int bj = 0; bj < 2; ++bj) { const int col = col0 + bj * 128; const u32x4 w = yc[m][bj];
                    const f32x4 v0 = acc[ai][bj][m][0] + bv[bj][0], v1 = acc[ai][bj][m][1] + bv[bj][1];
                    const f32x4 o0 = (f32x4){bf_lo(w.x) * sigmoid_f(v0[0]), bf_hi(w.x) * sigmoid_f(v0[1]), bf_lo(w.y) * sigmoid_f(v0[2]), bf_hi(w.y) * sigmoid_f(v0[3])};
                    const f32x4 o1 = (f32x4){bf_lo(w.z) * sigmoid_f(v1[0]), bf_hi(w.z) * sigmoid_f(v1[1]), bf_lo(w.w) * sigmoid_f(v1[2]), bf_hi(w.w) * sigmoid_f(v1[3])};
                    *(u32x4*)(y + t * 2048 + 1280 + col) = pack8(o0, o1); } }
            asm volatile("" ::: "memory"); }
    } };
struct EpiRes { static constexpr bool PERM = false; static constexpr int BMAP = 0; float* x; const float* r0; const float* r1adj;
    __device__ __forceinline__ void operator()(AccRef acc, const Unit& u, int wr, int wc, int fr, int fq) const {
        const int row0 = u.pm * 256 + wr * 64 + fr, col0 = u.pn * 256 + wc * 32 + 4 * fq;
        const float* sb = u.pm < 64 ? r0 : r1adj;
#pragma unroll
        for (int ai = 0; ai < 2; ++ai) {
            const size_t off = (size_t)(row0 + ai * 128) * 2048 + col0;
            f32x4 ld[4][2][2];
#pragma unroll
            for (int m = 0; m < 4; ++m)
#pragma unroll
                for (int bj = 0; bj < 2; ++bj)
#pragma unroll
                    for (int n = 0; n < 2; ++n) ld[m][bj][n] = *(const f32x4*)(sb + off + (size_t)m * 16 * 2048 + bj * 128 + n * 16);
#pragma unroll
            for (int m = 0; m < 4; ++m)
#pragma unroll
                for (int bj = 0; bj < 2; ++bj)
#pragma unroll
                    for (int n = 0; n < 2; ++n) *(f32x4*)(x + off + (size_t)m * 16 * 2048 + bj * 128 + n * 16) = ld[m][bj][n] + acc[ai][bj][m][n];
            asm volatile("" ::: "memory"); }
    } };
struct EpiSwi { static constexpr bool PERM = true; static constexpr int BMAP = 0; bf16_t* hid;
    __device__ __forceinline__ void operator()(AccRef acc, const Unit& u, int wr, int wc, int fr, int fq) const {
        const int row0 = u.pm * 256 + wr * 64 + fr, col0 = u.pn * 128 + wc * 32 + 8 * fq;
#pragma unroll
        for (int ai = 0; ai < 2; ++ai)
#pragma unroll
            for (int m = 0; m < 4; ++m) {
                f32x4 o[2];
#pragma unroll
                for (int n = 0; n < 2; ++n) { const f32x4 g = acc[ai][0][m][n], up = acc[ai][1][m][n];
                    o[n] = (f32x4){g[0] * sigmoid_f(g[0]) * up[0], g[1] * sigmoid_f(g[1]) * up[1], g[2] * sigmoid_f(g[2]) * up[2], g[3] * sigmoid_f(g[3]) * up[3]}; }
                *(u32x4*)(hid + (size_t)(row0 + ai * 128 + m * 16) * 5632 + col0) = pack8(o[0], o[1]); }
    } };

struct TrDesc { const float* src; int ldsrc, K, c0, nc; bf16_t* dst; int mode, doff; };
template <class SEL, class CTX>
__device__ __forceinline__ void transpose_run(LAS unsigned char* lds, const CTX& ctx, int t0, int t1, int stride) {
    const int tid = tid_l();
    LAS unsigned* tl = (LAS unsigned*)lds;
    const int k = tid >> 3, n8 = (tid & 7) * 8;
    f32x4 v[4][2];
    TrDesc d; int lt;
    if (t0 < t1) { SEL::get(ctx, t0, d, lt); const int nkt = d.K >> 6, kt = lt % nkt, ct = lt / nkt;
        const float* s = d.src + (size_t)(kt * 64 + k) * d.ldsrc + d.c0 + ct * 256 + n8;
#pragma unroll
        for (int q = 0; q < 4; ++q) { v[q][0] = *(const f32x4*)(s + q * 64); v[q][1] = *(const f32x4*)(s + q * 64 + 4); } }
    for (int t = t0; t < t1; t += stride) {
        SEL::get(ctx, t, d, lt);
        const int nkt = d.K >> 6, kt = lt % nkt, ct = lt / nkt;
        unsigned w[4][4];
#pragma unroll
        for (int q = 0; q < 4; ++q)
#pragma unroll
            for (int j = 0; j < 4; ++j) { const float lo = v[q][0][j], hi = v[q][1][j];
                const float recv = __shfl_xor((k & 1) ? lo : hi, 8);
                w[q][j] = (k & 1) ? cvt_pk_bf16(recv, hi) : cvt_pk_bf16(lo, recv); }
        if (t + stride < t1) { TrDesc dn; int ltn; SEL::get(ctx, t + stride, dn, ltn); const int nktn = dn.K >> 6, ktn = ltn % nktn, ctn = ltn / nktn;
            const float* s = dn.src + (size_t)(ktn * 64 + k) * dn.ldsrc + dn.c0 + ctn * 256 + n8;
#pragma unroll
            for (int q = 0; q < 4; ++q) { v[q][0] = *(const f32x4*)(s + q * 64); v[q][1] = *(const f32x4*)(s + q * 64 + 4); } }
#pragma unroll
        for (int q = 0; q < 4; ++q)
#pragma unroll
            for (int j = 0; j < 4; ++j) tl[(q * 64 + n8 + j + ((k & 1) ? 4 : 0)) * 33 + (k >> 1)] = w[q][j];
        __syncthreads();
        { const int n = tid >> 3, k8 = (tid & 7) * 8;
#pragma unroll
          for (int q = 0; q < 4; ++q) {
              const LAS unsigned* p = tl + (q * 64 + n) * 33 + (k8 >> 1);
              u32x4 ww; ww.x = p[0]; ww.y = p[1]; ww.z = p[2]; ww.w = p[3];
              const int cc = ct * 256 + q * 64 + n;
              const int drow = d.mode == 0 ? d.doff + cc : ((cc >> 7) * 256 + (cc & 127) + (d.mode == 2 ? 128 : 0));
              *(u32x4*)(d.dst + (size_t)drow * d.K + kt * 64 + k8) = ww; } }
        __syncthreads();
    }
}
struct SelOne { static __device__ __forceinline__ void get(const TrDesc& c, int t, TrDesc& d, int& lt) { d = c; lt = t; } };
struct FfnCtx { const float* wg; const float* wu; const float* wd; bf16_t* wgu; bf16_t* wdown; };
struct SelFfn { static __device__ __forceinline__ void get(const FfnCtx& c, int t, TrDesc& d, int& lt) {
    if (t < 704)       { d = TrDesc{c.wg, DFF, 2048, 0, DFF, c.wgu, 1, 0}; lt = t; }
    else if (t < 1408) { d = TrDesc{c.wu, DFF, 2048, 0, DFF, c.wgu, 2, 0}; lt = t - 704; }
    else               { d = TrDesc{c.wd, 2048, DFF, 0, 2048, c.wdown, 0, 0}; lt = t - 1408; } } };

__device__ __forceinline__ double kd(double c) { asm volatile("" : "+v"(c)); return c; }
__device__ __forceinline__ double exp_d(double x) {
    const double y = x * 0.125; double term = 1.0, sum = 1.0;
#pragma unroll 1
    for (int n = 1; n <= 22; ++n) { term *= y / (double)n; sum += term; }
    sum *= sum; sum *= sum; sum *= sum; return sum;
}
__device__ __forceinline__ void sincos_d(double x, double& s, double& c) {
    const double k = rint(x * kd(0.15915494309189535));
    double r = fma(-k, kd(6.283185307179586232), x); r = fma(-k, kd(2.4492935982947064e-16), r);
    const double y = r * 0.125, my2 = -(y * y);
    double sn = y, cs = 1.0, ts = y, tc = 1.0;
#pragma unroll 1
    for (int n = 1; n <= 10; ++n) { tc *= my2 / (double)((2 * n - 1) * (2 * n)); cs += tc; ts *= my2 / (double)((2 * n) * (2 * n + 1)); sn += ts; }
#pragma unroll 1
    for (int i = 0; i < 3; ++i) { const double c2 = cs * cs - sn * sn, s2 = 2.0 * sn * cs; cs = c2; sn = s2; }
    s = sn; c = cs;
}

__device__ __forceinline__ void s5_disc(const Args& a, int l, int g, int dir, int p, double& ar, double& ai, double& qr, double& qi) {
    const double lr = (double)a.in[7][((l * 2 + dir) * 48 + g) * 64 + p], li = (double)a.in[8][((l * 2 + dir) * 48 + g) * 64 + p];
    const double st = exp_d((double)a.in[9][(l * 2 + dir) * 48 + g]);
    const double mag = exp_d(lr * st); double sn, cs; sincos_d(li * st, sn, cs);
    ar = mag * cs; ai = mag * sn; const double den = lr * lr + li * li, nr = ar - 1.0;
    qr = (nr * lr + ai * li) / den; qi = (ai * lr - nr * li) / den;
}
__device__ __forceinline__ void s5_group_a(LAS unsigned char* lds, const Args& a, int l, int g) {
    const int tid = tid_l();
    LAS float* apw = (LAS float*)lds;
    LAS float* bbr = apw + 2 * 33 * 64 * 2;
    bf16_t* GMp = (bf16_t*)(a.ws + WS_GM); float* ALp = (float*)(a.ws + WS_AL); float* APWp = (float*)(a.ws + WS_APW);
    if (tid < 128) {
        const int dir = tid >> 6, p = tid & 63;
        double ar, ai, qr, qi; s5_disc(a, l, g, dir, p, ar, ai, qr, qi);
        double pr = 1.0, pi = 0.0;
#pragma unroll 1
        for (int tau = 0; tau <= 32; ++tau) { const float fr_ = (float)pr, fi_ = (float)pi;
            apw[((dir * 33 + tau) * 64 + p) * 2] = fr_; apw[((dir * 33 + tau) * 64 + p) * 2 + 1] = fi_;
            *(f32x2*)(APWp + ((size_t)((g * 2 + dir) * 33 + tau) * 64 + p) * 2) = (f32x2){fr_, fi_};
            const double nr2 = pr * ar - pi * ai, ni2 = pr * ai + pi * ar; pr = nr2; pi = ni2; }
        ALp[((g * 2 + dir) * 64 + p) * 2] = apw[((dir * 33 + 32) * 64 + p) * 2]; ALp[((g * 2 + dir) * 64 + p) * 2 + 1] = apw[((dir * 33 + 32) * 64 + p) * 2 + 1];
#pragma unroll 1
        for (int c = 0; c < 16; ++c) { const double br = (double)a.in[10][((l * 48 + g) * 64 + p) * 16 + c], bi = (double)a.in[11][((l * 48 + g) * 64 + p) * 16 + c];
            bbr[((dir * 64 + p) * 16 + c) * 2] = (float)(qr * br - qi * bi); bbr[((dir * 64 + p) * 16 + c) * 2 + 1] = (float)(qr * bi + qi * br); }
    }
    __syncthreads();
    {
        const int row = tid >> 1, half = tid & 1, dir = row >> 7, p = (row >> 1) & 63, ri = row & 1;
        bf16_t* rowp = GMp + ((size_t)g * 256 + row) * 512;
        for (int jj = 0; jj < 16; ++jj) { const int j = half * 16 + jj, e = dir == 0 ? 31 - j : j;
            const float wr_ = apw[((dir * 33 + e) * 64 + p) * 2], wi_ = apw[((dir * 33 + e) * 64 + p) * 2 + 1];
            float v[16];
#pragma unroll
            for (int c2 = 0; c2 < 16; ++c2) { const float Br = bbr[((dir * 64 + p) * 16 + c2) * 2], Bi = bbr[((dir * 64 + p) * 16 + c2) * 2 + 1];
                v[c2] = ri == 0 ? wr_ * Br - wi_ * Bi : wr_ * Bi + wi_ * Br; }
            u32x4 w0, w1; w0.x = cvt_pk_bf16(v[0], v[1]); w0.y = cvt_pk_bf16(v[2], v[3]); w0.z = cvt_pk_bf16(v[4], v[5]); w0.w = cvt_pk_bf16(v[6], v[7]);
            w1.x = cvt_pk_bf16(v[8], v[9]); w1.y = cvt_pk_bf16(v[10], v[11]); w1.z = cvt_pk_bf16(v[12], v[13]); w1.w = cvt_pk_bf16(v[14], v[15]);
            *(u32x4*)(rowp + j * 16) = w0; *(u32x4*)(rowp + j * 16 + 8) = w1; }
    }
    __syncthreads();
}
__device__ __forceinline__ void s5_ktab(LAS unsigned char* lds, const Args& a, int l, int task) {
    const int tid = tid_l(), g = task >> 3, dir = (task >> 2) & 1, tb = task & 3;
    LAS float* ap8 = (LAS float*)lds;
    LAS float* bbr = ap8 + 8 * 64 * 2;
    LAS float* ccx = bbr + 64 * 16 * 2;
    LAS float* cw  = ccx + 16 * 64 * 2;
    float* KTp = (float*)(a.ws + WS_KT);
    if (tid < 64) {
        const int p = tid; double ar, ai, qr, qi; s5_disc(a, l, g, dir, p, ar, ai, qr, qi);
        double pr = 1.0, pi = 0.0;
#pragma unroll 1
        for (int t = 0; t < tb * 8; ++t) { const double nr2 = pr * ar - pi * ai, ni2 = pr * ai + pi * ar; pr = nr2; pi = ni2; }
#pragma unroll 1
        for (int t = 0; t < 8; ++t) { ap8[(t * 64 + p) * 2] = (float)pr; ap8[(t * 64 + p) * 2 + 1] = (float)pi;
            const double nr2 = pr * ar - pi * ai, ni2 = pr * ai + pi * ar; pr = nr2; pi = ni2; }
#pragma unroll 1
        for (int c = 0; c < 16; ++c) { const double br = (double)a.in[10][((l * 48 + g) * 64 + p) * 16 + c], bi = (double)a.in[11][((l * 48 + g) * 64 + p) * 16 + c];
            bbr[(p * 16 + c) * 2] = (float)(qr * br - qi * bi); bbr[(p * 16 + c) * 2 + 1] = (float)(qr * bi + qi * br); }
    }
    for (int idx = tid; idx < 1024; idx += NTHREADS) { const int c = idx >> 6, p = idx & 63;
        ccx[idx * 2] = a.in[12][((l * 48 + g) * 16 + c) * 64 + p]; ccx[idx * 2 + 1] = a.in[13][((l * 48 + g) * 16 + c) * 64 + p]; }
    __syncthreads();
    for (int idx = tid; idx < 8192; idx += NTHREADS) { const int t = idx >> 10, cp = idx & 1023, p = idx & 63;
        const float Cr = ccx[cp * 2], Ci = ccx[cp * 2 + 1], wr_ = ap8[(t * 64 + p) * 2], wi_ = ap8[(t * 64 + p) * 2 + 1];
        cw[idx * 2] = Cr * wr_ - Ci * wi_; cw[idx * 2 + 1] = Cr * wi_ + Ci * wr_; }
    __syncthreads();
#pragma unroll
    for (int k = 0; k < 4; ++k) { const int o = tid + k * NTHREADS, t = o >> 8, c = (o >> 4) & 15, c2 = o & 15;
        float s = 0.f;
        for (int p = 0; p < 64; ++p) s += cw[((t * 16 + c) * 64 + p) * 2] * bbr[(p * 16 + c2) * 2] - cw[((t * 16 + c) * 64 + p) * 2 + 1] * bbr[(p * 16 + c2) * 2 + 1];
        KTp[((size_t)((g * 2 + dir) * 32 + tb * 8 + t)) * 256 + c * 16 + c2] = s; }
    __syncthreads();
}
__device__ __forceinline__ void s5_te(const Args& a, int l, int task) {
    const int tid = tid_l(), g = task >> 2, qd = task & 3, r = tid >> 2, sub = tid & 3, i = qd * 8 + (r >> 4), c = r & 15;
    const float* KTp = (const float*)(a.ws + WS_KT); const float* APWp = (const float*)(a.ws + WS_APW);
    bf16_t* rowp = (bf16_t*)(a.ws + WS_TE) + ((size_t)g * 512 + i * 16 + c) * 768;
    const float dsk = a.in[14][l * 768 + g * 16 + c];
    const float* kf = KTp + (size_t)((g * 2 + 0) * 32) * 256 + c * 16; const float* kb = KTp + (size_t)((g * 2 + 1) * 32) * 256 + c * 16;
#pragma unroll
    for (int jb = 0; jb < 8; jb += 4) {
        f32x4 v[4][4];
#pragma unroll
        for (int jq = 0; jq < 4; ++jq) { const int j = sub * 8 + jb + jq;
            const float* kp = j < i ? kf + (i - j) * 256 : (j > i ? kb + (j - i) * 256 : kf);
#pragma unroll
            for (int q = 0; q < 4; ++q) v[jq][q] = *(const f32x4*)(kp + q * 4);
            if (j == i) {
#pragma unroll
                for (int q = 0; q < 4; ++q) { v[jq][q] += *(const f32x4*)(kb + q * 4);
#pragma unroll
                    for (int e = 0; e < 4; ++e) v[jq][q][e] += (q * 4 + e == c) ? dsk : 0.f; } } }
#pragma unroll
        for (int jq = 0; jq < 4; ++jq) { const int j = sub * 8 + jb + jq;
            *(u32x4*)(rowp + j * 16) = pack8(v[jq][0], v[jq][1]); *(u32x4*)(rowp + j * 16 + 8) = pack8(v[jq][2], v[jq][3]); } }
    { const int dir = sub >> 1, p0 = (sub & 1) * 32, e = dir == 0 ? i + 1 : 32 - i;
      const float* cr = a.in[12] + ((l * 48 + g) * 16 + c) * 64 + p0; const float* ci = a.in[13] + ((l * 48 + g) * 16 + c) * 64 + p0;
      const float* aw = APWp + ((size_t)((g * 2 + dir) * 33 + e) * 64 + p0) * 2;
#pragma unroll 2
      for (int p4 = 0; p4 < 32; p4 += 4) { const f32x4 Cr = *(const f32x4*)(cr + p4), Ci = *(const f32x4*)(ci + p4), w0 = *(const f32x4*)(aw + p4 * 2), w1 = *(const f32x4*)(aw + p4 * 2 + 4);
          u32x4 ww; ww.x = cvt_pk_bf16(Cr[0] * w0[0] - Ci[0] * w0[1], -(Cr[0] * w0[1] + Ci[0] * w0[0])); ww.y = cvt_pk_bf16(Cr[1] * w0[2] - Ci[1] * w0[3], -(Cr[1] * w0[3] + Ci[1] * w0[2]));
          ww.z = cvt_pk_bf16(Cr[2] * w1[0] - Ci[2] * w1[1], -(Cr[2] * w1[1] + Ci[2] * w1[0])); ww.w = cvt_pk_bf16(Cr[3] * w1[2] - Ci[3] * w1[3], -(Cr[3] * w1[3] + Ci[3] * w1[2]));
          *(u32x4*)(rowp + 512 + dir * 128 + (p0 + p4) * 2) = ww; } }
}

__device__ __forceinline__ void winbf_task(LAS unsigned char* lds, const float* w_in_l, bf16_t* dst, int task) {
    const int tid = tid_l(), g = task & 3, k0 = (task >> 2) * 64;
    LAS float* Wt = (LAS float*)lds;
    LAS float* tc = Wt + 64 * 128; LAS float* ts = tc + 128;
    { const int k = tid >> 3, c16 = (tid & 7) * 16; const float* s = w_in_l + (size_t)(k0 + k) * INW + 1536 + g * 128 + c16;
#pragma unroll
      for (int q = 0; q < 4; ++q) *(LAS f32x4*)(Wt + k * 128 + c16 + q * 4) = *(const f32x4*)(s + q * 4); }
    if (tid < 128) { float sn, cs; sincospif((float)tid * (1.0f / 64.0f), &sn, &cs); tc[tid] = cs; ts[tid] = sn; }
    __syncthreads();
    const int cp = tid & 127, kq = tid >> 7;
    float aC[16], aS[16];
#pragma unroll
    for (int kk = 0; kk < 16; ++kk) { aC[kk] = 0.f; aS[kk] = 0.f; }
    for (int c = 0; c < 128; ++c) { const int idx = (c * cp) & 127; const float vc = tc[idx], vs = ts[idx];
#pragma unroll
        for (int kk = 0; kk < 16; ++kk) { const float w = Wt[(kq * 16 + kk) * 128 + c]; aC[kk] += w * vc; aS[kk] += w * vs; } }
    bf16_t* dc = dst + (size_t)(g * 128 + cp) * 2048 + k0 + kq * 16; bf16_t* ds = dst + (size_t)(512 + g * 128 + cp) * 2048 + k0 + kq * 16;
    u32x4 w; w.x = cvt_pk_bf16(aC[0], aC[1]); w.y = cvt_pk_bf16(aC[2], aC[3]); w.z = cvt_pk_bf16(aC[4], aC[5]); w.w = cvt_pk_bf16(aC[6], aC[7]); *(u32x4*)dc = w;
    w.x = cvt_pk_bf16(aC[8], aC[9]); w.y = cvt_pk_bf16(aC[10], aC[11]); w.z = cvt_pk_bf16(aC[12], aC[13]); w.w = cvt_pk_bf16(aC[14], aC[15]); *(u32x4*)(dc + 8) = w;
    w.x = cvt_pk_bf16(aS[0], aS[1]); w.y = cvt_pk_bf16(aS[2], aS[3]); w.z = cvt_pk_bf16(aS[4], aS[5]); w.w = cvt_pk_bf16(aS[6], aS[7]); *(u32x4*)ds = w;
    w.x = cvt_pk_bf16(aS[8], aS[9]); w.y = cvt_pk_bf16(aS[10], aS[11]); w.z = cvt_pk_bf16(aS[12], aS[13]); w.w = cvt_pk_bf16(aS[14], aS[15]); *(u32x4*)(ds + 8) = w;
    __syncthreads();
}

__device__ __forceinline__ void d256_gen(bf16_t* d256, int bx, int G) {
    for (int idx = bx * NTHREADS + tid_l(); idx < 256 * 512; idx += G * NTHREADS) { const int k1 = idx >> 9, ri = (idx >> 8) & 1, n1 = idx & 255, e = (n1 * k1) & 255;
        float sn, cs; sincospif((float)e * (1.0f / 128.0f), &sn, &cs);
        d256[idx] = f2bf((ri == 0 ? cs : -sn) * 0.0013810679320049757f); }
}
__device__ __forceinline__ void fft16_pass(LAS unsigned char* lds, const bf16_t* zf2, bf16_t* vt, int bx, int G) {
    const int tid = tid_l();
    LAS float* tw = (LAS float*)lds;
    for (int i = tid; i < 4096; i += NTHREADS) { float sn, cs; sincospif((float)i * (1.0f / 2048.0f), &sn, &cs); tw[2 * i] = cs; tw[2 * i + 1] = sn; }
    __syncthreads();
    const int n1 = tid & 255, sub = tid >> 8;
    u32x4 pw0, pw1, pw2, pw3;
    { const int task0 = bx * 2 + sub; if (task0 < 3072) { const bf16_t* src = zf2 + ((size_t)task0 * 256 + n1) * 32; pw0 = *(const u32x4*)src; pw1 = *(const u32x4*)(src + 8); pw2 = *(const u32x4*)(src + 16); pw3 = *(const u32x4*)(src + 24); } }
    for (int task = bx * 2 + sub; task < 3072; task += G * 2) {
        const u32x4 w0 = pw0, w1 = pw1, w2 = pw2, w3 = pw3;
        if (task + G * 2 < 3072) { const bf16_t* src = zf2 + ((size_t)(task + G * 2) * 256 + n1) * 32; pw0 = *(const u32x4*)src; pw1 = *(const u32x4*)(src + 8); pw2 = *(const u32x4*)(src + 16); pw3 = *(const u32x4*)(src + 24); }
        float zr[16], zi[16];
#pragma unroll
        for (int e = 0; e < 4; ++e) { zr[2 * e] = bf_lo(w0[e]); zr[2 * e + 1] = bf_hi(w0[e]); zr[8 + 2 * e] = bf_lo(w1[e]); zr[8 + 2 * e + 1] = bf_hi(w1[e]);
                                      zi[2 * e] = bf_lo(w2[e]); zi[2 * e + 1] = bf_hi(w2[e]); zi[8 + 2 * e] = bf_lo(w3[e]); zi[8 + 2 * e + 1] = bf_hi(w3[e]); }
        float Ar[4][4], Ai[4][4];
#pragma unroll
        for (int q = 0; q < 4; ++q) {
            const float s0r = zr[q] + zr[8 + q], s0i = zi[q] + zi[8 + q], s1r = zr[q] - zr[8 + q], s1i = zi[q] - zi[8 + q];
            const float s2r = zr[4 + q] + zr[12 + q], s2i = zi[4 + q] + zi[12 + q], s3r = zr[4 + q] - zr[12 + q], s3i = zi[4 + q] - zi[12 + q];
            Ar[q][0] = s0r + s2r; Ai[q][0] = s0i + s2i; Ar[q][2] = s0r - s2r; Ai[q][2] = s0i - s2i;
            Ar[q][1] = s1r - s3i; Ai[q][1] = s1i + s3r; Ar[q][3] = s1r + s3i; Ai[q][3] = s1i - s3r; }
        const float c1 = 0.9238795325f, s1 = 0.3826834324f, c2 = 0.7071067812f;
#define CMUL(xr, xi, cr, ci) { const float t_ = xr * (cr) - xi * (ci); xi = xr * (ci) + xi * (cr); xr = t_; }
        CMUL(Ar[1][1], Ai[1][1], c1, s1) CMUL(Ar[1][2], Ai[1][2], c2, c2) CMUL(Ar[1][3], Ai[1][3], s1, c1)
        CMUL(Ar[2][1], Ai[2][1], c2, c2) CMUL(Ar[2][2], Ai[2][2], 0.f, 1.f) CMUL(Ar[2][3], Ai[2][3], -c2, c2)
        CMUL(Ar[3][1], Ai[3][1], s1, c1) CMUL(Ar[3][2], Ai[3][2], -c2, c2) CMUL(Ar[3][3], Ai[3][3], -c1, -s1)
#undef CMUL
        float xr[16], xi[16];
#pragma unroll
        for (int r = 0; r < 4; ++r) {
            const float s0r = Ar[0][r] + Ar[2][r], s0i = Ai[0][r] + Ai[2][r], s1r = Ar[0][r] - Ar[2][r], s1i = Ai[0][r] - Ai[2][r];
            const float s2r = Ar[1][r] + Ar[3][r], s2i = Ai[1][r] + Ai[3][r], s3r = Ar[1][r] - Ar[3][r], s3i = Ai[1][r] - Ai[3][r];
            xr[r] = s0r + s2r; xi[r] = s0i + s2i; xr[r + 8] = s0r - s2r; xi[r + 8] = s0i - s2i;
            xr[r + 4] = s1r - s3i; xi[r + 4] = s1i + s3r; xr[r + 12] = s1r + s3i; xi[r + 12] = s1i - s3r; }
        const int b = task >> 9, gc = task & 511;
        bf16_t* dst = vt + ((size_t)(b * 16) * 512 + gc) * 512 + n1;
#pragma unroll
        for (int k2 = 0; k2 < 16; ++k2) { const int idx = (n1 * k2) & 4095; const float c = tw[2 * idx], sn = tw[2 * idx + 1];
            dst[(size_t)k2 * 512 * 512] = f2bf(xr[k2] * c - xi[k2] * sn); dst[(size_t)k2 * 512 * 512 + 256] = f2bf(xr[k2] * sn + xi[k2] * c); }
    }
    __syncthreads();
}

template <int MODE>
__device__ __forceinline__ void rms_rows(const float* xp, const float* xs, float* xres, const float* gain, bf16_t* outb, int bx, int G) {
    const int tid = tid_l(), lane = tid & 63, wave = tid >> 6;
    f32x4 gv[8];
#pragma unroll
    for (int it = 0; it < 8; ++it) gv[it] = *(const f32x4*)(gain + it * 256 + lane * 4);
    for (int row = (bx * 8 + wave) * 2; row < T; row += G * 16) {
        f32x4 v[2][8]; float ss[2] = {0.f, 0.f};
#pragma unroll
        for (int rr = 0; rr < 2; ++rr) { const int r_ = row + rr;
            const float* src = MODE == 0 ? (r_ < 16384 ? xp + (size_t)r_ * 2048 : xs + (size_t)(r_ - 16384) * 2048) : xres + (size_t)r_ * 2048;
#pragma unroll
            for (int it = 0; it < 8; ++it) v[rr][it] = *(const f32x4*)(src + it * 256 + lane * 4); }
#pragma unroll
        for (int rr = 0; rr < 2; ++rr) {
#pragma unroll
            for (int it = 0; it < 8; ++it) ss[rr] += v[rr][it][0] * v[rr][it][0] + v[rr][it][1] * v[rr][it][1] + v[rr][it][2] * v[rr][it][2] + v[rr][it][3] * v[rr][it][3];
            ss[rr] = wave_sum(ss[rr]); }
#pragma unroll
        for (int rr = 0; rr < 2; ++rr) { const float r = 1.0f / sqrtf(ss[rr] * (1.0f / 2048.0f) + EPS);
#pragma unroll
            for (int it = 0; it < 8; ++it) {
                const f32x4 o = v[rr][it] * r * gv[it];
                if (MODE == 2) *(f32x4*)(xres + (size_t)(row + rr) * 2048 + it * 256 + lane * 4) = o;
                else { u32x2 w; w.x = cvt_pk_bf16(o[0], o[1]); w.y = cvt_pk_bf16(o[2], o[3]); *(u32x2*)(outb + (size_t)(row + rr) * 2048 + it * 256 + lane * 4) = w; }
            } }
    }
}

__device__ __forceinline__ void outnorm_rows(bf16_t* y, const float* og, int bx, int G) {
    const int tid = tid_l(), lane = tid & 63, wave = tid >> 6;
    for (int row = (bx * 8 + wave) * 2; row < T; row += G * 16) {
        u32x4 w[2][4]; float ss[2][3];
#pragma unroll
        for (int rr = 0; rr < 2; ++rr)
#pragma unroll
            for (int it = 0; it < 4; ++it) w[rr][it] = *(const u32x4*)(y + (size_t)(row + rr) * 2048 + (it * 64 + lane) * 8);
#pragma unroll
        for (int rr = 0; rr < 2; ++rr) { ss[rr][0] = 0.f; ss[rr][1] = 0.f; ss[rr][2] = 0.f;
#pragma unroll
            for (int it = 0; it < 4; ++it) { const int ch = it * 64 + lane; float s = 0.f;
#pragma unroll
                for (int q = 0; q < 4; ++q) { const float a0 = bf_lo(w[rr][it][q]), a1 = bf_hi(w[rr][it][q]); s += a0 * a0 + a1 * a1; }
                const int seg = ch < 96 ? 0 : (ch < 160 ? 1 : 2);
                ss[rr][0] += seg == 0 ? s : 0.f; ss[rr][1] += seg == 1 ? s : 0.f; ss[rr][2] += seg == 2 ? s : 0.f; }
            ss[rr][0] = wave_sum(ss[rr][0]); ss[rr][1] = wave_sum(ss[rr][1]); ss[rr][2] = wave_sum(ss[rr][2]); }
#pragma unroll
        for (int rr = 0; rr < 2; ++rr) {
            const float r0 = 1.0f / sqrtf(ss[rr][0] * (1.0f / 768.0f) + EPS), r1 = 1.0f / sqrtf(ss[rr][1] * (1.0f / 512.0f) + EPS), r2 = 1.0f / sqrtf(ss[rr][2] * (1.0f / 768.0f) + EPS);
#pragma unroll
            for (int it = 0; it < 4; ++it) { const int ch = it * 64 + lane; const float r = ch < 96 ? r0 : (ch < 160 ? r1 : r2);
                const f32x4 g0 = *(const f32x4*)(og + ch * 8), g1 = *(const f32x4*)(og + ch * 8 + 4);
                const u32x4 ww = w[rr][it];
                u32x4 o; o.x = cvt_pk_bf16(bf_lo(ww.x) * r * g0[0], bf_hi(ww.x) * r * g0[1]); o.y = cvt_pk_bf16(bf_lo(ww.y) * r * g0[2], bf_hi(ww.y) * r * g0[3]);
                o.z = cvt_pk_bf16(bf_lo(ww.z) * r * g1[0], bf_hi(ww.z) * r * g1[1]); o.w = cvt_pk_bf16(bf_lo(ww.w) * r * g1[2], bf_hi(ww.w) * r * g1[3]);
                *(u32x4*)(y + (size_t)(row + rr) * 2048 + ch * 8) = o; } }
    }
}

__device__ __forceinline__ void gmlp_task(LAS unsigned char* lds, const bf16_t* zina, const bf16_t* wsb, const float* vg, const float* bs, bf16_t* y, int task) {
    const int tid = tid_l(), lane = tid & 63, wid = tid >> 6, fr = lane & 15, fq = lane >> 4;
    const int cidx = task / 6, h = task - cidx * 6, t0 = cidx * 128;
    LAS bf16_t* vT = (LAS bf16_t*)lds;
    { const int k = tid >> 2, dq = (tid & 3) * 32;
      const bf16_t* src = zina + (size_t)(t0 + k) * 1536 + 768 + h * 128 + dq;
      u32x4 w[4]; float ss = 0.f;
#pragma unroll
      for (int q = 0; q < 4; ++q) { w[q] = *(const u32x4*)(src + q * 8);
#pragma unroll
          for (int e = 0; e < 4; ++e) { const float a0 = bf_lo(w[q][e]), a1 = bf_hi(w[q][e]); ss += a0 * a0 + a1 * a1; } }
      ss += __shfl_xor(ss, 1); ss += __shfl_xor(ss, 2);
      const float r = 1.0f / sqrtf(ss * (1.0f / 128.0f) + EPS);
#pragma unroll
      for (int q = 0; q < 4; ++q)
#pragma unroll
          for (int e = 0; e < 4; ++e) { const int d = dq + q * 8 + e * 2;
              vT[d * 136 + k] = f2bf(bf_lo(w[q][e]) * r * vg[h * 128 + d]); vT[(d + 1) * 136 + k] = f2bf(bf_hi(w[q][e]) * r * vg[h * 128 + d + 1]); } }
    __syncthreads();
    const int q0 = (wid >> 1) * 32, d0 = (wid & 1) * 64;
    f32x4 acc[2][4];
#pragma unroll
    for (int mq = 0; mq < 2; ++mq)
#pragma unroll
        for (int nd = 0; nd < 4; ++nd) acc[mq][nd] = (f32x4){0.f, 0.f, 0.f, 0.f};
#pragma unroll
    for (int ks = 0; ks < 4; ++ks) {
        bf16x8 af[2], bfr[4];
#pragma unroll
        for (int mq = 0; mq < 2; ++mq) af[mq] = *(const bf16x8*)(wsb + (size_t)(h * 128 + q0 + mq * 16 + fr) * 128 + ks * 32 + fq * 8);
#pragma unroll
        for (int nd = 0; nd < 4; ++nd) bfr[nd] = *(const LAS bf16x8*)(vT + (d0 + nd * 16 + fr) * 136 + ks * 32 + fq * 8);
#pragma unroll
        for (int mq = 0; mq < 2; ++mq)
#pragma unroll
            for (int nd = 0; nd < 4; ++nd) acc[mq][nd] = __builtin_amdgcn_mfma_f32_16x16x32_bf16(bfr[nd], af[mq], acc[mq][nd], 0, 0, 0);
    }
    u32x2 uq[2][4];
#pragma unroll
    for (int mq = 0; mq < 2; ++mq)
#pragma unroll
        for (int nd = 0; nd < 4; ++nd) uq[mq][nd] = *(const u32x2*)(zina + (size_t)(t0 + q0 + mq * 16 + fr) * 1536 + h * 128 + d0 + nd * 16 + 4 * fq);
#pragma unroll
    for (int mq = 0; mq < 2; ++mq) { const int q = q0 + mq * 16 + fr; const float b = bs[h * 128 + q];
#pragma unroll
        for (int nd = 0; nd < 4; ++nd) { const int d = d0 + nd * 16 + 4 * fq;
            const u32x2 uu = uq[mq][nd];
            const f32x4 m = acc[mq][nd] + b;
            u32x2 o; o.x = cvt_pk_bf16(bf_lo(uu.x) * m[0], bf_hi(uu.x) * m[1]); o.y = cvt_pk_bf16(bf_lo(uu.y) * m[2], bf_hi(uu.y) * m[3]);
            *(u32x2*)(y + (size_t)(t0 + q) * 2048 + h * 128 + d) = o; } }
    __syncthreads();
}

__device__ __forceinline__ void carry_scan(const float* xs, const float* ALp, bf16_t* ucat, int bx) {
    const int idx = bx * NTHREADS + tid_l();
    if (idx >= 48 * 6 * 128) return;
    const int p = idx & 63, dir = (idx >> 6) & 1, b = (idx >> 7) % 6, g = idx / 768;
    const f32x2 aL = *(const f32x2*)(ALp + ((g * 2 + dir) * 64 + p) * 2);
    float hr = 0.f, hi = 0.f;
#pragma unroll 32
    for (int s = 0; s < 128; ++s) { const int c = dir == 0 ? s : 127 - s; const size_t chunk = (size_t)g * 768 + b * 128 + c;
        const f32x2 x = *(const f32x2*)(xs + chunk * 256 + dir * 128 + p * 2);
        *(unsigned*)(ucat + chunk * 768 + 512 + dir * 128 + p * 2) = cvt_pk_bf16(hr, hi);
        const float nr = aL.x * hr - aL.y * hi + x.x, ni = aL.x * hi + aL.y * hr + x.y; hr = nr; hi = ni; }
}

#define XB_TMO      128
#define XB_XCNT(j)  (256  + 64 * (j))
#define XB_XSUB(j)  (1280 + 64 * (j))
#define XB_XGEN(j)  (2304 + 64 * (j))
#define XB_TOP      3328
#define XB_TOPGEN   3392
#define XCD_BAR_WORDS 3456
#define XB_SPIN_CAP (1u << 22)
__device__ __forceinline__ unsigned xb_ld(unsigned* p)              { return __hip_atomic_load(p, __ATOMIC_RELAXED, __HIP_MEMORY_SCOPE_AGENT); }
__device__ __forceinline__ unsigned xb_add(unsigned* p, unsigned v) { return __hip_atomic_fetch_add(p, v, __ATOMIC_RELAXED, __HIP_MEMORY_SCOPE_AGENT); }
__device__ __forceinline__ unsigned xb_xcc_id() { return (unsigned)__builtin_amdgcn_s_getreg((3 << 11) | 20) & 0xFu; }
#define XB_SPIN(cond, bar) do { unsigned _sp = 0; while (cond) { __builtin_amdgcn_s_sleep(1); \
    if ((++_sp & 255u) == 0u) { if (xb_ld(&(bar)[XB_TMO])) break; if (_sp > XB_SPIN_CAP) { atomicAdd(&(bar)[XB_TMO], 1u); break; } } } } while (0)
struct XcdBarrier { unsigned* bar; unsigned x; volatile LAS unsigned* st; };
__device__ __forceinline__ XcdBarrier xcd_barrier_post(unsigned* bar, volatile LAS unsigned* st) {
    XcdBarrier b; b.bar = bar; b.x = xb_xcc_id(); b.st = st;
    if (threadIdx.x == 0) (void)xb_add(&bar[XB_XCNT(b.x)], 1u);
    return b;
}
__device__ __forceinline__ void xcd_barrier_complete(unsigned* bar, unsigned x, unsigned& nloc, unsigned& nx) {
    const unsigned Gt = gridDim.x * gridDim.y * gridDim.z;
    unsigned sum, cnt, mine, sp = 0u;
    for (;;) {
        sum = 0u; cnt = 0u; mine = 0u;
#pragma unroll
        for (unsigned j = 0; j < 16; ++j) { const unsigned c = xb_ld(&bar[XB_XCNT(j)]); sum += c; cnt += (c > 0u) ? 1u : 0u; mine = (j == x) ? c : mine; }
        if (sum == Gt) break;
        __builtin_amdgcn_s_sleep(1);
        if ((++sp & 255u) == 0u) { if (xb_ld(&bar[XB_TMO])) break; if (sp > XB_SPIN_CAP) { atomicAdd(&bar[XB_TMO], 1u); break; } }
    }
    nloc = mine > 0u ? mine : 1u; nx = cnt > 0u ? cnt : 1u;
}
__device__ __forceinline__ void xcd_barrier(const XcdBarrier& b) {
    asm volatile("s_waitcnt vmcnt(0)" ::: "memory");
    __syncthreads();
    if (threadIdx.x == 0) {
        unsigned* bar = b.bar;
        __builtin_amdgcn_s_waitcnt(0);
        unsigned nloc = b.st[0], nx = b.st[1];
        if (nloc == 0u) { xcd_barrier_complete(bar, b.x, nloc, nx); b.st[0] = nloc; b.st[1] = nx; }
        const unsigned old = xb_add(&bar[XB_XSUB(b.x)], 1u);
        const unsigned gen = old / nloc;
        if (old + 1u == (gen + 1u) * nloc) {
            __builtin_amdgcn_fence(__ATOMIC_RELEASE, "agent");
            asm volatile("s_waitcnt vmcnt(0)" ::: "memory");
            const unsigned og = xb_add(&bar[XB_TOP], 1u);
            const unsigned tg = og / nx;
            if (og + 1u == (tg + 1u) * nx) xb_add(&bar[XB_TOPGEN], 1u);
            else XB_SPIN(xb_ld(&bar[XB_TOPGEN]) == tg, bar);
            __builtin_amdgcn_fence(__ATOMIC_ACQUIRE, "agent");
            xb_add(&bar[XB_XGEN(b.x)], 1u);
            asm volatile("s_waitcnt vmcnt(0)" ::: "memory");
        } else {
            XB_SPIN(xb_ld(&bar[XB_XGEN(b.x)]) == gen, bar);
            __builtin_amdgcn_fence(__ATOMIC_ACQUIRE, "agent");
            asm volatile("s_waitcnt vmcnt(0)" ::: "memory");
        }
    }
    __syncthreads();
}

__device__ __forceinline__ void grid_bar(unsigned* cnt, unsigned target) {
    asm volatile("s_waitcnt vmcnt(0)" ::: "memory");
    __syncthreads();
    if (threadIdx.x == 0) {
        __builtin_amdgcn_fence(__ATOMIC_RELEASE, "agent");
        asm volatile("s_waitcnt vmcnt(0)" ::: "memory");
        (void)__hip_atomic_fetch_add(cnt, 1u, __ATOMIC_RELAXED, __HIP_MEMORY_SCOPE_AGENT);
        unsigned sp = 0;
        while (__hip_atomic_load(cnt, __ATOMIC_RELAXED, __HIP_MEMORY_SCOPE_AGENT) < target) { __builtin_amdgcn_s_sleep(1); if (++sp > (1u << 22)) break; }
        __builtin_amdgcn_fence(__ATOMIC_ACQUIRE, "agent");
        asm volatile("s_waitcnt vmcnt(0)" ::: "memory");
    }
    __syncthreads();
}

constexpr int N_PHASES = 23;
__global__ void __launch_bounds__(NTHREADS, 2) mega_fwd(Args a) {
    extern __shared__ __attribute__((aligned(16))) unsigned char lds_raw[];
    LAS unsigned char* lds = (LAS unsigned char*)lds_raw;
    cg::grid_group grid = cg::this_grid();
#define WINAC ((bf16_t*)(ws + WS_WINAC))
#define WINBF ((bf16_t*)(ws + WS_WINBF))
#define WOUT  ((bf16_t*)(ws + WS_WOUT))
#define WGLU  ((bf16_t*)(ws + WS_WGLU))
#define WSB   ((bf16_t*)(ws + WS_WS))
#define WGU   ((bf16_t*)(ws + WS_WGU))
#define WDOWN ((bf16_t*)(ws + WS_WDOWN))
#define VT    ((bf16_t*)(ws + WS_VT))
#define D256  ((bf16_t*)(ws + WS_D256))
#define AL    ((float*)(ws + WS_AL))
#define SLOT1 ((bf16_t*)(ws + WS_SLOT1))
#define ZINA  ((bf16_t*)(ws + WS_ZINA))
#define ZFT   ((bf16_t*)(ws + WS_ZFT))
#define YCPRE ((bf16_t*)(ws + WS_YCPRE))
#define UCAT  ((bf16_t*)(ws + WS_UCAT))
#define XS    ((float*)(ws + WS_XS))
#define TE    ((bf16_t*)(ws + WS_TE))
#define GM    ((bf16_t*)(ws + WS_GM))
#define HID   ((bf16_t*)(ws + WS_HID))
    int ph = 0; unsigned nbar = 0;
    volatile LAS unsigned* xst = (volatile LAS unsigned*)(lds + 131072);
    if (threadIdx.x == 0) { xst[0] = 0u; xst[1] = 0u; }
    __syncthreads();
    const XcdBarrier xbar = xcd_barrier_post((unsigned*)(a.ws + WS_CTL), xst);
#define GRID_SYNC() do { if (a.ph_lo > 4096) { grid.sync(); } else { xcd_barrier(xbar); } ++nbar; } while (0)
#ifndef ONLY_PH
#define ONLY_PH -1
#endif
#ifndef PROBE_DUP
#define PROBE_DUP -1
#endif
#define PH_BEGIN(k) if ((ONLY_PH < 0 || ONLY_PH == (k)) && ph >= a.ph_lo && ph < a.ph_hi) { const int nrep_ = ((k) == PROBE_DUP) ? 2 : 1; for (int rep_ = 0; rep_ < nrep_; ++rep_) { unsigned char* ws = a.ws; float* X = a.out; int bx = blockIdx.x, G = gridDim.x; asm volatile("; PHASEMARK %4" : "+s"(ws), "+s"(X), "+s"(bx), "+s"(G) : "i"(k));
#define PH_END   if (rep_ + 1 < nrep_) GRID_SYNC(); } if (ph + 1 < a.ph_hi) GRID_SYNC(); } ++ph;

#define FFN_CONVERT(t0, t1) do { if (bx >= 32) { \
        const FfnCtx fc{a.in[20] + (size_t)l * 2048 * DFF, a.in[21] + (size_t)l * 2048 * DFF, a.in[22] + (size_t)l * DFF * 2048, WGU, WDOWN}; \
        transpose_run<SelFfn>(lds, fc, (t0) + bx - 32, (t1), G - 32); } } while (0)
#pragma unroll 1
    for (int l = 0; l < 2; ++l) {
        PH_BEGIN(0)
            for (int g = bx; g < NGRP; g += G) s5_group_a(lds, a, l, g);
            for (int t = G - 1 - bx; t < NGRP * 8; t += G) s5_ktab(lds, a, l, t);
            for (int t = (bx + G - 48) % G; t < 128; t += G) winbf_task(lds, a.in[3] + (size_t)l * 2048 * INW, WINBF, t);
            if (l == 0) d256_gen(D256, bx, G);
            {
                const float* s = a.in[5] + (size_t)l * 6 * 128 * 128;
                for (int i = bx * NTHREADS + tid_l(); i < 6 * 128 * 128 / 2; i += G * NTHREADS) ((unsigned*)WSB)[i] = cvt_pk_bf16(s[2 * i], s[2 * i + 1]);
            }
            {
                const TrDesc td[4] = {
                    {a.in[3] + (size_t)l * 2048 * INW, INW, 2048, 0, 1536, WINAC, 0, 0},
                    {a.in[3] + (size_t)l * 2048 * INW, INW, 2048, 2048, 768, WINAC, 0, 1536},
                    {a.in[18] + (size_t)l * 2048 * 2048, 2048, 2048, 0, 2048, WOUT, 0, 0},
                    {a.in[15] + (size_t)l * 768 * 768, 768, 768, 0, 768, WGLU, 0, 0}};
                const int ntile[4] = {32 * 6, 32 * 3, 32 * 8, 12 * 3};
#pragma unroll
                for (int m = 0; m < 4; ++m) transpose_run<SelOne>(lds, td[m], bx, ntile[m], G);
            }
            if (l == 0) rms_rows<0>(a.in[0], a.in[1], X, a.in[2], SLOT1, bx, G);
            else        rms_rows<1>(nullptr, nullptr, X, a.in[2] + l * 2048, SLOT1, bx, G);
        PH_END
        PH_BEGIN(1)
            { pg8::Sched S{(const char*)SLOT1, (const char*)WINAC, 0, 0, 2048, 2048, T / 256, 9, 1, G, bx, 0, 4}; EpiWin E{ZINA, UCAT}; pg8::gemm_phase(lds, S, 2048, E); }
            { pg8::Sched S{(const char*)WINBF, (const char*)SLOT1, 0, 0, 2048, 2048, 4, T / 256, 1, G, G - 1 - bx, 1, 8}; EpiZft2 E{ZFT}; pg8::gemm_phase(lds, S, 2048, E); }
        PH_END
        PH_BEGIN(2)
            fft16_pass(lds, ZFT, VT, bx, G);
            { pg8::Sched S{(const char*)UCAT, (const char*)GM, (long)768 * 768 * 2, (long)256 * 512 * 2, 768, 512, 3, 1, NGRP, G, bx, 0, 8}; EpiXs E{XS}; pg8::gemm_phase(lds, S, 512, E); }
            for (int t = G - 1 - bx; t < 192 * 6; t += G) gmlp_task(lds, ZINA, WSB, a.in[4] + l * 768, a.in[6] + l * 768, SLOT1, t);
            for (int t = bx; t < NGRP * 4; t += G) s5_te(a, l, t);
        PH_END
        PH_BEGIN(3)
            if (bx < 72) carry_scan(XS, AL, UCAT, bx);
            if (bx >= 64) { pg8::Sched S{(const char*)D256, (const char*)VT, 0, 0, 512, 512, 1, 192, 1, G - 64, bx - 64, 0, 8}; EpiFour2 E{SLOT1}; pg8::gemm_phase(lds, S, 512, E); }
        PH_END
        PH_BEGIN(4)
            { pg8::Sched S{(const char*)UCAT, (const char*)TE, (long)768 * 768 * 2, (long)512 * 768 * 2, 768, 768, 3, 2, NGRP, G, bx, 0, 8}; EpiYc E{YCPRE}; pg8::gemm_phase(lds, S, 768, E); }
            FFN_CONVERT(0, 1056);
        PH_END
        PH_BEGIN(5)
            { pg8::Sched S{(const char*)YCPRE, (const char*)WGLU, 0, 0, 768, 768, T / 256, 3, 1, G, bx, 0, 4}; EpiGlu E{YCPRE, a.in[16] + l * 768, SLOT1}; pg8::gemm_phase(lds, S, 768, E); }
            FFN_CONVERT(1056, 2112);
        PH_END
        PH_BEGIN(6)
            outnorm_rows(SLOT1, a.in[17] + l * 2048, bx, G);
        PH_END
        PH_BEGIN(7)
            { pg8::Sched S{(const char*)SLOT1, (const char*)WOUT, 0, 0, 2048, 2048, T / 256, 8, 1, G, bx, 0, 4}; EpiRes E{X, l == 0 ? a.in[0] : X, (l == 0 ? a.in[1] : X + (size_t)16384 * 2048) - (size_t)16384 * 2048}; pg8::gemm_phase(lds, S, 2048, E); }
        PH_END
        PH_BEGIN(8)
            rms_rows<1>(nullptr, nullptr, X, a.in[19] + l * 2048, SLOT1, bx, G);
        PH_END
        PH_BEGIN(9)
            { pg8::Sched S{(const char*)SLOT1, (const char*)WGU, 0, 0, 2048, 2048, T / 256, 44, 1, G, bx, 0, 4}; EpiSwi E{HID}; pg8::gemm_phase(lds, S, 2048, E); }
        PH_END
        PH_BEGIN(10)
            { pg8::Sched S{(const char*)HID, (const char*)WDOWN, 0, 0, DFF, DFF, T / 256, 8, 1, G, bx, 0, 4}; EpiRes E{X, X, X}; pg8::gemm_phase(lds, S, DFF, E); }
        PH_END
    }
    PH_BEGIN(11)
        rms_rows<2>(nullptr, nullptr, X, a.in[23], nullptr, bx, G);
    PH_END
#undef PH_BEGIN
#undef PH_END
}

extern "C" void kernel_launch(void* const* d_in, const int* in_sizes, int n_in, void* d_out, int out_size, void* d_ws, size_t ws_size, hipStream_t stream) {
    static int grid = 0;
    if (grid == 0) {
        if (n_in != 24 || out_size != T * DM || ws_size < WS_END) { fprintf(stderr, "kernel_launch: unexpected shapes / workspace (n_in %d out %d ws %zu need %zu)\n", n_in, out_size, ws_size, (size_t)WS_END); grid = -1; return; }
        int dev = 0, cus = 0, per_cu = 0;
        if (hipGetDevice(&dev) != hipSuccess || hipDeviceGetAttribute(&cus, hipDeviceAttributeMultiprocessorCount, dev) != hipSuccess) { grid = -1; return; }
        if (hipFuncSetAttribute((const void*)mega_fwd, hipFuncAttributeMaxDynamicSharedMemorySize, LDS_BYTES) != hipSuccess) { fprintf(stderr, "kernel_launch: hipFuncSetAttribute failed\n"); grid = -1; return; }
        if (hipOccupancyMaxActiveBlocksPerMultiprocessor(&per_cu, (const void*)mega_fwd, NTHREADS, LDS_BYTES) != hipSuccess || per_cu < 1) { fprintf(stderr, "kernel_launch: occupancy query says %d\n", per_cu); per_cu = 1; }
        (void)hipGetLastError();
        grid = cus * 1;
    }
    if (grid < 0) return;
    if (hipMemsetAsync((char*)d_ws + WS_CTL, 0, 16384, stream) != hipSuccess) { fprintf(stderr, "kernel_launch: memset of the barrier word failed\n"); return; }
    Args a{};
    for (int i = 0; i < 24; ++i) a.in[i] = (const float*)d_in[i];
    a.out = (float*)d_out; a.ws = (unsigned char*)d_ws;
#if MK_ONE_LAUNCH
    a.ph_lo = 0; a.ph_hi = N_PHASES;
    void* args[] = {&a};
    hipError_t e = hipLaunchCooperativeKernel((const void*)mega_fwd, dim3(grid), dim3(NTHREADS), args, LDS_BYTES, stream);
    if (e != hipSuccess) fprintf(stderr, "cooperative launch failed: %s (grid %d)\n", hipGetErrorString(e), grid);
#else
    for (int p = 0; p < N_PHASES; ++p) {
        a.ph_lo = p; a.ph_hi = p + 1;
        hipLaunchKernelGGL(mega_fwd, dim3(grid), dim3(NTHREADS), LDS_BYTES, stream, a);
    }
#endif
}
```

```cpp
#include <hip/hip_runtime.h>
#include <hip/hip_cooperative_groups.h>
#include <cstdio>
#include <cstdint>
namespace cg = cooperative_groups;

#ifndef MK_ONE_LAUNCH
#define MK_ONE_LAUNCH 1
#endif

#define LAS __attribute__((address_space(3)))
typedef unsigned short bf16_t;
typedef short bf16x8 __attribute__((ext_vector_type(8)));
typedef float f32x4 __attribute__((ext_vector_type(4)));
typedef float f32x2 __attribute__((ext_vector_type(2)));
typedef unsigned u32x4 __attribute__((ext_vector_type(4)));
typedef unsigned u32x2 __attribute__((ext_vector_type(2)));

constexpr int T = 24576, DM = 2048, NBATCH = 6, SEQ = 4096, DFF = 5632, INW = 2816;
constexpr int NGRP = 48, NCHUNK = T / 32;
constexpr float EPS = 1e-6f;
constexpr int NTHREADS = 512;
constexpr int LDS_BYTES = 131072 + 1024;

constexpr size_t WS_WINAC = 0;
constexpr size_t WS_WINBF = WS_WINAC + (size_t)2304 * 2048 * 2;
constexpr size_t WS_WOUT  = WS_WINBF + (size_t)1024 * 2048 * 2;
constexpr size_t WS_WGLU  = WS_WOUT + (size_t)2048 * 2048 * 2;
constexpr size_t WS_WS    = WS_WGLU + (size_t)768 * 768 * 2;
constexpr size_t WS_WGU   = WS_WS + (size_t)6 * 128 * 128 * 2;
constexpr size_t WS_WDOWN = WS_WGU + (size_t)11264 * 2048 * 2;
constexpr size_t WS_DFT   = WS_WDOWN + (size_t)2048 * 5632 * 2;
constexpr size_t WS_VT    = WS_DFT;
constexpr size_t WS_D256  = WS_DFT + (size_t)49152 * 512 * 2;
constexpr size_t WS_AL    = WS_DFT + (size_t)4096 * 8192 * 2;
constexpr size_t WS_APW   = WS_AL + (size_t)48 * 2 * 64 * 2 * 4;
constexpr size_t WS_KT    = WS_APW + (size_t)48 * 2 * 33 * 64 * 2 * 4;
constexpr size_t WS_SLOT1 = WS_KT + (size_t)48 * 2 * 32 * 256 * 4;
constexpr size_t WS_ACT   = WS_SLOT1 + (size_t)T * 2048 * 2;
constexpr size_t WS_ZINA  = WS_ACT;
constexpr size_t WS_ZFT   = WS_ZINA + (size_t)T * 1536 * 2;
constexpr size_t WS_YCPRE = WS_ZFT;
constexpr size_t WS_UCAT  = WS_ZFT + (size_t)512 * 49152 * 2;
constexpr size_t WS_XS    = WS_UCAT + (size_t)48 * 768 * 768 * 2;
constexpr size_t WS_TE    = WS_XS + (size_t)48 * 768 * 256 * 4;
constexpr size_t WS_GM    = WS_TE + (size_t)48 * 512 * 768 * 2;
constexpr size_t WS_MIXEND = WS_GM + (size_t)48 * 256 * 512 * 2;
constexpr size_t WS_HID   = WS_ACT;
constexpr size_t WS_CTL   = WS_ACT + (size_t)T * 5632 * 2;
constexpr size_t WS_END   = WS_CTL + 16384;
static_assert(WS_MIXEND <= WS_CTL, "mixer buffers must fit under the FFN hidden buffer");

struct Args { const float* in[24]; float* out; unsigned char* ws; int ph_lo, ph_hi; };

__device__ __forceinline__ int tid_l() { int t = threadIdx.x; asm volatile("" : "+v"(t)); return t; }
__device__ __forceinline__ unsigned cvt_pk_bf16(float lo, float hi) { unsigned r; asm("v_cvt_pk_bf16_f32 %0, %1, %2" : "=v"(r) : "v"(lo), "v"(hi)); return r; }
__device__ __forceinline__ float bf_lo(unsigned w) { return __uint_as_float(w << 16); }
__device__ __forceinline__ float bf_hi(unsigned w) { return __uint_as_float(w & 0xffff0000u); }
__device__ __forceinline__ bf16_t f2bf(float f) { return (bf16_t)(cvt_pk_bf16(f, 0.f) & 0xffffu); }
__device__ __forceinline__ float sigmoid_f(float v) { return __builtin_amdgcn_rcpf(1.0f + __builtin_amdgcn_exp2f(-1.4426950409f * v)); }
__device__ __forceinline__ float gelu_tanh(float x) { const float z = x * (1.5957691216f + 0.0713548163f * x * x); return x * sigmoid_f(z); }
__device__ __forceinline__ float wave_sum(float v) {
#pragma unroll
    for (int o = 32; o >= 1; o >>= 1) v += __shfl_xor(v, o);
    return v;
}

namespace pg8 {
constexpr int BM = 256, BK = 64, HALF = 128, HTB = HALF * BK * 2, STAGE_BYTES = 8 * HTB, NXCD = 8, WGM = 8;
__device__ __forceinline__ int lds_byte(int r, int c) { const int st = (r >> 4) * 2 + (c >> 5), rr = r & 15, cc = c & 31, ob = rr * 64 + cc * 2; return st * 1024 + (ob ^ (((ob >> 9) & 1) << 5)); }
__device__ __forceinline__ void stage_rc(int b, int& R, int& C) { const int st = b / 1024, sb = b % 1024, swz = sb ^ (((sb >> 9) & 1) << 5); R = (st >> 1) * 16 + swz / 64; C = (st & 1) * 32 + (swz % 64) / 2; }
__device__ __forceinline__ int perm32(int rho) { const int n = rho >> 4, i = rho & 15; return 8 * (i >> 2) + 4 * n + (i & 3); }

struct Unit { const char* A; const char* B; int pm, pn, grp; };
struct Sched {
    const char* A; const char* B; long gsA, gsB; int lda, ldb, nM, nN, nG, G, c, bmap, wgm;
    __device__ __forceinline__ bool next(int i, Unit& u) const {
        const int nwg = nM * nN;
        const long L = (long)i * G + c; if (c < 0 || L >= (long)nwg * nG) return false;
        const int grp = (int)(L / nwg); int wgid = (int)(L - (long)grp * nwg);
        { const int q = nwg / NXCD, r = nwg % NXCD, xcd = wgid % NXCD, off = wgid / NXCD; wgid = (xcd < r ? xcd * (q + 1) : r * (q + 1) + (xcd - r) * q) + off; }
        const int nig = wgm * nN, gid = wgid / nig, fm = gid * wgm, gsz = (nM - fm) < wgm ? (nM - fm) : wgm;
        u.pm = fm + ((wgid % nig) % gsz); u.pn = (wgid % nig) / gsz; u.grp = grp;
        u.A = A + (size_t)grp * gsA + (size_t)u.pm * 512 * lda; u.B = B + (size_t)grp * gsB + (bmap ? (size_t)((u.pn >> 4) * 4096 + (u.pn & 15) * 16) * 2 * ldb : (size_t)u.pn * 512 * ldb);
        return true;
    }
};

template <class Epi>
__device__ __forceinline__ void gemm_phase(LAS unsigned char* lds, const Sched& S, const int K, const Epi& E) {
    int tid = threadIdx.x; asm volatile("" : "+v"(tid));
    const int wid = __builtin_amdgcn_readfirstlane(tid >> 6), lane = tid & 63, wr = wid >> 2, wc = wid & 3, fr = lane & 15, fq = lane >> 4;
    const int nt = K / BK;
    unsigned voffA[2], voffB[2];
#pragma unroll
    for (int i = 0; i < 2; ++i) { int R, C; stage_rc(tid * 16 + i * 8192, R, C); const int Rb = Epi::PERM ? ((R & ~31) + perm32(R & 31)) : R;
        const int RbT = Epi::BMAP ? ((Rb >> 4) + 256 * (Rb & 15)) : Rb;
        voffA[i] = (unsigned)(R * S.lda + C) * 2u; voffB[i] = (unsigned)(RbT * S.ldb + C) * 2u; }
    const size_t kstep = (size_t)(BK * 2);
    const size_t hstepA = (size_t)HALF * S.lda * 2, hstepB = (size_t)(Epi::BMAP ? 8 : HALF) * S.ldb * 2;
    const unsigned ldsw = (unsigned)wid * 1024u;
    const int aoff = lds_byte(wr * 64 + fr, fq * 8), boff = lds_byte(wc * 32 + fr, fq * 8);
#define PG8_SA(b, h) (((b) * 2 + (h)) * HTB)
#define PG8_SB(b, h) ((4 + (b) * 2 + (h)) * HTB)
#define PG8_STAGE(bufoff, gbase, voff) do { _Pragma("unroll") for (int _i = 0; _i < 2; ++_i) \
        __builtin_amdgcn_global_load_lds((const unsigned*)((const char*)(gbase) + (voff)[_i]), (LAS unsigned*)(lds + (bufoff) + ldsw + _i * 8192), 16, 0, 0); } while (0)
#define PG8_LDA(dst, b, h) do { _Pragma("unroll") for (int m = 0; m < 4; ++m) _Pragma("unroll") for (int k = 0; k < 2; ++k) dst[m][k] = *(const LAS bf16x8*)(lds + PG8_SA(b, h) + aoff + m * 2048 + k * 1024); } while (0)
#define PG8_LDB(dst, b, h) do { _Pragma("unroll") for (int n = 0; n < 2; ++n) _Pragma("unroll") for (int k = 0; k < 2; ++k) dst[n][k] = *(const LAS bf16x8*)(lds + PG8_SB(b, h) + boff + n * 2048 + k * 1024); } while (0)
#define PG8_MMA(ai, bj, At, Bt) do { __builtin_amdgcn_s_setprio(1); _Pragma("unroll") for (int m = 0; m < 4; ++m) _Pragma("unroll") for (int n = 0; n < 2; ++n) _Pragma("unroll") for (int k = 0; k < 2; ++k) \
        acc[ai][bj][m][n] = __builtin_amdgcn_mfma_f32_16x16x32_bf16(Bt[n][k], At[m][k], acc[ai][bj][m][n], 0, 0, 0); __builtin_amdgcn_s_setprio(0); } while (0)
#define PG8_WAIT_V(n) asm volatile("s_waitcnt vmcnt(" #n ")" ::: "memory")
#define PG8_WAIT_L(n) asm volatile("s_waitcnt lgkmcnt(" #n ")" ::: "memory")
#define PG8_BAR __builtin_amdgcn_s_barrier()
#define PG8_SCHED __builtin_amdgcn_sched_barrier(0)
    Unit cur, nxt; int ui = 0;
    if (!S.next(0, cur)) return;
    f32x4 acc[2][2][4][2];
#pragma unroll
    for (int a = 0; a < 2; ++a)
#pragma unroll
        for (int b = 0; b < 2; ++b)
#pragma unroll
            for (int m = 0; m < 4; ++m)
#pragma unroll
                for (int n = 0; n < 2; ++n) acc[a][b][m][n] = (f32x4){0.f, 0.f, 0.f, 0.f};
    bf16x8 At[4][2], B0[2][2], B1[2][2];
    const char* cA = cur.A; const char* cB = cur.B;
    PG8_STAGE(PG8_SB(0, 0), cB, voffB); PG8_STAGE(PG8_SB(0, 1), cB + hstepB, voffB); PG8_STAGE(PG8_SA(0, 0), cA, voffA); PG8_STAGE(PG8_SA(0, 1), cA + hstepA, voffA);
    if (wr == 1) PG8_BAR;
    PG8_WAIT_V(2); PG8_BAR;
    PG8_STAGE(PG8_SB(1, 0), cB + kstep, voffB); PG8_STAGE(PG8_SA(1, 0), cA + kstep, voffA); PG8_STAGE(PG8_SB(1, 1), cB + hstepB + kstep, voffB);
    PG8_WAIT_V(6); PG8_BAR;
    for (;;) {
        const bool has_next = S.next(ui + 1, nxt);
        const char* nA = has_next ? nxt.A : cA; const char* nB = has_next ? nxt.B : cB;
        for (int t = 0; t < nt; t += 2) {
            const bool last = (t == nt - 2);
            const char* a1 = cA + (size_t)(t + 1) * kstep;
            const char* a2 = last ? nA : cA + (size_t)(t + 2) * kstep; const char* b2 = last ? nB : cB + (size_t)(t + 2) * kstep;
            const char* a3 = a2 + kstep; const char* b3 = b2 + kstep;
            PG8_LDB(B0, 0, 0); PG8_LDB(B1, 0, 1); PG8_SCHED; PG8_LDA(At, 0, 0); PG8_STAGE(PG8_SA(1, 1), a1 + hstepA, voffA);
            PG8_WAIT_V(8); PG8_WAIT_L(0); PG8_BAR; PG8_MMA(0, 0, At, B0); PG8_MMA(0, 1, At, B1); PG8_BAR; PG8_SCHED;
            PG8_LDA(At, 0, 1); PG8_STAGE(PG8_SB(0, 0), b2, voffB); PG8_STAGE(PG8_SB(0, 1), b2 + hstepB, voffB); PG8_STAGE(PG8_SA(0, 0), a2, voffA);
            PG8_WAIT_V(8); PG8_WAIT_L(0); PG8_BAR; PG8_MMA(1, 0, At, B0); PG8_MMA(1, 1, At, B1); PG8_BAR; PG8_SCHED;
            PG8_LDB(B0, 1, 0); PG8_LDB(B1, 1, 1); PG8_SCHED; PG8_LDA(At, 1, 0); PG8_STAGE(PG8_SA(0, 1), a2 + hstepA, voffA);
            PG8_WAIT_V(8); PG8_WAIT_L(0); PG8_BAR; PG8_MMA(0, 0, At, B0); PG8_MMA(0, 1, At, B1); PG8_BAR; PG8_SCHED;
            PG8_LDA(At, 1, 1); PG8_STAGE(PG8_SB(1, 0), b3, voffB); PG8_STAGE(PG8_SB(1, 1), b3 + hstepB, voffB); PG8_STAGE(PG8_SA(1, 0), a3, voffA);
            PG8_WAIT_V(8); PG8_WAIT_L(0); PG8_BAR; PG8_MMA(1, 0, At, B0); PG8_MMA(1, 1, At, B1); PG8_BAR; PG8_SCHED;
        }
        if (wr == 0) PG8_BAR;
        E(acc, cur, wr, wc, fr, fq);
        if (!has_next) break;
#pragma unroll
        for (int a = 0; a < 2; ++a)
#pragma unroll
            for (int b = 0; b < 2; ++b)
#pragma unroll
                for (int m = 0; m < 4; ++m)
#pragma unroll
                    for (int n = 0; n < 2; ++n) acc[a][b][m][n] = (f32x4){0.f, 0.f, 0.f, 0.f};
        cur = nxt; cA = nA; cB = nB; ++ui;
        if (wr == 1) PG8_BAR;
    }
    PG8_WAIT_V(0);
    PG8_BAR;
#undef PG8_SA
#undef PG8_SB
#undef PG8_STAGE
#undef PG8_LDA
#undef PG8_LDB
#undef PG8_MMA
#undef PG8_WAIT_V
#undef PG8_WAIT_L
#undef PG8_BAR
#undef PG8_SCHED
}
}
using pg8::Unit;
typedef const f32x4 (&AccRef)[2][2][4][2];

__device__ __forceinline__ u32x4 pack8(f32x4 v0, f32x4 v1) { u32x4 w; w.x = cvt_pk_bf16(v0[0], v0[1]); w.y = cvt_pk_bf16(v0[2], v0[3]); w.z = cvt_pk_bf16(v1[0], v1[1]); w.w = cvt_pk_bf16(v1[2], v1[3]); return w; }
__device__ __forceinline__ f32x4 gelu4(f32x4 v) { return (f32x4){gelu_tanh(v[0]), gelu_tanh(v[1]), gelu_tanh(v[2]), gelu_tanh(v[3])}; }

struct EpiWin { static constexpr bool PERM = true; static constexpr int BMAP = 0; bf16_t* zina; bf16_t* ucat;
    __device__ __forceinline__ void operator()(AccRef acc, const Unit& u, int wr, int wc, int fr, int fq) const {
        const int row0 = u.pm * 256 + wr * 64 + fr;
        if (u.pn < 6) {
            const int col0 = u.pn * 256 + wc * 32 + 8 * fq;
#pragma unroll
            for (int ai = 0; ai < 2; ++ai)
#pragma unroll
                for (int m = 0; m < 4; ++m) { bf16_t* rowp = zina + (size_t)(row0 + ai * 128 + m * 16) * 1536 + col0;
#pragma unroll
                    for (int bj = 0; bj < 2; ++bj) *(u32x4*)(rowp + bj * 128) = pack8(gelu4(acc[ai][bj][m][0]), gelu4(acc[ai][bj][m][1])); }
        } else {
            const int cc0 = (u.pn - 6) * 256 + wc * 32 + 8 * fq;
#pragma unroll
            for (int ai = 0; ai < 2; ++ai)
#pragma unroll
                for (int m = 0; m < 4; ++m) { const int t = row0 + ai * 128 + m * 16, n = t >> 5, j = t & 31;
#pragma unroll
                    for (int bj = 0; bj < 2; ++bj) { const int cc = cc0 + bj * 128, g = cc >> 4, c0 = cc & 15;
                        *(u32x4*)(ucat + ((size_t)(g * 768 + n) * 768 + j * 16 + c0)) = pack8(acc[ai][bj][m][0], acc[ai][bj][m][1]); } }
        }
    } };
struct EpiZft2 { static constexpr bool PERM = true; static constexpr int BMAP = 1; bf16_t* zf2;
    __device__ __forceinline__ void operator()(AccRef acc, const Unit& u, int wr, int wc, int fr, int fq) const {
        const int row0 = u.pm * 256 + wr * 64 + fr, b = u.pn >> 4, n1b = (u.pn & 15) * 16 + 2 * wc + (fq >> 1), n20 = (fq & 1) * 8;
#pragma unroll
        for (int ai = 0; ai < 2; ++ai)
#pragma unroll
            for (int m = 0; m < 4; ++m) { const int r = row0 + ai * 128 + m * 16, ri = r >> 9, gc = r & 511;
#pragma unroll
                for (int bj = 0; bj < 2; ++bj) { const int n1 = n1b + 8 * bj;
                    *(u32x4*)(zf2 + ((((size_t)b * 512 + gc) * 256 + n1) * 32 + ri * 16 + n20)) = pack8(acc[ai][bj][m][0], acc[ai][bj][m][1]); } }
    } };
struct EpiFour2 { static constexpr bool PERM = true; static constexpr int BMAP = 0; bf16_t* y;
    __device__ __forceinline__ void operator()(AccRef acc, const Unit& u, int wr, int wc, int fr, int fq) const {
        const int bk = u.pn >> 1, b = bk >> 4, k2 = bk & 15, col0 = 768 + (u.pn & 1) * 256 + wc * 32 + 8 * fq, k10 = wr * 64 + fr;
#pragma unroll
        for (int ai = 0; ai < 2; ++ai)
#pragma unroll
            for (int m = 0; m < 4; ++m) { const int k1 = k10 + ai * 128 + m * 16; bf16_t* rowp = y + (size_t)(b * 4096 + 16 * k1 + k2) * 2048 + col0;
#pragma unroll
                for (int bj = 0; bj < 2; ++bj) *(u32x4*)(rowp + bj * 128) = pack8(acc[ai][bj][m][0], acc[ai][bj][m][1]); }
    } };
struct EpiXs { static constexpr bool PERM = false; static constexpr int BMAP = 0; float* xs;
    __device__ __forceinline__ void operator()(AccRef acc, const Unit& u, int wr, int wc, int fr, int fq) const {
        const int row0 = u.pm * 256 + wr * 64 + fr, col0 = wc * 32 + 4 * fq;
#pragma unroll
        for (int ai = 0; ai < 2; ++ai)
#pragma unroll
            for (int m = 0; m < 4; ++m) { float* rowp = xs + ((size_t)u.grp * 768 + row0 + ai * 128 + m * 16) * 256 + col0;
#pragma unroll
                for (int bj = 0; bj < 2; ++bj)
#pragma unroll
                    for (int n = 0; n < 2; ++n) *(f32x4*)(rowp + bj * 128 + n * 16) = acc[ai][bj][m][n]; }
    } };
struct EpiYc { static constexpr bool PERM = true; static constexpr int BMAP = 0; bf16_t* ycpre;
    __device__ __forceinline__ void operator()(AccRef acc, const Unit& u, int wr, int wc, int fr, int fq) const {
        const int row0 = u.pm * 256 + wr * 64 + fr, col0 = u.pn * 256 + wc * 32 + 8 * fq;
#pragma unroll
        for (int ai = 0; ai < 2; ++ai)
#pragma unroll
            for (int m = 0; m < 4; ++m) { const int n = row0 + ai * 128 + m * 16;
#pragma unroll
                for (int bj = 0; bj < 2; ++bj) { const int col = col0 + bj * 128, i = col >> 4, c0 = col & 15;
                    *(u32x4*)(ycpre + ((size_t)(n * 32 + i) * 768 + u.grp * 16 + c0)) = pack8(gelu4(acc[ai][bj][m][0]), gelu4(acc[ai][bj][m][1])); } }
    } };
struct EpiGlu { static constexpr bool PERM = true; static constexpr int BMAP = 0; const bf16_t* ycpre; const float* bias; bf16_t* y;
    __device__ __forceinline__ void operator()(AccRef acc, const Unit& u, int wr, int wc, int fr, int fq) const {
        const int row0 = u.pm * 256 + wr * 64 + fr, col0 = u.pn * 256 + wc * 32 + 8 * fq;
        f32x4 bv[2][2];
#pragma unroll
        for (int bj = 0; bj < 2; ++bj)
#pragma unroll
            for (int n = 0; n < 2; ++n) bv[bj][n] = *(const f32x4*)(bias + col0 + bj * 128 + 4 * n);
#pragma unroll
        for (int ai = 0; ai < 2; ++ai) {
            u32x4 yc[4][2];
#pragma unroll
            for (int m = 0; m < 4; ++m)
#pragma unroll
                for (int bj = 0; bj < 2; ++bj) yc[m][bj] = *(const u32x4*)(ycpre + (size_t)(row0 + ai * 128 + m * 16) * 768 + col0 + bj * 128);
#pragma unroll
            for (int m = 0; m < 4; ++m) { const size_t t = (size_t)(row0 + ai * 128 + m * 16);
#pragma unroll
                for (int bj = 0; bj < 2; ++bj) { const int col = col0 + bj * 128; const u32x4 w = yc[m][bj];
                    const f32x4 v0 = acc[ai][bj][m][0] + bv[bj][0], v1 = acc[ai][bj][m][1] + bv[bj][1];
                    const f32x4 o0 = (f32x4){bf_lo(w.x) * sigmoid_f(v0[0]), bf_hi(w.x) * sigmoid_f(v0[1]), bf_lo(w.y) * sigmoid_f(v0[2]), bf_hi(w.y) * sigmoid_f(v0[3])};
                    const f32x4 o1 = (f32x4){bf_lo(w.z) * sigmoid_f(v1[0]), bf_hi(w.z) * sigmoid_f(v1[1]), bf_lo(w.w) * sigmoid_f(v1[2]), bf_hi(w.w) * sigmoid_f(v1[3])};
                    *(u32x4*)(y + t * 2048 + 1280 + col) = pack8(o0, o1); } }
            asm volatile("" ::: "memory"); }
    } };
struct EpiRes { static constexpr bool PERM = false; static constexpr int BMAP = 0; float* x; const float* r0; const float* r1adj;
    __device__ __forceinline__ void operator()(AccRef acc, const Unit& u, int wr, int wc, int fr, int fq) const {
        const int row0 = u.pm * 256 + wr * 64 + fr, col0 = u.pn * 256 + wc * 32 + 4 * fq;
        const float* sb = u.pm < 64 ? r0 : r1adj;
#pragma unroll
        for (int ai = 0; ai < 2; ++ai) {
            const size_t off = (size_t)(row0 + ai * 128) * 2048 + col0;
            f32x4 ld[4][2][2];
#pragma unroll
            for (int m = 0; m < 4; ++m)
#pragma unroll
                for (int bj = 0; bj < 2; ++bj)
#pragma unroll
                    for (int n = 0; n < 2; ++n) ld[m][bj][n] = *(const f32x4*)(sb + off + (size_t)m * 16 * 2048 + bj * 128 + n * 16);
#pragma unroll
            for (int m = 0; m < 4; ++m)
#pragma unroll
                for (int bj = 0; bj < 2; ++bj)
#pragma unroll
                    for (int n = 0; n < 2; ++n) *(f32x4*)(x + off + (size_t)m * 16 * 2048 + bj * 128 + n * 16) = ld[m][bj][n] + acc[ai][bj][m][n];
            asm volatile("" ::: "memory"); }
    } };
struct EpiSwi { static constexpr bool PERM = true; static constexpr int BMAP = 0; bf16_t* hid;
    __device__ __forceinline__ void operator()(AccRef acc, const Unit& u, int wr, int wc, int fr, int fq) const {
        const int row0 = u.pm * 256 + wr * 64 + fr, col0 = u.pn * 128 + wc * 32 + 8 * fq;
#pragma unroll
        for (int ai = 0; ai < 2; ++ai)
#pragma unroll
            for (int m = 0; m < 4; ++m) {
                f32x4 o[2];
#pragma unroll
                for (int n = 0; n < 2; ++n) { const f32x4 g = acc[ai][0][m][n], up = acc[ai][1][m][n];
                    o[n] = (f32x4){g[0] * sigmoid_f(g[0]) * up[0], g[1] * sigmoid_f(g[1]) * up[1], g[2] * sigmoid_f(g[2]) * up[2], g[3] * sigmoid_f(g[3]) * up[3]}; }
                *(u32x4*)(hid + (size_t)(row0 + ai * 128 + m * 16) * 5632 + col0) = pack8(o[0], o[1]); }
    } };

struct TrDesc { const float* src; int ldsrc, K, c0, nc; bf16_t* dst; int mode, doff; };
template <class SEL, class CTX>
__device__ __forceinline__ void transpose_run(LAS unsigned char* lds, const CTX& ctx, int t0, int t1, int stride) {
    const int tid = tid_l();
    LAS unsigned* tl = (LAS unsigned*)lds;
    const int k = tid >> 3, n8 = (tid & 7) * 8;
    f32x4 v[4][2];
    TrDesc d; int lt;
    if (t0 < t1) { SEL::get(ctx, t0, d, lt); const int nkt = d.K >> 6, kt = lt % nkt, ct = lt / nkt;
        const float* s = d.src + (size_t)(kt * 64 + k) * d.ldsrc + d.c0 + ct * 256 + n8;
#pragma unroll
        for (int q = 0; q < 4; ++q) { v[q][0] = *(const f32x4*)(s + q * 64); v[q][1] = *(const f32x4*)(s + q * 64 + 4); } }
    for (int t = t0; t < t1; t += stride) {
        SEL::get(ctx, t, d, lt);
        const int nkt = d.K >> 6, kt = lt % nkt, ct = lt / nkt;
        unsigned w[4][4];
#pragma unroll
        for (int q = 0; q < 4; ++q)
#pragma unroll
            for (int j = 0; j < 4; ++j) { const float lo = v[q][0][j], hi = v[q][1][j];
                const float recv = __shfl_xor((k & 1) ? lo : hi, 8);
                w[q][j] = (k & 1) ? cvt_pk_bf16(recv, hi) : cvt_pk_bf16(lo, recv); }
        if (t + stride < t1) { TrDesc dn; int ltn; SEL::get(ctx, t + stride, dn, ltn); const int nktn = dn.K >> 6, ktn = ltn % nktn, ctn = ltn / nktn;
            const float* s = dn.src + (size_t)(ktn * 64 + k) * dn.ldsrc + dn.c0 + ctn * 256 + n8;
#pragma unroll
            for (int q = 0; q < 4; ++q) { v[q][0] = *(const f32x4*)(s + q * 64); v[q][1] = *(const f32x4*)(s + q * 64 + 4); } }
#pragma unroll
        for (int q = 0; q < 4; ++q)
#pragma unroll
            for (int j = 0; j < 4; ++j) tl[(q * 64 + n8 + j + ((k & 1) ? 4 : 0)) * 33 + (k >> 1)] = w[q][j];
        __syncthreads();
        { const int n = tid >> 3, k8 = (tid & 7) * 8;
#pragma unroll
          for (int q = 0; q < 4; ++q) {
              const LAS unsigned* p = tl + (q * 64 + n) * 33 + (k8 >> 1);
              u32x4 ww; ww.x = p[0]; ww.y = p[1]; ww.z = p[2]; ww.w = p[3];
              const int cc = ct * 256 + q * 64 + n;
              const int drow = d.mode == 0 ? d.doff + cc : ((cc >> 7) * 256 + (cc & 127) + (d.mode == 2 ? 128 : 0));
              *(u32x4*)(d.dst + (size_t)drow * d.K + kt * 64 + k8) = ww; } }
        __syncthreads();
    }
}
struct SelOne { static __device__ __forceinline__ void get(const TrDesc& c, int t, TrDesc& d, int& lt) { d = c; lt = t; } };
struct FfnCtx { const float* wg; const float* wu; const float* wd; bf16_t* wgu; bf16_t* wdown; };
struct SelFfn { static __device__ __forceinline__ void get(const FfnCtx& c, int t, TrDesc& d, int& lt) {
    if (t < 704)       { d = TrDesc{c.wg, DFF, 2048, 0, DFF, c.wgu, 1, 0}; lt = t; }
    else if (t < 1408) { d = TrDesc{c.wu, DFF, 2048, 0, DFF, c.wgu, 2, 0}; lt = t - 704; }
    else               { d = TrDesc{c.wd, 2048, DFF, 0, 2048, c.wdown, 0, 0}; lt = t - 1408; } } };

__device__ __forceinline__ double kd(double c) { asm volatile("" : "+v"(c)); return c; }
__device__ __forceinline__ double exp_d(double x) {
    const double y = x * 0.125; double term = 1.0, sum = 1.0;
#pragma unroll 1
    for (int n = 1; n <= 22; ++n) { term *= y / (double)n; sum += term; }
    sum *= sum; sum *= sum; sum *= sum; return sum;
}
__device__ __forceinline__ void sincos_d(double x, double& s, double& c) {
    const double k = rint(x * kd(0.15915494309189535));
    double r = fma(-k, kd(6.283185307179586232), x); r = fma(-k, kd(2.4492935982947064e-16), r);
    const double y = r * 0.125, my2 = -(y * y);
    double sn = y, cs = 1.0, ts = y, tc = 1.0;
#pragma unroll 1
    for (int n = 1; n <= 10; ++n) { tc *= my2 / (double)((2 * n - 1) * (2 * n)); cs += tc; ts *= my2 / (double)((2 * n) * (2 * n + 1)); sn += ts; }
#pragma unroll 1
    for (int i = 0; i < 3; ++i) { const double c2 = cs * cs - sn * sn, s2 = 2.0 * sn * cs; cs = c2; sn = s2; }
    s = sn; c = cs;
}

__device__ __forceinline__ void s5_disc(const Args& a, int l, int g, int dir, int p, double& ar, double& ai, double& qr, double& qi) {
    const double lr = (double)a.in[7][((l * 2 + dir) * 48 + g) * 64 + p], li = (double)a.in[8][((l * 2 + dir) * 48 + g) * 64 + p];
    const double st = exp_d((double)a.in[9][(l * 2 + dir) * 48 + g]);
    const double mag = exp_d(lr * st); double sn, cs; sincos_d(li * st, sn, cs);
    ar = mag * cs; ai = mag * sn; const double den = lr * lr + li * li, nr = ar - 1.0;
    qr = (nr * lr + ai * li) / den; qi = (ai * lr - nr * li) / den;
}
__device__ __forceinline__ void s5_group_a(LAS unsigned char* lds, const Args& a, int l, int g) {
    const int tid = tid_l();
    LAS float* apw = (LAS float*)lds;
    LAS float* bbr = apw + 2 * 33 * 64 * 2;
    bf16_t* GMp = (bf16_t*)(a.ws + WS_GM); float* ALp = (float*)(a.ws + WS_AL); float* APWp = (float*)(a.ws + WS_APW);
    if (tid < 128) {
        const int dir = tid >> 6, p = tid & 63;
        double ar, ai, qr, qi; s5_disc(a, l, g, dir, p, ar, ai, qr, qi);
        double pr = 1.0, pi = 0.0;
#pragma unroll 1
        for (int tau = 0; tau <= 32; ++tau) { const float fr_ = (float)pr, fi_ = (float)pi;
            apw[((dir * 33 + tau) * 64 + p) * 2] = fr_; apw[((dir * 33 + tau) * 64 + p) * 2 + 1] = fi_;
            *(f32x2*)(APWp + ((size_t)((g * 2 + dir) * 33 + tau) * 64 + p) * 2) = (f32x2){fr_, fi_};
            const double nr2 = pr * ar - pi * ai, ni2 = pr * ai + pi * ar; pr = nr2; pi = ni2; }
        ALp[((g * 2 + dir) * 64 + p) * 2] = apw[((dir * 33 + 32) * 64 + p) * 2]; ALp[((g * 2 + dir) * 64 + p) * 2 + 1] = apw[((dir * 33 + 32) * 64 + p) * 2 + 1];
#pragma unroll 1
        for (int c = 0; c < 16; ++c) { const double br = (double)a.in[10][((l * 48 + g) * 64 + p) * 16 + c], bi = (double)a.in[11][((l * 48 + g) * 64 + p) * 16 + c];
            bbr[((dir * 64 + p) * 16 + c) * 2] = (float)(qr * br - qi * bi); bbr[((dir * 64 + p) * 16 + c) * 2 + 1] = (float)(qr * bi + qi * br); }
    }
    __syncthreads();
    {
        const int row = tid >> 1, half = tid & 1, dir = row >> 7, p = (row >> 1) & 63, ri = row & 1;
        bf16_t* rowp = GMp + ((size_t)g * 256 + row) * 512;
        for (int jj = 0; jj < 16; ++jj) { const int j = half * 16 + jj, e = dir == 0 ? 31 - j : j;
            const float wr_ = apw[((dir * 33 + e) * 64 + p) * 2], wi_ = apw[((dir * 33 + e) * 64 + p) * 2 + 1];
            float v[16];
#pragma unroll
            for (int c2 = 0; c2 < 16; ++c2) { const float Br = bbr[((dir * 64 + p) * 16 + c2) * 2], Bi = bbr[((dir * 64 + p) * 16 + c2) * 2 + 1];
                v[c2] = ri == 0 ? wr_ * Br - wi_ * Bi : wr_ * Bi + wi_ * Br; }
            u32x4 w0, w1; w0.x = cvt_pk_bf16(v[0], v[1]); w0.y = cvt_pk_bf16(v[2], v[3]); w0.z = cvt_pk_bf16(v[4], v[5]); w0.w = cvt_pk_bf16(v[6], v[7]);
            w1.x = cvt_pk_bf16(v[8], v[9]); w1.y = cvt_pk_bf16(v[10], v[11]); w1.z = cvt_pk_bf16(v[12], v[13]); w1.w = cvt_pk_bf16(v[14], v[15]);
            *(u32x4*)(rowp + j * 16) = w0; *(u32x4*)(rowp + j * 16 + 8) = w1; }
    }
    __syncthreads();
}
__device__ __forceinline__ void s5_ktab(LAS unsigned char* lds, const Args& a, int l, int task) {
    const int tid = tid_l(), g = task >> 3, dir = (task >> 2) & 1, tb = task & 3;
    LAS float* ap8 = (LAS float*)lds;
    LAS float* bbr = ap8 + 8 * 64 * 2;
    LAS float* ccx = bbr + 64 * 16 * 2;
    LAS float* cw  = ccx + 16 * 64 * 2;
    float* KTp = (float*)(a.ws + WS_KT);
    if (tid < 64) {
        const int p = tid; double ar, ai, qr, qi; s5_disc(a, l, g, dir, p, ar, ai, qr, qi);
        double pr = 1.0, pi = 0.0;
#pragma unroll 1
        for (int t = 0; t < tb * 8; ++t) { const double nr2 = pr * ar - pi * ai, ni2 = pr * ai + pi * ar; pr = nr2; pi = ni2; }
#pragma unroll 1
        for (int t = 0; t < 8; ++t) { ap8[(t * 64 + p) * 2] = (float)pr; ap8[(t * 64 + p) * 2 + 1] = (float)pi;
            const double nr2 = pr * ar - pi * ai, ni2 = pr * ai + pi * ar; pr = nr2; pi = ni2; }
#pragma unroll 1
        for (int c = 0; c < 16; ++c) { const double br = (double)a.in[10][((l * 48 + g) * 64 + p) * 16 + c], bi = (double)a.in[11][((l * 48 + g) * 64 + p) * 16 + c];
            bbr[(p * 16 + c) * 2] = (float)(qr * br - qi * bi); bbr[(p * 16 + c) * 2 + 1] = (float)(qr * bi + qi * br); }
    }
    for (int idx = tid; idx < 1024; idx += NTHREADS) { const int c = idx >> 6, p = idx & 63;
        ccx[idx * 2] = a.in[12][((l * 48 + g) * 16 + c) * 64 + p]; ccx[idx * 2 + 1] = a.in[13][((l * 48 + g) * 16 + c) * 64 + p]; }
    __syncthreads();
    for (int idx = tid; idx < 8192; idx += NTHREADS) { const int t = idx >> 10, cp = idx & 1023, p = idx & 63;
        const float Cr = ccx[cp * 2], Ci = ccx[cp * 2 + 1], wr_ = ap8[(t * 64 + p) * 2], wi_ = ap8[(t * 64 + p) * 2 + 1];
        cw[idx * 2] = Cr * wr_ - Ci * wi_; cw[idx * 2 + 1] = Cr * wi_ + Ci * wr_; }
    __syncthreads();
#pragma unroll
    for (int k = 0; k < 4; ++k) { const int o = tid + k * NTHREADS, t = o >> 8, c = (o >> 4) & 15, c2 = o & 15;
        float s = 0.f;
        for (int p = 0; p < 64; ++p) s += cw[((t * 16 + c) * 64 + p) * 2] * bbr[(p * 16 + c2) * 2] - cw[((t * 16 + c) * 64 + p) * 2 + 1] * bbr[(p * 16 + c2) * 2 + 1];
        KTp[((size_t)((g * 2 + dir) * 32 + tb * 8 + t)) * 256 + c * 16 + c2] = s; }
    __syncthreads();
}
__device__ __forceinline__ void s5_te(const Args& a, int l, int task) {
    const int tid = tid_l(), g = task >> 2, qd = task & 3, r = tid >> 2, sub = tid & 3, i = qd * 8 + (r >> 4), c = r & 15;
    const float* KTp = (const float*)(a.ws + WS_KT); const float* APWp = (const float*)(a.ws + WS_APW);
    bf16_t* rowp = (bf16_t*)(a.ws + WS_TE) + ((size_t)g * 512 + i * 16 + c) * 768;
    const float dsk = a.in[14][l * 768 + g * 16 + c];
    const float* kf = KTp + (size_t)((g * 2 + 0) * 32) * 256 + c * 16; const float* kb = KTp + (size_t)((g * 2 + 1) * 32) * 256 + c * 16;
#pragma unroll
    for (int jb = 0; jb < 8; jb += 4) {
        f32x4 v[4][4];
#pragma unroll
        for (int jq = 0; jq < 4; ++jq) { const int j = sub * 8 + jb + jq;
            const float* kp = j < i ? kf + (i - j) * 256 : (j > i ? kb + (j - i) * 256 : kf);
#pragma unroll
            for (int q = 0; q < 4; ++q) v[jq][q] = *(const f32x4*)(kp + q * 4);
            if (j == i) {
#pragma unroll
                for (int q = 0; q < 4; ++q) { v[jq][q] += *(const f32x4*)(kb + q * 4);
#pragma unroll
                    for (int e = 0; e < 4; ++e) v[jq][q][e] += (q * 4 + e == c) ? dsk : 0.f; } } }
#pragma unroll
        for (int jq = 0; jq < 4; ++jq) { const int j = sub * 8 + jb + jq;
            *(u32x4*)(rowp + j * 16) = pack8(v[jq][0], v[jq][1]); *(u32x4*)(rowp + j * 16 + 8) = pack8(v[jq][2], v[jq][3]); } }
    { const int dir = sub >> 1, p0 = (sub & 1) * 32, e = dir == 0 ? i + 1 : 32 - i;
      const float* cr = a.in[12] + ((l * 48 + g) * 16 + c) * 64 + p0; const float* ci = a.in[13] + ((l * 48 + g) * 16 + c) * 64 + p0;
      const float* aw = APWp + ((size_t)((g * 2 + dir) * 33 + e) * 64 + p0) * 2;
#pragma unroll 2
      for (int p4 = 0; p4 < 32; p4 += 4) { const f32x4 Cr = *(const f32x4*)(cr + p4), Ci = *(const f32x4*)(ci + p4), w0 = *(const f32x4*)(aw + p4 * 2), w1 = *(const f32x4*)(aw + p4 * 2 + 4);
          u32x4 ww; ww.x = cvt_pk_bf16(Cr[0] * w0[0] - Ci[0] * w0[1], -(Cr[0] * w0[1] + Ci[0] * w0[0])); ww.y = cvt_pk_bf16(Cr[1] * w0[2] - Ci[1] * w0[3], -(Cr[1] * w0[3] + Ci[1] * w0[2]));
          ww.z = cvt_pk_bf16(Cr[2] * w1[0] - Ci[2] * w1[1], -(Cr[2] * w1[1] + Ci[2] * w1[0])); ww.w = cvt_pk_bf16(Cr[3] * w1[2] - Ci[3] * w1[3], -(Cr[3] * w1[3] + Ci[3] * w1[2]));
          *(u32x4*)(rowp + 512 + dir * 128 + (p0 + p4) * 2) = ww; } }
}

__device__ __forceinline__ void winbf_task(LAS unsigned char* lds, const float* w_in_l, bf16_t* dst, int task) {
    const int tid = tid_l(), g = task & 3, k0 = (task >> 2) * 64;
    LAS float* Wt = (LAS float*)lds;
    LAS float* tc = Wt + 64 * 128; LAS float* ts = tc + 128;
    { const int k = tid >> 3, c16 = (tid & 7) * 16; const float* s = w_in_l + (size_t)(k0 + k) * INW + 1536 + g * 128 + c16;
#pragma unroll
      for (int q = 0; q < 4; ++q) *(LAS f32x4*)(Wt + k * 128 + c16 + q * 4) = *(const f32x4*)(s + q * 4); }
    if (tid < 128) { float sn, cs; sincospif((float)tid * (1.0f / 64.0f), &sn, &cs); tc[tid] = cs; ts[tid] = sn; }
    __syncthreads();
    const int cp = tid & 127, kq = tid >> 7;
    float aC[16], aS[16];
#pragma unroll
    for (int kk = 0; kk < 16; ++kk) { aC[kk] = 0.f; aS[kk] = 0.f; }
    for (int c = 0; c < 128; ++c) { const int idx = (c * cp) & 127; const float vc = tc[idx], vs = ts[idx];
#pragma unroll
        for (int kk = 0; kk < 16; ++kk) { const float w = Wt[(kq * 16 + kk) * 128 + c]; aC[kk] += w * vc; aS[kk] += w * vs; } }
    bf16_t* dc = dst + (size_t)(g * 128 + cp) * 2048 + k0 + kq * 16; bf16_t* ds = dst + (size_t)(512 + g * 128 + cp) * 2048 + k0 + kq * 16;
    u32x4 w; w.x = cvt_pk_bf16(aC[0], aC[1]); w.y = cvt_pk_bf16(aC[2], aC[3]); w.z = cvt_pk_bf16(aC[4], aC[5]); w.w = cvt_pk_bf16(aC[6], aC[7]); *(u32x4*)dc = w;
    w.x = cvt_pk_bf16(aC[8], aC[9]); w.y = cvt_pk_bf16(aC[10], aC[11]); w.z = cvt_pk_bf16(aC[12], aC[13]); w.w = cvt_pk_bf16(aC[14], aC[15]); *(u32x4*)(dc + 8) = w;
    w.x = cvt_pk_bf16(aS[0], aS[1]); w.y = cvt_pk_bf16(aS[2], aS[3]); w.z = cvt_pk_bf16(aS[4], aS[5]); w.w = cvt_pk_bf16(aS[6], aS[7]); *(u32x4*)ds = w;
    w.x = cvt_pk_bf16(aS[8], aS[9]); w.y = cvt_pk_bf16(aS[10], aS[11]); w.z = cvt_pk_bf16(aS[12], aS[13]); w.w = cvt_pk_bf16(aS[14], aS[15]); *(u32x4*)(ds + 8) = w;
    __syncthreads();
}

__device__ __forceinline__ void d256_gen(bf16_t* d256, int bx, int G) {
    for (int idx = bx * NTHREADS + tid_l(); idx < 256 * 512; idx += G * NTHREADS) { const int k1 = idx >> 9, ri = (idx >> 8) & 1, n1 = idx & 255, e = (n1 * k1) & 255;
        float sn, cs; sincospif((float)e * (1.0f / 128.0f), &sn, &cs);
        d256[idx] = f2bf((ri == 0 ? cs : -sn) * 0.0013810679320049757f); }
}
__device__ __forceinline__ void fft16_pass(LAS unsigned char* lds, const bf16_t* zf2, bf16_t* vt, int bx, int G) {
    const int tid = tid_l();
    LAS float* tw = (LAS float*)lds;
    for (int i = tid; i < 4096; i += NTHREADS) { float sn, cs; sincospif((float)i * (1.0f / 2048.0f), &sn, &cs); tw[2 * i] = cs; tw[2 * i + 1] = sn; }
    __syncthreads();
    const int n1 = tid & 255, sub = tid >> 8;
    u32x4 pw0, pw1, pw2, pw3;
    { const int task0 = bx * 2 + sub; if (task0 < 3072) { const bf16_t* src = zf2 + ((size_t)task0 * 256 + n1) * 32; pw0 = *(const u32x4*)src; pw1 = *(const u32x4*)(src + 8); pw2 = *(const u32x4*)(src + 16); pw3 = *(const u32x4*)(src + 24); } }
    for (int task = bx * 2 + sub; task < 3072; task += G * 2) {
        const u32x4 w0 = pw0, w1 = pw1, w2 = pw2, w3 = pw3;
        if (task + G * 2 < 3072) { const bf16_t* src = zf2 + ((size_t)(task + G * 2) * 256 + n1) * 32; pw0 = *(const u32x4*)src; pw1 = *(const u32x4*)(src + 8); pw2 = *(const u32x4*)(src + 16); pw3 = *(const u32x4*)(src + 24); }
        float zr[16], zi[16];
#pragma unroll
        for (int e = 0; e < 4; ++e) { zr[2 * e] = bf_lo(w0[e]); zr[2 * e + 1] = bf_hi(w0[e]); zr[8 + 2 * e] = bf_lo(w1[e]); zr[8 + 2 * e + 1] = bf_hi(w1[e]);
                                      zi[2 * e] = bf_lo(w2[e]); zi[2 * e + 1] = bf_hi(w2[e]); zi[8 + 2 * e] = bf_lo(w3[e]); zi[8 + 2 * e + 1] = bf_hi(w3[e]); }
        float Ar[4][4], Ai[4][4];
#pragma unroll
        for (int q = 0; q < 4; ++q) {
            const float s0r = zr[q] + zr[8 + q], s0i = zi[q] + zi[8 + q], s1r = zr[q] - zr[8 + q], s1i = zi[q] - zi[8 + q];
            const float s2r = zr[4 + q] + zr[12 + q], s2i = zi[4 + q] + zi[12 + q], s3r = zr[4 + q] - zr[12 + q], s3i = zi[4 + q] - zi[12 + q];
            Ar[q][0] = s0r + s2r; Ai[q][0] = s0i + s2i; Ar[q][2] = s0r - s2r; Ai[q][2] = s0i - s2i;
            Ar[q][1] = s1r - s3i; Ai[q][1] = s1i + s3r; Ar[q][3] = s1r + s3i; Ai[q][3] = s1i - s3r; }
        const float c1 = 0.9238795325f, s1 = 0.3826834324f, c2 = 0.7071067812f;
#define CMUL(xr, xi, cr, ci) { const float t_ = xr * (cr) - xi * (ci); xi = xr * (ci) + xi * (cr); xr = t_; }
        CMUL(Ar[1][1], Ai[1][1], c1, s1) CMUL(Ar[1][2], Ai[1][2], c2, c2) CMUL(Ar[1][3], Ai[1][3], s1, c1)
        CMUL(Ar[2][1], Ai[2][1], c2, c2) CMUL(Ar[2][2], Ai[2][2], 0.f, 1.f) CMUL(Ar[2][3], Ai[2][3], -c2, c2)
        CMUL(Ar[3][1], Ai[3][1], s1, c1) CMUL(Ar[3][2], Ai[3][2], -c2, c2) CMUL(Ar[3][3], Ai[3][3], -c1, -s1)
#undef CMUL
        float xr[16], xi[16];
#pragma unroll
        for (int r = 0; r < 4; ++r) {
            const float s0r = Ar[0][r] + Ar[2][r], s0i = Ai[0][r] + Ai[2][r], s1r = Ar[0][r] - Ar[2][r], s1i = Ai[0][r] - Ai[2][r];
            const float s2r = Ar[1][r] + Ar[3][r], s2i = Ai[1][r] + Ai[3][r], s3r = Ar[1][r] - Ar[3][r], s3i = Ai[1][r] - Ai[3][r];
            xr[r] = s0r + s2r; xi[r] = s0i + s2i; xr[r + 8] = s0r - s2r; xi[r + 8] = s0i - s2i;
            xr[r + 4] = s1r - s3i; xi[r + 4] = s1i + s3r; xr[r + 12] = s1r + s3i; xi[r + 12] = s1i - s3r; }
        const int b = task >> 9, gc = task & 511;
        bf16_t* dst = vt + ((size_t)(b * 16) * 512 + gc) * 512 + n1;
#pragma unroll
        for (int k2 = 0; k2 < 16; ++k2) { const int idx = (n1 * k2) & 4095; const float c = tw[2 * idx], sn = tw[2 * idx + 1];
            dst[(size_t)k2 * 512 * 512] = f2bf(xr[k2] * c - xi[k2] * sn); dst[(size_t)k2 * 512 * 512 + 256] = f2bf(xr[k2] * sn + xi[k2] * c); }
    }
    __syncthreads();
}

template <int MODE>
__device__ __forceinline__ void rms_rows(const float* xp, const float* xs, float* xres, const float* gain, bf16_t* outb, int bx, int G) {
    const int tid = tid_l(), lane = tid & 63, wave = tid >> 6;
    f32x4 gv[8];
#pragma unroll
    for (int it = 0; it < 8; ++it) gv[it] = *(const f32x4*)(gain + it * 256 + lane * 4);
    for (int row = (bx * 8 + wave) * 2; row < T; row += G * 16) {
        f32x4 v[2][8]; float ss[2] = {0.f, 0.f};
#pragma unroll
        for (int rr = 0; rr < 2; ++rr) { const int r_ = row + rr;
            const float* src = MODE == 0 ? (r_ < 16384 ? xp + (size_t)r_ * 2048 : xs + (size_t)(r_ - 16384) * 2048) : xres + (size_t)r_ * 2048;
#pragma unroll
            for (int it = 0; it < 8; ++it) v[rr][it] = *(const f32x4*)(src + it * 256 + lane * 4); }
#pragma unroll
        for (int rr = 0; rr < 2; ++rr) {
#pragma unroll
            for (int it = 0; it < 8; ++it) ss[rr] += v[rr][it][0] * v[rr][it][0] + v[rr][it][1] * v[rr][it][1] + v[rr][it][2] * v[rr][it][2] + v[rr][it][3] * v[rr][it][3];
            ss[rr] = wave_sum(ss[rr]); }
#pragma unroll
        for (int rr = 0; rr < 2; ++rr) { const float r = 1.0f / sqrtf(ss[rr] * (1.0f / 2048.0f) + EPS);
#pragma unroll
            for (int it = 0; it < 8; ++it) {
                const f32x4 o = v[rr][it] * r * gv[it];
                if (MODE == 2) *(f32x4*)(xres + (size_t)(row + rr) * 2048 + it * 256 + lane * 4) = o;
                else { u32x2 w; w.x = cvt_pk_bf16(o[0], o[1]); w.y = cvt_pk_bf16(o[2], o[3]); *(u32x2*)(outb + (size_t)(row + rr) * 2048 + it * 256 + lane * 4) = w; }
            } }
    }
}

__device__ __forceinline__ void outnorm_rows(bf16_t* y, const float* og, int bx, int G) {
    const int tid = tid_l(), lane = tid & 63, wave = tid >> 6;
    for (int row = (bx * 8 + wave) * 2; row < T; row += G * 16) {
        u32x4 w[2][4]; float ss[2][3];
#pragma unroll
        for (int rr = 0; rr < 2; ++rr)
#pragma unroll
            for (int it = 0; it < 4; ++it) w[rr][it] = *(const u32x4*)(y + (size_t)(row + rr) * 2048 + (it * 64 + lane) * 8);
#pragma unroll
        for (int rr = 0; rr < 2; ++rr) { ss[rr][0] = 0.f; ss[rr][1] = 0.f; ss[rr][2] = 0.f;
#pragma unroll
            for (int it = 0; it < 4; ++it) { const int ch = it * 64 + lane; float s = 0.f;
#pragma unroll
                for (int q = 0; q < 4; ++q) { const float a0 = bf_lo(w[rr][it][q]), a1 = bf_hi(w[rr][it][q]); s += a0 * a0 + a1 * a1; }
                const int seg = ch < 96 ? 0 : (ch < 160 ? 1 : 2);
                ss[rr][0] += seg == 0 ? s : 0.f; ss[rr][1] += seg == 1 ? s : 0.f; ss[rr][2] += seg == 2 ? s : 0.f; }
            ss[rr][0] = wave_sum(ss[rr][0]); ss[rr][1] = wave_sum(ss[rr][1]); ss[rr][2] = wave_sum(ss[rr][2]); }
#pragma unroll
        for (int rr = 0; rr < 2; ++rr) {
            const float r0 = 1.0f / sqrtf(ss[rr][0] * (1.0f / 768.0f) + EPS), r1 = 1.0f / sqrtf(ss[rr][1] * (1.0f / 512.0f) + EPS), r2 = 1.0f / sqrtf(ss[rr][2] * (1.0f / 768.0f) + EPS);
#pragma unroll
            for (int it = 0; it < 4; ++it) { const int ch = it * 64 + lane; const float r = ch < 96 ? r0 : (ch < 160 ? r1 : r2);
                const f32x4 g0 = *(const f32x4*)(og + ch * 8), g1 = *(const f32x4*)(og + ch * 8 + 4);
                const u32x4 ww = w[rr][it];
                u32x4 o; o.x = cvt_pk_bf16(bf_lo(ww.x) * r * g0[0], bf_hi(ww.x) * r * g0[1]); o.y = cvt_pk_bf16(bf_lo(ww.y) * r * g0[2], bf_hi(ww.y) * r * g0[3]);
                o.z = cvt_pk_bf16(bf_lo(ww.z) * r * g1[0], bf_hi(ww.z) * r * g1[1]); o.w = cvt_pk_bf16(bf_lo(ww.w) * r * g1[2], bf_hi(ww.w) * r * g1[3]);
                *(u32x4*)(y + (size_t)(row + rr) * 2048 + ch * 8) = o; } }
    }
}

__device__ __forceinline__ void gmlp_task(LAS unsigned char* lds, const bf16_t* zina, const bf16_t* wsb, const float* vg, const float* bs, bf16_t* y, int task) {
    const int tid = tid_l(), lane = tid & 63, wid = tid >> 6, fr = lane & 15, fq = lane >> 4;
    const int cidx = task / 6, h = task - cidx * 6, t0 = cidx * 128;
    LAS bf16_t* vT = (LAS bf16_t*)lds;
    { const int k = tid >> 2, dq = (tid & 3) * 32;
      const bf16_t* src = zina + (size_t)(t0 + k) * 1536 + 768 + h * 128 + dq;
      u32x4 w[4]; float ss = 0.f;
#pragma unroll
      for (int q = 0; q < 4; ++q) { w[q] = *(const u32x4*)(src + q * 8);
#pragma unroll
          for (int e = 0; e < 4; ++e) { const float a0 = bf_lo(w[q][e]), a1 = bf_hi(w[q][e]); ss += a0 * a0 + a1 * a1; } }
      ss += __shfl_xor(ss, 1); ss += __shfl_xor(ss, 2);
      const float r = 1.0f / sqrtf(ss * (1.0f / 128.0f) + EPS);
#pragma unroll
      for (int q = 0; q < 4; ++q)
#pragma unroll
          for (int e = 0; e < 4; ++e) { const int d = dq + q * 8 + e * 2;
              vT[d * 136 + k] = f2bf(bf_lo(w[q][e]) * r * vg[h * 128 + d]); vT[(d + 1) * 136 + k] = f2bf(bf_hi(w[q][e]) * r * vg[h * 128 + d + 1]); } }
    __syncthreads();
    const int q0 = (wid >> 1) * 32, d0 = (wid & 1) * 64;
    f32x4 acc[2][4];
#pragma unroll
    for (int mq = 0; mq < 2; ++mq)
#pragma unroll
        for (int nd = 0; nd < 4; ++nd) acc[mq][nd] = (f32x4){0.f, 0.f, 0.f, 0.f};
#pragma unroll
    for (int ks = 0; ks < 4; ++ks) {
        bf16x8 af[2], bfr[4];
#pragma unroll
        for (int mq = 0; mq < 2; ++mq) af[mq] = *(const bf16x8*)(wsb + (size_t)(h * 128 + q0 + mq * 16 + fr) * 128 + ks * 32 + fq * 8);
#pragma unroll
        for (int nd = 0; nd < 4; ++nd) bfr[nd] = *(const LAS bf16x8*)(vT + (d0 + nd * 16 + fr) * 136 + ks * 32 + fq * 8);
#pragma unroll
        for (int mq = 0; mq < 2; ++mq)
#pragma unroll
            for (int nd = 0; nd < 4; ++nd) acc[mq][nd] = __builtin_amdgcn_mfma_f32_16x16x32_bf16(bfr[nd], af[mq], acc[mq][nd], 0, 0, 0);
    }
    u32x2 uq[2][4];
#pragma unroll
    for (int mq = 0; mq < 2; ++mq)
#pragma unroll
        for (int nd = 0; nd < 4; ++nd) uq[mq][nd] = *(const u32x2*)(zina + (size_t)(t0 + q0 + mq * 16 + fr) * 1536 + h * 128 + d0 + nd * 16 + 4 * fq);
#pragma unroll
    for (int mq = 0; mq < 2; ++mq) { const int q = q0 + mq * 16 + fr; const float b = bs[h * 128 + q];
#pragma unroll
        for (int nd = 0; nd < 4; ++nd) { const int d = d0 + nd * 16 + 4 * fq;
            const u32x2 uu = uq[mq][nd];
            const f32x4 m = acc[mq][nd] + b;
            u32x2 o; o.x = cvt_pk_bf16(bf_lo(uu.x) * m[0], bf_hi(uu.x) * m[1]); o.y = cvt_pk_bf16(bf_lo(uu.y) * m[2], bf_hi(uu.y) * m[3]);
            *(u32x2*)(y + (size_t)(t0 + q) * 2048 + h * 128 + d) = o; } }
    __syncthreads();
}

__device__ __forceinline__ void carry_scan(const float* xs, const float* ALp, bf16_t* ucat, int bx) {
    const int idx = bx * NTHREADS + tid_l();
    if (idx >= 48 * 6 * 128) return;
    const int p = idx & 63, dir = (idx >> 6) & 1, b = (idx >> 7) % 6, g = idx / 768;
    const f32x2 aL = *(const f32x2*)(ALp + ((g * 2 + dir) * 64 + p) * 2);
    float hr = 0.f, hi = 0.f;
#pragma unroll 32
    for (int s = 0; s < 128; ++s) { const int c = dir == 0 ? s : 127 - s; const size_t chunk = (size_t)g * 768 + b * 128 + c;
        const f32x2 x = *(const f32x2*)(xs + chunk * 256 + dir * 128 + p * 2);
        *(unsigned*)(ucat + chunk * 768 + 512 + dir * 128 + p * 2) = cvt_pk_bf16(hr, hi);
        const float nr = aL.x * hr - aL.y * hi + x.x, ni = aL.x * hi + aL.y * hr + x.y; hr = nr; hi = ni; }
}

__device__ __forceinline__ void carry_scan_tile(const float* xs, const float* ALp, bf16_t* ucat, int g, int pm) {
    const int tid = tid_l();
    if (tid < 256) {
        const int p = tid & 63, dir = (tid >> 6) & 1, b = 2 * pm + (tid >> 7);
        const f32x2 aL = *(const f32x2*)(ALp + ((g * 2 + dir) * 64 + p) * 2);
        float hr = 0.f, hi = 0.f;
#pragma unroll 32
        for (int s = 0; s < 128; ++s) { const int c = dir == 0 ? s : 127 - s; const size_t chunk = (size_t)g * 768 + b * 128 + c;
            const f32x2 x = *(const f32x2*)(xs + chunk * 256 + dir * 128 + p * 2);
            *(unsigned*)(ucat + chunk * 768 + 512 + dir * 128 + p * 2) = cvt_pk_bf16(hr, hi);
            const float nr = aL.x * hr - aL.y * hi + x.x, ni = aL.x * hi + aL.y * hr + x.y; hr = nr; hi = ni; }
    }
}
#define XB_TMO      128
#define XB_XCNT(j)  (256  + 64 * (j))
#define XB_XSUB(j)  (1280 + 64 * (j))
#define XB_XGEN(j)  (2304 + 64 * (j))
#define XB_TOP      3328
#define XB_TOPGEN   3392
#define XCD_BAR_WORDS 3456
#define XB_SPIN_CAP (1u << 22)
__device__ __forceinline__ unsigned xb_ld(unsigned* p)              { return __hip_atomic_load(p, __ATOMIC_RELAXED, __HIP_MEMORY_SCOPE_AGENT); }
__device__ __forceinline__ unsigned xb_add(unsigned* p, unsigned v) { return __hip_atomic_fetch_add(p, v, __ATOMIC_RELAXED, __HIP_MEMORY_SCOPE_AGENT); }
__device__ __forceinline__ unsigned xb_xcc_id() { return (unsigned)__builtin_amdgcn_s_getreg((3 << 11) | 20) & 0xFu; }
#define XB_SPIN(cond, bar) do { unsigned _sp = 0; while (cond) { __builtin_amdgcn_s_sleep(1); \
    if ((++_sp & 255u) == 0u) { if (xb_ld(&(bar)[XB_TMO])) break; if (_sp > XB_SPIN_CAP) { atomicAdd(&(bar)[XB_TMO], 1u); break; } } } } while (0)
struct XcdBarrier { unsigned* bar; unsigned x; volatile LAS unsigned* st; };
__device__ __forceinline__ XcdBarrier xcd_barrier_post(unsigned* bar, volatile LAS unsigned* st) {
    XcdBarrier b; b.bar = bar; b.x = xb_xcc_id(); b.st = st;
    if (threadIdx.x == 0) (void)xb_add(&bar[XB_XCNT(b.x)], 1u);
    return b;
}
__device__ __forceinline__ void xcd_barrier_complete(unsigned* bar, unsigned x, unsigned& nloc, unsigned& nx) {
    const unsigned Gt = gridDim.x * gridDim.y * gridDim.z;
    unsigned sum, cnt, mine, sp = 0u;
    for (;;) {
        sum = 0u; cnt = 0u; mine = 0u;
#pragma unroll
        for (unsigned j = 0; j < 16; ++j) { const unsigned c = xb_ld(&bar[XB_XCNT(j)]); sum += c; cnt += (c > 0u) ? 1u : 0u; mine = (j == x) ? c : mine; }
        if (sum == Gt) break;
        __builtin_amdgcn_s_sleep(1);
        if ((++sp & 255u) == 0u) { if (xb_ld(&bar[XB_TMO])) break; if (sp > XB_SPIN_CAP) { atomicAdd(&bar[XB_TMO], 1u); break; } }
    }
    nloc = mine > 0u ? mine : 1u; nx = cnt > 0u ? cnt : 1u;
}
__device__ __forceinline__ void xcd_barrier(const XcdBarrier& b) {
    asm volatile("s_waitcnt vmcnt(0)" ::: "memory");
    __syncthreads();
    if (threadIdx.x == 0) {
        unsigned* bar = b.bar;
        __builtin_amdgcn_s_waitcnt(0);
        unsigned nloc = b.st[0], nx = b.st[1];
        if (nloc == 0u) { xcd_barrier_complete(bar, b.x, nloc, nx); b.st[0] = nloc; b.st[1] = nx; }
        const unsigned old = xb_add(&bar[XB_XSUB(b.x)], 1u);
        const unsigned gen = old / nloc;
        if (old + 1u == (gen + 1u) * nloc) {
            __builtin_amdgcn_fence(__ATOMIC_RELEASE, "agent");
            asm volatile("s_waitcnt vmcnt(0)" ::: "memory");
            const unsigned og = xb_add(&bar[XB_TOP], 1u);
            const unsigned tg = og / nx;
            if (og + 1u == (tg + 1u) * nx) xb_add(&bar[XB_TOPGEN], 1u);
            else XB_SPIN(xb_ld(&bar[XB_TOPGEN]) == tg, bar);
            __builtin_amdgcn_fence(__ATOMIC_ACQUIRE, "agent");
            xb_add(&bar[XB_XGEN(b.x)], 1u);
            asm volatile("s_waitcnt vmcnt(0)" ::: "memory");
        } else {
            XB_SPIN(xb_ld(&bar[XB_XGEN(b.x)]) == gen, bar);
            __builtin_amdgcn_fence(__ATOMIC_ACQUIRE, "agent");
            asm volatile("s_waitcnt vmcnt(0)" ::: "memory");
        }
    }
    __syncthreads();
}

__device__ __forceinline__ void grid_bar(unsigned* cnt, unsigned target) {
    asm volatile("s_waitcnt vmcnt(0)" ::: "memory");
    __syncthreads();
    if (threadIdx.x == 0) {
        __builtin_amdgcn_fence(__ATOMIC_RELEASE, "agent");
        asm volatile("s_waitcnt vmcnt(0)" ::: "memory");
        (void)__hip_atomic_fetch_add(cnt, 1u, __ATOMIC_RELAXED, __HIP_MEMORY_SCOPE_AGENT);
        unsigned sp = 0;
        while (__hip_atomic_load(cnt, __ATOMIC_RELAXED, __HIP_MEMORY_SCOPE_AGENT) < target) { __builtin_amdgcn_s_sleep(1); if (++sp > (1u << 22)) break; }
        __builtin_amdgcn_fence(__ATOMIC_ACQUIRE, "agent");
        asm volatile("s_waitcnt vmcnt(0)" ::: "memory");
    }
    __syncthreads();
}

constexpr int N_PHASES = 23;
__global__ void __launch_bounds__(NTHREADS, 2) mega_fwd(Args a) {
    extern __shared__ __attribute__((aligned(16))) unsigned char lds_raw[];
    LAS unsigned char* lds = (LAS unsigned char*)lds_raw;
    cg::grid_group grid = cg::this_grid();
#define WINAC ((bf16_t*)(ws + WS_WINAC))
#define WINBF ((bf16_t*)(ws + WS_WINBF))
#define WOUT  ((bf16_t*)(ws + WS_WOUT))
#define WGLU  ((bf16_t*)(ws + WS_WGLU))
#define WSB   ((bf16_t*)(ws + WS_WS))
#define WGU   ((bf16_t*)(ws + WS_WGU))
#define WDOWN ((bf16_t*)(ws + WS_WDOWN))
#define VT    ((bf16_t*)(ws + WS_VT))
#define D256  ((bf16_t*)(ws + WS_D256))
#define AL    ((float*)(ws + WS_AL))
#define SLOT1 ((bf16_t*)(ws + WS_SLOT1))
#define ZINA  ((bf16_t*)(ws + WS_ZINA))
#define ZFT   ((bf16_t*)(ws + WS_ZFT))
#define YCPRE ((bf16_t*)(ws + WS_YCPRE))
#define UCAT  ((bf16_t*)(ws + WS_UCAT))
#define XS    ((float*)(ws + WS_XS))
#define TE    ((bf16_t*)(ws + WS_TE))
#define GM    ((bf16_t*)(ws + WS_GM))
#define HID   ((bf16_t*)(ws + WS_HID))
    int ph = 0; unsigned nbar = 0;
    volatile LAS unsigned* xst = (volatile LAS unsigned*)(lds + 131072);
    if (threadIdx.x == 0) { xst[0] = 0u; xst[1] = 0u; }
    __syncthreads();
    const XcdBarrier xbar = xcd_barrier_post((unsigned*)(a.ws + WS_CTL), xst);
#define GRID_SYNC() do { if (a.ph_lo > 4096) { grid.sync(); } else { xcd_barrier(xbar); } ++nbar; } while (0)
#ifndef ONLY_PH
#define ONLY_PH -1
#endif
#ifndef PROBE_DUP
#define PROBE_DUP -1
#endif
#define PH_BEGIN(k) if ((ONLY_PH < 0 || ONLY_PH == (k)) && ph >= a.ph_lo && ph < a.ph_hi) { const int nrep_ = ((k) == PROBE_DUP) ? 2 : 1; for (int rep_ = 0; rep_ < nrep_; ++rep_) { unsigned char* ws = a.ws; float* X = a.out; int bx = blockIdx.x, G = gridDim.x; asm volatile("; PHASEMARK %4" : "+s"(ws), "+s"(X), "+s"(bx), "+s"(G) : "i"(k));
#define PH_END   if (rep_ + 1 < nrep_) GRID_SYNC(); } if (ph + 1 < a.ph_hi) GRID_SYNC(); } ++ph;

#define FFN_CONVERT(t0, t1) do { if (bx >= 32) { \
        const FfnCtx fc{a.in[20] + (size_t)l * 2048 * DFF, a.in[21] + (size_t)l * 2048 * DFF, a.in[22] + (size_t)l * DFF * 2048, WGU, WDOWN}; \
        transpose_run<SelFfn>(lds, fc, (t0) + bx - 32, (t1), G - 32); } } while (0)
#pragma unroll 1
    for (int l = 0; l < 2; ++l) {
        PH_BEGIN(0)
            for (int g = bx; g < NGRP; g += G) s5_group_a(lds, a, l, g);
            for (int t = G - 1 - bx; t < NGRP * 8; t += G) s5_ktab(lds, a, l, t);
            for (int t = (bx + G - 48) % G; t < 128; t += G) winbf_task(lds, a.in[3] + (size_t)l * 2048 * INW, WINBF, t);
            if (l == 0) d256_gen(D256, bx, G);
            {
                const float* s = a.in[5] + (size_t)l * 6 * 128 * 128;
                for (int i = bx * NTHREADS + tid_l(); i < 6 * 128 * 128 / 2; i += G * NTHREADS) ((unsigned*)WSB)[i] = cvt_pk_bf16(s[2 * i], s[2 * i + 1]);
            }
            {
                const TrDesc td[4] = {
                    {a.in[3] + (size_t)l * 2048 * INW, INW, 2048, 0, 1536, WINAC, 0, 0},
                    {a.in[3] + (size_t)l * 2048 * INW, INW, 2048, 2048, 768, WINAC, 0, 1536},
                    {a.in[18] + (size_t)l * 2048 * 2048, 2048, 2048, 0, 2048, WOUT, 0, 0},
                    {a.in[15] + (size_t)l * 768 * 768, 768, 768, 0, 768, WGLU, 0, 0}};
                const int ntile[4] = {32 * 6, 32 * 3, 32 * 8, 12 * 3};
#pragma unroll
                for (int m = 0; m < 4; ++m) transpose_run<SelOne>(lds, td[m], bx, ntile[m], G);
            }
            if (l == 0) rms_rows<0>(a.in[0], a.in[1], X, a.in[2], SLOT1, bx, G);
            else        rms_rows<1>(nullptr, nullptr, X, a.in[2] + l * 2048, SLOT1, bx, G);
        PH_END
        PH_BEGIN(1)
            { pg8::Sched S{(const char*)SLOT1, (const char*)WINAC, 0, 0, 2048, 2048, T / 256, 9, 1, G, bx, 0, 4}; EpiWin E{ZINA, UCAT}; pg8::gemm_phase(lds, S, 2048, E); }
            { pg8::Sched S{(const char*)WINBF, (const char*)SLOT1, 0, 0, 2048, 2048, 4, T / 256, 1, G, G - 1 - bx, 1, 8}; EpiZft2 E{ZFT}; pg8::gemm_phase(lds, S, 2048, E); }
        PH_END
        PH_BEGIN(2)
            fft16_pass(lds, ZFT, VT, bx, G);
            { pg8::Sched S{(const char*)UCAT, (const char*)GM, (long)768 * 768 * 2, (long)256 * 512 * 2, 768, 512, 3, 1, NGRP, G, bx, 0, 8}; EpiXs E{XS}; pg8::gemm_phase(lds, S, 512, E);
              asm volatile("s_waitcnt vmcnt(0)" ::: "memory"); __syncthreads();
              pg8::Unit u; for (int i = 0; S.next(i, u); ++i) carry_scan_tile(XS, AL, UCAT, u.grp, u.pm); }
            if (G == 256) {
                if (bx < 144) { for (int t = bx; t < 432; t += 144) gmlp_task(lds, ZINA, WSB, a.in[4] + l * 768, a.in[6] + l * 768, SLOT1, t); }
                else { for (int t = 432 + bx - 144; t < 192 * 6; t += 112) gmlp_task(lds, ZINA, WSB, a.in[4] + l * 768, a.in[6] + l * 768, SLOT1, t); }
            } else for (int t = G - 1 - bx; t < 192 * 6; t += G) gmlp_task(lds, ZINA, WSB, a.in[4] + l * 768, a.in[6] + l * 768, SLOT1, t);
            for (int t = bx; t < NGRP * 4; t += G) s5_te(a, l, t);
        PH_END
        PH_BEGIN(3)
            { pg8::Sched S{(const char*)D256, (const char*)VT, 0, 0, 512, 512, 1, 192, 1, G, bx, 0, 8}; EpiFour2 E{SLOT1}; pg8::gemm_phase(lds, S, 512, E); }
        PH_END
        PH_BEGIN(4)
            { pg8::Sched S{(const char*)UCAT, (const char*)TE, (long)768 * 768 * 2, (long)512 * 768 * 2, 768, 768, 3, 2, NGRP, G, bx, 0, 8}; EpiYc E{YCPRE}; pg8::gemm_phase(lds, S, 768, E); }
            FFN_CONVERT(0, 1056);
        PH_END
        PH_BEGIN(5)
            { pg8::Sched S{(const char*)YCPRE, (const char*)WGLU, 0, 0, 768, 768, T / 256, 3, 1, G, bx, 0, 4}; EpiGlu E{YCPRE, a.in[16] + l * 768, SLOT1}; pg8::gemm_phase(lds, S, 768, E); }
            FFN_CONVERT(1056, 2112);
        PH_END
        PH_BEGIN(6)
            outnorm_rows(SLOT1, a.in[17] + l * 2048, bx, G);
        PH_END
        PH_BEGIN(7)
            { pg8::Sched S{(const char*)SLOT1, (const char*)WOUT, 0, 0, 2048, 2048, T / 256, 8, 1, G, bx, 0, 4}; EpiRes E{X, l == 0 ? a.in[0] : X, (l == 0 ? a.in[1] : X + (size_t)16384 * 2048) - (size_t)16384 * 2048}; pg8::gemm_phase(lds, S, 2048, E); }
        PH_END
        PH_BEGIN(8)
            rms_rows<1>(nullptr, nullptr, X, a.in[19] + l * 2048, SLOT1, bx, G);
        PH_END
        PH_BEGIN(9)
            { pg8::Sched S{(const char*)SLOT1, (const char*)WGU, 0, 0, 2048, 2048, T / 256, 44, 1, G, bx, 0, 4}; EpiSwi E{HID}; pg8::gemm_phase(lds, S, 2048, E); }
        PH_END
        PH_BEGIN(10)
            { pg8::Sched S{(const char*)HID, (const char*)WDOWN, 0, 0, DFF, DFF, T / 256, 8, 1, G, bx, 0, 4}; EpiRes E{X, X, X}; pg8::gemm_phase(lds, S, DFF, E); }
        PH_END
    }
    PH_BEGIN(11)
        rms_rows<2>(nullptr, nullptr, X, a.in[23], nullptr, bx, G);
    PH_END
#undef PH_BEGIN
#undef PH_END
}

extern "C" void kernel_launch(void* const* d_in, const int* in_sizes, int n_in, void* d_out, int out_size, void* d_ws, size_t ws_size, hipStream_t stream) {
    static int grid = 0;
    if (grid == 0) {
        if (n_in != 24 || out_size != T * DM || ws_size < WS_END) { fprintf(stderr, "kernel_launch: unexpected shapes / workspace (n_in %d out %d ws %zu need %zu)\n", n_in, out_size, ws_size, (size_t)WS_END); grid = -1; return; }
        int dev = 0, cus = 0, per_cu = 0;
        if (hipGetDevice(&dev) != hipSuccess || hipDeviceGetAttribute(&cus, hipDeviceAttributeMultiprocessorCount, dev) != hipSuccess) { grid = -1; return; }
        if (hipFuncSetAttribute((const void*)mega_fwd, hipFuncAttributeMaxDynamicSharedMemorySize, LDS_BYTES) != hipSuccess) { fprintf(stderr, "kernel_launch: hipFuncSetAttribute failed\n"); grid = -1; return; }
        if (hipOccupancyMaxActiveBlocksPerMultiprocessor(&per_cu, (const void*)mega_fwd, NTHREADS, LDS_BYTES) != hipSuccess || per_cu < 1) { fprintf(stderr, "kernel_launch: occupancy query says %d\n", per_cu); per_cu = 1; }
        (void)hipGetLastError();
        grid = cus * 1;
    }
    if (grid < 0) return;
    if (hipMemsetAsync((char*)d_ws + WS_CTL, 0, 16384, stream) != hipSuccess) { fprintf(stderr, "kernel_launch: memset of the barrier word failed\n"); return; }
    Args a{};
    for (int i = 0; i < 24; ++i) a.in[i] = (const float*)d_in[i];
    a.out = (float*)d_out; a.ws = (unsigned char*)d_ws;
#if MK_ONE_LAUNCH
    a.ph_lo = 0; a.ph_hi = N_PHASES;
    void* args[] = {&a};
    hipError_t e = hipLaunchCooperativeKernel((const void*)mega_fwd, dim3(grid), dim3(NTHREADS), args, LDS_BYTES, stream);
    if (e != hipSuccess) fprintf(stderr, "cooperative launch failed: %s (grid %d)\n", hipGetErrorString(e), grid);
#else
    for (int p = 0; p < N_PHASES; ++p) {
        a.ph_lo = p; a.ph_hi = p + 1;
        hipLaunchKernelGGL(mega_fwd, dim3(grid), dim3(NTHREADS), LDS_BYTES, stream, a);
    }
#endif
}
```
